# Optimizing an MI355X kernel written in HIP

```python
import math
import jax, jax.numpy as jnp
from jax import lax
import numpy as np

D_MODEL = 1024
BATCH = 2
SEQ = 8192
DEPTH = 4

HEAD_DIM = 64
BLOCK = 128
DIFF_HEADS = D_MODEL // 256
DIFF_V_DIM = 2 * HEAD_DIM
SWA_Q_HEADS = D_MODEL // 128
SWA_KV_HEADS = max(1, SWA_Q_HEADS // 4)
SWA_GROUP = SWA_Q_HEADS // SWA_KV_HEADS
WINDOW = 128
A_Q = DIFF_HEADS * 2 * HEAD_DIM
A_K = DIFF_HEADS * 2 * HEAD_DIM
A_V = DIFF_HEADS * DIFF_V_DIM
B_Q = SWA_Q_HEADS * HEAD_DIM
B_KV = SWA_KV_HEADS * HEAD_DIM
IN_ATT = A_Q + A_K + A_V + B_Q + 2 * B_KV
MIX_WIDTH = A_V + B_Q
CONV_WIDTH = 31
D_FF = 2816
N_EXPERTS = 8
TOP_K = 2
D_FF_EXPERT = 3584
MOE_CHUNK = 256
RMS_EPS = 1e-6
LN_EPS = 1e-5
N_ATT_LAYERS = (DEPTH + 1) // 2
N_CONV_LAYERS = DEPTH // 2

kernel_name = "hybrid_diffattn_swa_conformer_moe"


def rms_norm(x, g, eps=RMS_EPS):
    xf = x.astype(jnp.float32)
    y = xf * lax.rsqrt(jnp.mean(xf * xf, axis=-1, keepdims=True) + eps)
    return (y * g.astype(jnp.float32)).astype(x.dtype)


def layer_norm(x, g, b, eps=LN_EPS):
    xf = x.astype(jnp.float32)
    mu = jnp.mean(xf, axis=-1, keepdims=True)
    xc = xf - mu
    var = jnp.mean(xc * xc, axis=-1, keepdims=True)
    y = xc * lax.rsqrt(var + eps) * g.astype(jnp.float32) + b.astype(jnp.float32)
    return y.astype(x.dtype)


def swiglu(h, w_gate, w_up, w_down):
    return (jax.nn.silu(h @ w_gate) * (h @ w_up)) @ w_down


def diff_lambda_init(layer):
    return 0.8 - 0.6 * math.exp(-0.3 * layer)


def differential_attention(q, k, v, lam, subln_g, lam_init):
    bsz, seq, heads = q.shape[0], q.shape[1], q.shape[2]
    nb = seq // BLOCK
    scale = HEAD_DIM ** -0.5
    kt = jnp.transpose(k, (0, 3, 2, 1, 4))
    vt = jnp.transpose(v, (0, 2, 1, 3))
    qb = q.reshape(bsz, nb, BLOCK, heads, 2, HEAD_DIM).transpose(1, 0, 4, 3, 2, 5)
    k_pos = jnp.arange(seq)

    def one_block(args):
        qblk, n = args
        s = jnp.einsum('bchqd,bchkd->bchqk', qblk, kt).astype(jnp.float32) * scale
        q_pos = n * BLOCK + jnp.arange(BLOCK)
        causal = k_pos[None, :] <= q_pos[:, None]
        p = jax.nn.softmax(jnp.where(causal, s, -jnp.inf), axis=-1)
        attn = p[:, 0] - lam * p[:, 1]
        return jnp.einsum('bhqk,bhkv->bhqv', attn.astype(vt.dtype), vt)

    o = lax.map(one_block, (qb, jnp.arange(nb)))
    o = o.transpose(1, 0, 3, 2, 4).reshape(bsz, seq, heads, DIFF_V_DIM)
    o = rms_norm(o, subln_g) * (1.0 - lam_init)
    return o.reshape(bsz, seq, heads * DIFF_V_DIM)


def sliding_window_attention(q, k, v, sinks):
    bsz, seq = q.shape[0], q.shape[1]
    nb = seq // BLOCK
    scale = HEAD_DIM ** -0.5
    qb = q.reshape(bsz, nb, BLOCK, SWA_KV_HEADS, SWA_GROUP, HEAD_DIM)

    def with_prev(t):
        tb = t.reshape(bsz, nb, BLOCK, SWA_KV_HEADS, HEAD_DIM)
        prev = jnp.concatenate([jnp.zeros_like(tb[:, :1]), tb[:, :-1]], axis=1)
        return jnp.concatenate([prev, tb], axis=2)

    kw, vw = with_prev(k), with_prev(v)
    s = jnp.einsum('bnqhgd,bnkhd->bnhgqk', qb, kw).astype(jnp.float32) * scale
    i = jnp.arange(BLOCK)[:, None]
    j = jnp.arange(2 * BLOCK)[None, :]
    rel = BLOCK + i - j
    band = (rel >= 0) & (rel < WINDOW)
    key_pos = jnp.arange(nb)[:, None] * BLOCK - BLOCK + jnp.arange(2 * BLOCK)[None, :]
    valid = band[None] & (key_pos >= 0)[:, None, :]
    s = jnp.where(valid[None, :, None, None], s, -jnp.inf)
    sink = sinks.astype(jnp.float32)[None, None, :, :, None, None]
    m = jnp.maximum(jnp.max(s, axis=-1, keepdims=True), sink)
    e = jnp.exp(s - m)
    p = e / (jnp.sum(e, axis=-1, keepdims=True) + jnp.exp(sink - m))
    o = jnp.einsum('bnhgqk,bnkhd->bnqhgd', p.astype(vw.dtype), vw)
    return o.reshape(bsz, seq, SWA_Q_HEADS * HEAD_DIM)


def attention_mixer(x, norm_g, w_in, lam_params, subln_g, sinks, w_out, layer):
    bsz, seq = x.shape[0], x.shape[1]
    h = rms_norm(x, norm_g)
    proj = h @ w_in
    cuts = [A_Q, A_Q + A_K, A_Q + A_K + A_V, A_Q + A_K + A_V + B_Q,
            A_Q + A_K + A_V + B_Q + B_KV]
    qa, ka, va, qb, kb, vb = jnp.split(proj, cuts, axis=-1)
    lam_init = diff_lambda_init(layer)
    lp = lam_params.astype(jnp.float32)
    lam = jnp.exp(jnp.sum(lp[0] * lp[1])) - jnp.exp(jnp.sum(lp[2] * lp[3])) + lam_init
    oa = differential_attention(
        qa.reshape(bsz, seq, DIFF_HEADS, 2, HEAD_DIM),
        ka.reshape(bsz, seq, DIFF_HEADS, 2, HEAD_DIM),
        va.reshape(bsz, seq, DIFF_HEADS, DIFF_V_DIM),
        lam, subln_g, lam_init)
    ob = sliding_window_attention(
        qb.reshape(bsz, seq, SWA_KV_HEADS, SWA_GROUP, HEAD_DIM),
        kb.reshape(bsz, seq, SWA_KV_HEADS, HEAD_DIM),
        vb.reshape(bsz, seq, SWA_KV_HEADS, HEAD_DIM),
        sinks.reshape(SWA_KV_HEADS, SWA_GROUP))
    return jnp.concatenate([oa, ob], axis=-1) @ w_out


def conformer_conv(x, norm_g, w_pw1, b_pw1, w_dw, b_dw, ln_g, ln_b, w_pw2, b_pw2):
    h = rms_norm(x, norm_g)
    a, gate = jnp.split(h @ w_pw1 + b_pw1, 2, axis=-1)
    u = a * jax.nn.sigmoid(gate)
    u = lax.conv_general_dilated(
        u, w_dw[:, None, :], window_strides=(1,),
        padding=((CONV_WIDTH - 1, 0),),
        dimension_numbers=('NWC', 'WIO', 'NWC'),
        feature_group_count=D_MODEL) + b_dw
    u = jax.nn.silu(layer_norm(u, ln_g, ln_b))
    return u @ w_pw2 + b_pw2


def moe_swiglu(x, norm_g, w_router, w_gate, w_up, w_down):
    bsz, seq, dm = x.shape
    h = rms_norm(x, norm_g).reshape(-1, dm)
    n_tok = h.shape[0]
    logits = (h @ w_router).astype(jnp.float32)
    top_logits, top_idx = lax.top_k(logits, TOP_K)
    top_w = jax.nn.softmax(top_logits, axis=-1)
    n_rows = n_tok * TOP_K
    flat_e = top_idx.reshape(-1)
    flat_tok = jnp.arange(n_rows) // TOP_K
    flat_w = top_w.reshape(-1)
    order = jnp.argsort(flat_e, stable=True)
    sorted_e = flat_e[order]
    counts = jnp.bincount(flat_e, length=N_EXPERTS)
    padded = (counts + MOE_CHUNK - 1) // MOE_CHUNK * MOE_CHUNK
    starts = jnp.cumsum(counts) - counts
    padded_ends = jnp.cumsum(padded)
    padded_starts = padded_ends - padded
    dest = padded_starts[sorted_e] + (jnp.arange(n_rows) - starts[sorted_e])
    n_chunks = -(-n_rows // MOE_CHUNK) + N_EXPERTS
    n_pad = n_chunks * MOE_CHUNK
    row_tok = jnp.zeros((n_pad,), jnp.int32).at[dest].set(flat_tok[order].astype(jnp.int32))
    row_w = jnp.zeros((n_pad,), jnp.float32).at[dest].set(flat_w[order])
    chunk_e = jnp.minimum(
        jnp.searchsorted(padded_ends, jnp.arange(n_chunks) * MOE_CHUNK, side='right'),
        N_EXPERTS - 1)
    xs = h[row_tok].reshape(n_chunks, MOE_CHUNK, dm)

    def expert_block(args):
        xc, e = args
        return swiglu(xc, w_gate[e], w_up[e], w_down[e])

    ys = lax.map(expert_block, (xs, chunk_e)).reshape(n_pad, dm)
    y = jnp.zeros((n_tok, dm), h.dtype).at[row_tok].add(ys * row_w[:, None].astype(ys.dtype))
    return y.reshape(bsz, seq, dm)


def setup_inputs(seed: int = 0) -> dict:
    key = jax.random.key(seed)
    ks = iter(jax.random.split(key, 32))

    def nrm(shape, scale):
        return jax.random.normal(next(ks), shape, jnp.float32) * scale

    def gain(shape):
        return 1.0 + nrm(shape, 0.02)

    na, nc = N_ATT_LAYERS, N_CONV_LAYERS
    return {
        "x": nrm((BATCH, SEQ, D_MODEL), 1.0),
        "attn_norm_g": gain((na, D_MODEL)),
        "w_in_att": nrm((na, D_MODEL, IN_ATT), D_MODEL ** -0.5),
        "diff_lambda": nrm((na, 4, HEAD_DIM), 0.1),
        "diff_subln_g": gain((na, DIFF_V_DIM)),
        "attn_sinks": nrm((na, SWA_Q_HEADS), 1.0),
        "w_out_att": nrm((na, MIX_WIDTH, D_MODEL), MIX_WIDTH ** -0.5),
        "ffn_norm_g": gain((na, D_MODEL)),
        "w_ffn_gate": nrm((na, D_MODEL, D_FF), D_MODEL ** -0.5),
        "w_ffn_up": nrm((na, D_MODEL, D_FF), D_MODEL ** -0.5),
        "w_ffn_down": nrm((na, D_FF, D_MODEL), D_FF ** -0.5),
        "conv_norm_g": gain((nc, D_MODEL)),
        "w_pw1": nrm((nc, D_MODEL, 2 * D_MODEL), D_MODEL ** -0.5),
        "b_pw1": nrm((nc, 2 * D_MODEL), 0.02),
        "w_dw": nrm((nc, CONV_WIDTH, D_MODEL), CONV_WIDTH ** -0.5),
        "b_dw": nrm((nc, D_MODEL), 0.02),
        "conv_ln_g": gain((nc, D_MODEL)),
        "conv_ln_b": nrm((nc, D_MODEL), 0.02),
        "w_pw2": nrm((nc, D_MODEL, D_MODEL), D_MODEL ** -0.5),
        "b_pw2": nrm((nc, D_MODEL), 0.02),
        "moe_norm_g": gain((nc, D_MODEL)),
        "w_router": nrm((nc, D_MODEL, N_EXPERTS), D_MODEL ** -0.5),
        "w_exp_gate": nrm((nc, N_EXPERTS, D_MODEL, D_FF_EXPERT), D_MODEL ** -0.5),
        "w_exp_up": nrm((nc, N_EXPERTS, D_MODEL, D_FF_EXPERT), D_MODEL ** -0.5),
        "w_exp_down": nrm((nc, N_EXPERTS, D_FF_EXPERT, D_MODEL), D_FF_EXPERT ** -0.5),
        "final_norm_g": gain((D_MODEL,)),
    }


def reference(x, attn_norm_g, w_in_att, diff_lambda, diff_subln_g, attn_sinks, w_out_att,
              ffn_norm_g, w_ffn_gate, w_ffn_up, w_ffn_down,
              conv_norm_g, w_pw1, b_pw1, w_dw, b_dw, conv_ln_g, conv_ln_b, w_pw2, b_pw2,
              moe_norm_g, w_router, w_exp_gate, w_exp_up, w_exp_down, final_norm_g):
    for layer in range(DEPTH):
        i = layer // 2
        if layer % 2 == 0:
            x = x + attention_mixer(x, attn_norm_g[i], w_in_att[i], diff_lambda[i],
                                    diff_subln_g[i], attn_sinks[i], w_out_att[i], layer)
            x = x + swiglu(rms_norm(x, ffn_norm_g[i]), w_ffn_gate[i], w_ffn_up[i], w_ffn_down[i])
        else:
            x = x + conformer_conv(x, conv_norm_g[i], w_pw1[i], b_pw1[i], w_dw[i], b_dw[i],
                                   conv_ln_g[i], conv_ln_b[i], w_pw2[i], b_pw2[i])
            x = x + moe_swiglu(x, moe_norm_g[i], w_router[i], w_exp_gate[i],
                               w_exp_up[i], w_exp_down[i])
    return rms_norm(x, final_norm_g)
```

```cpp
#include <hip/hip_runtime.h>
#include <cstdio>
#include <cstdint>
#include <cmath>
namespace orc {
constexpr int T = 16384, D = 1024, SEQ = 8192, NPROJ = 2304, DFF = 2816, DFE = 3584, NE = 8;

__device__ __forceinline__ float wsum(float v) {
#pragma unroll
    for (int o = 1; o < 64; o <<= 1) v += __shfl_xor(v, o);
    return v;
}
__global__ void __launch_bounds__(256) k_copy(const float4* a, float4* b, size_t n4) {
    size_t i = (size_t)blockIdx.x * 256 + threadIdx.x; if (i < n4) b[i] = a[i];
}
__global__ void __launch_bounds__(256) k_rmsnorm(const float* x, const float* g, float* y, int rows) {
    const int row = blockIdx.x * 4 + (threadIdx.x >> 6), lane = threadIdx.x & 63; if (row >= rows) return;
    const float4* xr = (const float4*)(x + (size_t)row * 1024); const float4* gr = (const float4*)g; float4* yr = (float4*)(y + (size_t)row * 1024);
    float4 v0 = xr[lane], v1 = xr[lane + 64], v2 = xr[lane + 128], v3 = xr[lane + 192];
    float s = v0.x * v0.x + v0.y * v0.y + v0.z * v0.z + v0.w * v0.w + v1.x * v1.x + v1.y * v1.y + v1.z * v1.z + v1.w * v1.w + v2.x * v2.x + v2.y * v2.y + v2.z * v2.z + v2.w * v2.w + v3.x * v3.x + v3.y * v3.y + v3.z * v3.z + v3.w * v3.w;
    s = wsum(s); const float r = 1.0f / sqrtf(s * (1.0f / 1024.0f) + 1e-6f);
    float4 g0 = gr[lane], g1 = gr[lane + 64], g2 = gr[lane + 128], g3 = gr[lane + 192];
    yr[lane] = make_float4(v0.x * r * g0.x, v0.y * r * g0.y, v0.z * r * g0.z, v0.w * r * g0.w);
    yr[lane + 64] = make_float4(v1.x * r * g1.x, v1.y * r * g1.y, v1.z * r * g1.z, v1.w * r * g1.w);
    yr[lane + 128] = make_float4(v2.x * r * g2.x, v2.y * r * g2.y, v2.z * r * g2.z, v2.w * r * g2.w);
    yr[lane + 192] = make_float4(v3.x * r * g3.x, v3.y * r * g3.y, v3.z * r * g3.z, v3.w * r * g3.w);
}
__global__ void __launch_bounds__(256) k_ln_swish(const float* x, const float* g, const float* bb, float* y, int rows) {
    const int row = blockIdx.x * 4 + (threadIdx.x >> 6), lane = threadIdx.x & 63; if (row >= rows) return;
    const float* xr = x + (size_t)row * 1024; float* yr = y + (size_t)row * 1024;
    float v[16]; float s = 0.f;
#pragma unroll
    for (int j = 0; j < 16; ++j) { v[j] = xr[lane + 64 * j]; s += v[j]; }
    const float mu = wsum(s) * (1.0f / 1024.0f); float q = 0.f;
#pragma unroll
    for (int j = 0; j < 16; ++j) { v[j] -= mu; q += v[j] * v[j]; }
    const float r = 1.0f / sqrtf(wsum(q) * (1.0f / 1024.0f) + 1e-5f);
#pragma unroll
    for (int j = 0; j < 16; ++j) { const float t = v[j] * r * g[lane + 64 * j] + bb[lane + 64 * j]; yr[lane + 64 * j] = t / (1.0f + expf(-t)); }
}
struct OG { const float* A; int lda; const int* aidx; const float* W; int ldw; float* C; int ldc; const float* bias; int M, N, K, mode; const int* cntp; int coff; const int* cidx; const float* roww; };
__global__ void __launch_bounds__(256) k_gemm(OG p) {
    __shared__ float As[16][68]; __shared__ float Bs[16][64];
    int M = p.M; if (p.cntp) { const int c = *p.cntp - p.coff; M = c < 0 ? 0 : (c < p.M ? c : p.M); }
    const int m0 = blockIdx.y * 64, n0 = blockIdx.x * 64; if (m0 >= M) return;
    const int tid = threadIdx.x, tx = tid & 15, ty = tid >> 4;
    const int ar = tid >> 2, ak = (tid & 3) * 4; const int arow = m0 + ar; const bool aval = arow < M;
    const size_t asrc = aval ? (p.aidx ? (size_t)p.aidx[p.coff + arow] : (size_t)arow) : 0;
    const float* Ap = p.A + asrc * p.lda + ak;
    const int bk = tid >> 4, bn = (tid & 15) * 4;
    const float* Bp = p.W + (size_t)bk * p.ldw + n0 + bn;
    float acc[4][4];
#pragma unroll
    for (int i = 0; i < 4; ++i)
#pragma unroll
        for (int j = 0; j < 4; ++j) acc[i][j] = 0.f;
    for (int k0 = 0; k0 < p.K; k0 += 16) {
        float4 a = make_float4(0.f, 0.f, 0.f, 0.f); if (aval) a = *(const float4*)(Ap + k0);
        const float4 b = *(const float4*)(Bp + (size_t)k0 * p.ldw);
        As[ak + 0][ar] = a.x; As[ak + 1][ar] = a.y; As[ak + 2][ar] = a.z; As[ak + 3][ar] = a.w;
        *(float4*)&Bs[bk][bn] = b;
        __syncthreads();
#pragma unroll
        for (int kk = 0; kk < 16; ++kk) {
            const float4 av = *(const float4*)&As[kk][ty * 4]; const float4 bv = *(const float4*)&Bs[kk][tx * 4];
            const float aa[4] = {av.x, av.y, av.z, av.w}; const float bq[4] = {bv.x, bv.y, bv.z, bv.w};
#pragma unroll
            for (int i = 0; i < 4; ++i)
#pragma unroll
                for (int j = 0; j < 4; ++j) acc[i][j] += aa[i] * bq[j];
        }
        __syncthreads();
    }
#pragma unroll
    for (int i = 0; i < 4; ++i) {
        const int m = m0 + ty * 4 + i; if (m >= M) continue;
        size_t crow = (size_t)m; float rw = 1.f;
        if (p.mode == 3) { crow = (size_t)p.cidx[p.coff + m]; rw = p.roww[p.coff + m]; }
        float* cp = p.C + crow * p.ldc + n0 + tx * 4;
#pragma unroll
        for (int j = 0; j < 4; ++j) {
            float v = acc[i][j]; if (p.bias) v += p.bias[n0 + tx * 4 + j];
            if (p.mode == 0) cp[j] = v;
            else if (p.mode == 1) cp[j] += v;
            else if (p.mode == 2) { const float gq = cp[j]; cp[j] = gq / (1.0f + expf(-gq)) * v; }
            else cp[j] += rw * v;
        }
    }
}
__global__ void __launch_bounds__(64) k_diffattn(const float* proj, float* mix, const float* lamp, const float* subg, float lam_init) {
    __shared__ float Ks[32][64]; __shared__ float Vs[32][128];
    const int qb = blockIdx.x, h = blockIdx.y, b = blockIdx.z, lane = threadIdx.x;
    const int qpos = qb * 64 + lane; const size_t row = (size_t)b * SEQ + qpos;
    float l0 = 0.f, l1 = 0.f;
    for (int d = 0; d < 64; ++d) { l0 += lamp[d] * lamp[64 + d]; l1 += lamp[128 + d] * lamp[192 + d]; }
    const float lam = expf(l0) - expf(l1) + lam_init;
    float* orow = mix + row * 1024 + h * 128;
    for (int c = 0; c < 2; ++c) {
        float q[64]; float o[128];
        const float* qp = proj + row * NPROJ + h * 128 + c * 64;
#pragma unroll
        for (int d = 0; d < 64; ++d) q[d] = qp[d] * 0.125f;
#pragma unroll
        for (int d = 0; d < 128; ++d) o[d] = 0.f;
        float m = -INFINITY, l = 0.f;
        const int nk = qb * 64 + 64;
        for (int k0 = 0; k0 < nk; k0 += 32) {
            __syncthreads();
            for (int i = 0; i < 32; ++i) {
                const float* kr = proj + ((size_t)b * SEQ + k0 + i) * NPROJ;
                Ks[i][lane] = kr[512 + h * 128 + c * 64 + lane];
                Vs[i][lane] = kr[1024 + h * 128 + lane]; Vs[i][lane + 64] = kr[1024 + h * 128 + 64 + lane];
            }
            __syncthreads();
            for (int j = 0; j < 32; ++j) {
                float s = 0.f;
#pragma unroll
                for (int d = 0; d < 64; ++d) s += q[d] * Ks[j][d];
                if (k0 + j <= qpos) {
                    if (s > m) { const float f = expf(m - s); l *= f;
#pragma unroll
                        for (int d = 0; d < 128; ++d) o[d] *= f;
                        m = s; }
                    const float pp = expf(s - m); l += pp;
#pragma unroll
                    for (int d = 0; d < 128; ++d) o[d] += pp * Vs[j][d];
                }
            }
        }
        const float inv = 1.0f / l;
        if (c == 0) {
#pragma unroll
            for (int d = 0; d < 128; ++d) orow[d] = o[d] * inv;
        } else {
            float ss = 0.f;
#pragma unroll
            for (int d = 0; d < 128; ++d) { o[d] = orow[d] - lam * (o[d] * inv); ss += o[d] * o[d]; }
            const float r = 1.0f / sqrtf(ss * (1.0f / 128.0f) + 1e-6f) * (1.0f - lam_init);
#pragma unroll
            for (int d = 0; d < 128; ++d) orow[d] = o[d] * r * subg[d];
        }
    }
}
__global__ void __launch_bounds__(256) k_swa(const float* proj, float* mix, const float* sinks) {
    const int gid = blockIdx.x * 256 + threadIdx.x; const int hq = gid & 7; const int rowi = gid >> 3; if (rowi >= T) return;
    const int b = rowi / SEQ, qpos = rowi % SEQ, kvh = hq >> 2;
    float q[64], o[64];
    const float* qp = proj + (size_t)rowi * NPROJ + 1536 + hq * 64;
#pragma unroll
    for (int d = 0; d < 64; ++d) { q[d] = qp[d] * 0.125f; o[d] = 0.f; }
    float m = sinks[hq], l = 1.0f;
    const int kstart = qpos - 127 < 0 ? 0 : qpos - 127;
    for (int kp = kstart; kp <= qpos; ++kp) {
        const float* kr = proj + ((size_t)b * SEQ + kp) * NPROJ + 2048 + kvh * 64; const float* vr = kr + 128;
        float s = 0.f;
#pragma unroll
        for (int d = 0; d < 64; ++d) s += q[d] * kr[d];
        if (s > m) { const float f = expf(m - s); l *= f;
#pragma unroll
            for (int d = 0; d < 64; ++d) o[d] *= f;
            m = s; }
        const float pp = expf(s - m); l += pp;
#pragma unroll
        for (int d = 0; d < 64; ++d) o[d] += pp * vr[d];
    }
    const float inv = 1.0f / l; float* op = mix + (size_t)rowi * 1024 + 512 + hq * 64;
#pragma unroll
    for (int d = 0; d < 64; ++d) op[d] = o[d] * inv;
}
__global__ void __launch_bounds__(256) k_glu(const float* ag, float* u) {
    const size_t i = (size_t)blockIdx.x * 256 + threadIdx.x; const size_t t = i >> 10; const int c = (int)(i & 1023);
    const float a = ag[t * 2048 + c], g = ag[t * 2048 + 1024 + c]; u[i] = a / (1.0f + expf(-g));
}
__global__ void __launch_bounds__(256) k_dwconv(const float* u, const float* w, const float* bias, float* out) {
    const size_t i = (size_t)blockIdx.x * 256 + threadIdx.x; const int t = (int)(i >> 10), c = (int)(i & 1023); const int tp = t % SEQ;
    float acc = bias[c];
    for (int k = 0; k < 31; ++k) { const int sp = tp - 30 + k; if (sp >= 0) acc += w[k * 1024 + c] * u[((size_t)(t - 30 + k) << 10) + c]; }
    out[i] = acc;
}
__global__ void __launch_bounds__(256) k_router(const float* h, const float* wr, int* cnt, int* ltok, float* lw) {
    const int row = blockIdx.x * 4 + (threadIdx.x >> 6), lane = threadIdx.x & 63; if (row >= T) return;
    float lg[8];
#pragma unroll
    for (int e = 0; e < 8; ++e) lg[e] = 0.f;
    for (int j = 0; j < 16; ++j) { const int k = lane + 64 * j; const float hv = h[(size_t)row * 1024 + k];
#pragma unroll
        for (int e = 0; e < 8; ++e) lg[e] += hv * wr[k * 8 + e]; }
#pragma unroll
    for (int e = 0; e < 8; ++e) lg[e] = wsum(lg[e]);
    if (lane == 0) {
        int e0 = 0; float b0 = lg[0];
#pragma unroll
        for (int e = 1; e < 8; ++e) if (lg[e] > b0) { b0 = lg[e]; e0 = e; }
        int e1 = -1; float b1 = -INFINITY;
#pragma unroll
        for (int e = 0; e < 8; ++e) if (e != e0 && lg[e] > b1) { b1 = lg[e]; e1 = e; }
        const float w0 = 1.0f / (1.0f + expf(b1 - b0)), w1 = 1.0f - w0;
        const int p0 = atomicAdd(&cnt[e0], 1); ltok[e0 * T + p0] = row; lw[e0 * T + p0] = w0;
        const int p1 = atomicAdd(&cnt[e1], 1); ltok[e1 * T + p1] = row; lw[e1 * T + p1] = w1;
    }
}

constexpr size_t MiB = 1u << 20;
constexpr size_t O_X = 0, O_H = 64 * MiB, O_BIG = 128 * MiB  , O_LST = 272 * MiB  , O_END = 274 * MiB;

static void gemm(hipStream_t st, const float* A, int lda, const int* aidx, const float* W, int ldw, float* C, int ldc, const float* bias, int M, int N, int K, int mode, const int* cntp, int coff, const int* cidx, const float* roww) {
    OG p{}; p.A = A; p.lda = lda; p.aidx = aidx; p.W = W; p.ldw = ldw; p.C = C; p.ldc = ldc; p.bias = bias; p.M = M; p.N = N; p.K = K; p.mode = mode; p.cntp = cntp; p.coff = coff; p.cidx = cidx; p.roww = roww;
    hipLaunchKernelGGL(k_gemm, dim3(N / 64, (M + 63) / 64), dim3(256), 0, st, p);
}
struct In {
    const float *x, *attn_norm_g, *w_in_att, *diff_lambda, *diff_subln_g, *attn_sinks, *w_out_att, *ffn_norm_g, *w_ffn_gate, *w_ffn_up, *w_ffn_down,
        *conv_norm_g, *w_pw1, *b_pw1, *w_dw, *b_dw, *conv_ln_g, *conv_ln_b, *w_pw2, *b_pw2, *moe_norm_g, *w_router, *w_exp_gate, *w_exp_up, *w_exp_down, *final_norm_g;
};
static In make_in(void* const* d_in) { In I; const float** p = (const float**)&I; for (int i = 0; i < 26; ++i) p[i] = (const float*)d_in[i]; return I; }
static float lam_init_of(int layer) { return 0.8f - 0.6f * expf(-0.3f * (float)layer); }

static void sublayer(hipStream_t st, const In& I, unsigned char* base, int sub) {
    float* X = (float*)(base + O_X); float* H = (float*)(base + O_H); float* BIG = (float*)(base + O_BIG);
    int* cnt = (int*)(base + O_LST); int* ltok = cnt + 64; float* lw = (float*)(ltok + NE * T);
    const int layer = sub >> 1, i = layer >> 1;
    if ((layer & 1) == 0) {
        if ((sub & 1) == 0) {
            hipLaunchKernelGGL(k_rmsnorm, dim3(T / 4), dim3(256), 0, st, X, I.attn_norm_g + i * D, H, T);
            float* proj = BIG;
            gemm(st, H, D, nullptr, I.w_in_att + (size_t)i * D * NPROJ, NPROJ, proj, NPROJ, nullptr, T, NPROJ, D, 0, nullptr, 0, nullptr, nullptr);
            float* mix = H;
            hipLaunchKernelGGL(k_diffattn, dim3(SEQ / 64, 4, 2), dim3(64), 0, st, proj, mix, I.diff_lambda + i * 256, I.diff_subln_g + i * 128, lam_init_of(layer));
            hipLaunchKernelGGL(k_swa, dim3(T * 8 / 256), dim3(256), 0, st, proj, mix, I.attn_sinks + i * 8);
            gemm(st, mix, D, nullptr, I.w_out_att + (size_t)i * D * D, D, X, D, nullptr, T, D, D, 1, nullptr, 0, nullptr, nullptr);
        } else {
            hipLaunchKernelGGL(k_rmsnorm, dim3(T / 4), dim3(256), 0, st, X, I.ffn_norm_g + i * D, H, T);
            for (int c = 0; c < 2; ++c) {
                const float* Hc = H + (size_t)c * 8192 * D; float* G = BIG;
                gemm(st, Hc, D, nullptr, I.w_ffn_gate + (size_t)i * D * DFF, DFF, G, DFF, nullptr, 8192, DFF, D, 0, nullptr, 0, nullptr, nullptr);
                gemm(st, Hc, D, nullptr, I.w_ffn_up + (size_t)i * D * DFF, DFF, G, DFF, nullptr, 8192, DFF, D, 2, nullptr, 0, nullptr, nullptr);
                gemm(st, G, DFF, nullptr, I.w_ffn_down + (size_t)i * DFF * D, D, X + (size_t)c * 8192 * D, D, nullptr, 8192, D, DFF, 1, nullptr, 0, nullptr, nullptr);
            }
        }
    } else {
        if ((sub & 1) == 0) {
            hipLaunchKernelGGL(k_rmsnorm, dim3(T / 4), dim3(256), 0, st, X, I.conv_norm_g + i * D, H, T);
            float* ag = BIG;
            gemm(st, H, D, nullptr, I.w_pw1 + (size_t)i * D * 2048, 2048, ag, 2048, I.b_pw1 + i * 2048, T, 2048, D, 0, nullptr, 0, nullptr, nullptr);
            float* u = H;
            hipLaunchKernelGGL(k_glu, dim3(T * 1024 / 256), dim3(256), 0, st, ag, u);
            float* cv = BIG;
            hipLaunchKernelGGL(k_dwconv, dim3(T * 1024 / 256), dim3(256), 0, st, u, I.w_dw + i * 31 * D, I.b_dw + i * D, cv);
            float* v = H;
            hipLaunchKernelGGL(k_ln_swish, dim3(T / 4), dim3(256), 0, st, cv, I.conv_ln_g + i * D, I.conv_ln_b + i * D, v, T);
            gemm(st, v, D, nullptr, I.w_pw2 + (size_t)i * D * D, D, X, D, I.b_pw2 + i * D, T, D, D, 1, nullptr, 0, nullptr, nullptr);
        } else {
            hipLaunchKernelGGL(k_rmsnorm, dim3(T / 4), dim3(256), 0, st, X, I.moe_norm_g + i * D, H, T);
            hipMemsetAsync(cnt, 0, 256, st);
            hipLaunchKernelGGL(k_router, dim3(T / 4), dim3(256), 0, st, H, I.w_router + (size_t)i * D * NE, cnt, ltok, lw);
            float* S = BIG;
            for (int e = 0; e < NE; ++e)
                for (int c = 0; c < 4; ++c) {
                    const size_t wo = ((size_t)i * NE + e) * D * DFE;
                    gemm(st, H, D, ltok + e * T, I.w_exp_gate + wo, DFE, S, DFE, nullptr, 4096, DFE, D, 0, cnt + e, c * 4096, nullptr, nullptr);
                    gemm(st, H, D, ltok + e * T, I.w_exp_up + wo, DFE, S, DFE, nullptr, 4096, DFE, D, 2, cnt + e, c * 4096, nullptr, nullptr);
                    gemm(st, S, DFE, nullptr, I.w_exp_down + wo, D, X, D, nullptr, 4096, D, DFE, 3, cnt + e, c * 4096, ltok + e * T, lw + e * T);
                }
        }
    }
}
}
extern "C" void kernel_launch(void* const* d_in, const int* in_sizes, int n_in, void* d_out, int out_size, void* d_ws, size_t ws_size, hipStream_t stream) {
    if (n_in != 26 || ws_size < orc::O_END) { fprintf(stderr, "kernel_launch: unexpected n_in %d / ws %zu\n", n_in, ws_size); return; }
    const orc::In I = orc::make_in(d_in);
    unsigned char* base = (unsigned char*)d_ws;
    float* X = (float*)(base + orc::O_X);
    hipLaunchKernelGGL(orc::k_copy, dim3(orc::T * orc::D / 4 / 256), dim3(256), 0, stream, (const float4*)I.x, (float4*)X, (size_t)orc::T * orc::D / 4);
    for (int sub = 0; sub < 8; ++sub) orc::sublayer(stream, I, base, sub);
    hipLaunchKernelGGL(orc::k_rmsnorm, dim3(orc::T / 4), dim3(256), 0, stream, (const float*)X, I.final_norm_g, (float*)d_out, orc::T);
}
```

```cpp
#include <hip/hip_runtime.h>
#include <cstdio>
#include <cstdint>
#include <cmath>
namespace pg8 {
#define PG8_LAS __attribute__((address_space(3)))
typedef unsigned short bf16_t;
typedef short bf16x8 __attribute__((ext_vector_type(8)));
typedef float f32x4 __attribute__((ext_vector_type(4)));
typedef unsigned u32x4 __attribute__((ext_vector_type(4)));
typedef int i32x4 __attribute__((ext_vector_type(4)));
typedef int i32x8 __attribute__((ext_vector_type(8)));
typedef float f32x8 __attribute__((ext_vector_type(8)));
constexpr int F8_WSHIFT = 5, F8_W2SHIFT = 6, F8_HSHIFT = 4, F8_XSHIFT = 2, F8_FW2SHIFT = 5;
__host__ __device__ constexpr int f8_scale(int shift) { return (127 - shift) * 0x01010101; }
constexpr int BM = 256, BK = 64, HALF = 128, HTB = HALF * BK * 2  , STAGE_BYTES = 8 * HTB, NXCD = 8, WGM = 8;

__host__ __device__ __forceinline__ int lds_byte(int r, int c) { const int st = (r >> 4) * 2 + (c >> 5), rr = r & 15, cc = c & 31, ob = rr * 64 + cc * 2; return st * 1024 + (ob ^ (((ob >> 9) & 1) << 5)); }
__host__ __device__ __forceinline__ void stage_rc(int b, int& R, int& C) { const int st = b / 1024, sb = b % 1024, swz = sb ^ (((sb >> 9) & 1) << 5); R = (st >> 1) * 16 + swz / 64; C = (st & 1) * 32 + (swz % 64) / 2; }
__host__ __device__ __forceinline__ int perm32(int rho) { const int n = rho >> 4, i = rho & 15; return 8 * (i >> 2) + 4 * n + (i & 3); }

struct Unit { int pm, pn, am; size_t ea, eb; };
struct Gemm { const bf16_t* A; const bf16_t* Bt; int M, N, K, ldk; int f8sw, f8sa; };

struct StaticOrder {
    int nM, nN, nwg, G, c;
    __host__ __device__ void init(int M, int N, int G_, int c_) { nM = M / BM; nN = N / BM; nwg = nM * nN; G = G_; c = c_; }
    __host__ __device__ bool next(int i, Unit& u) const {
        const long L = (long)i * G + c; if (L >= nwg) return false;
        int wgid = (int)L; { const int q = nwg / NXCD, r = nwg % NXCD, xcd = wgid % NXCD, off = wgid / NXCD; wgid = (xcd < r ? xcd * (q + 1) : r * (q + 1) + (xcd - r) * q) + off; }
        const int nig = WGM * nN, gid = wgid / nig, fm = gid * WGM, gsz = (nM - fm) < WGM ? (nM - fm) : WGM;
        u.pm = fm + ((wgid % nig) % gsz); u.pn = (wgid % nig) / gsz; u.am = u.pm; u.ea = 0; u.eb = 0; return true;
    }
    __device__ __forceinline__ void a_ready(const Unit&) const {}
    __device__ __forceinline__ void done(const Unit&) const {}
};

__device__ __forceinline__ unsigned cvt_pk_bf16(float lo, float hi) { unsigned r; asm volatile("v_cvt_pk_bf16_f32 %0, %1, %2" : "=v"(r) : "v"(lo), "v"(hi)); return r; }
__device__ __forceinline__ float sigmoid_fast(float x) { return __builtin_amdgcn_rcpf(1.0f + __builtin_amdgcn_exp2f(-1.4426950408889634f * x)); }

struct MoeOrder {
    StaticOrder so; int cb[7]; size_t estride;
    __device__ __forceinline__ void load_cb(const int* CB) {
#pragma unroll
        for (int e = 0; e < 7; ++e) cb[e] = __builtin_amdgcn_readfirstlane(CB[e]); }
    __device__ __forceinline__ int expert_of(int pm) const { int e = 0;
#pragma unroll
        for (int j = 0; j < 7; ++j) e += (pm >= cb[j]) ? 1 : 0;
        return e; }
    __device__ bool next(int i, Unit& u) const { if (!so.next(i, u)) return false; u.eb = (size_t)expert_of(u.pm) * estride; return true; }
    __device__ __forceinline__ void a_ready(const Unit&) const {}
    __device__ __forceinline__ void done(const Unit&) const {}
};

struct TailOrder {
    int nsu, G, c, nfc, KS, kslice; int cb[7]; size_t estride;
    __device__ bool next(int i, Unit& u) const {
        const int L = i * G + c; if (L >= nsu) return false;
        const int ks = L % KS, r = L / KS, pn = r & 3, tc = r >> 2;
        u.pm = ks * 8 + tc; u.pn = pn; u.am = nfc + tc; u.ea = (size_t)ks * kslice * 2; int e = 0;
#pragma unroll
        for (int j = 0; j < 7; ++j) e += (nfc + tc >= cb[j]) ? 1 : 0;
        u.eb = (size_t)e * estride + (size_t)ks * kslice * 2; return true;
    }
    __device__ __forceinline__ void a_ready(const Unit&) const {}
    __device__ __forceinline__ void done(const Unit&) const {}
};

__device__ __forceinline__ float row_rstd(const float* ssq4, int row, float inv_n, float eps) {
    const f32x4 a = *(const f32x4*)(ssq4 + (size_t)row * 4);
    return 1.0f / sqrtf(((a[0] + a[1]) + (a[2] + a[3])) * inv_n + eps);
}
struct EpiProj {
    static constexpr bool PERM = true, AFTER_DRAIN = false;
    bf16_t* O; int ldc; unsigned smask; float sc; const float* ssq4; float inv_n, eps;
    __device__ __forceinline__ void operator()(const f32x4 (&acc)[2][2][4][2], const Unit& u, int wr, int wc, int fr, int fq) const {
        const int row0 = u.pm * BM + wr * 64 + fr, col0 = u.pn * BM + wc * 32 + 8 * fq; const float s = ((smask >> u.pn) & 1u) ? sc : 1.f;
#pragma unroll
        for (int ai = 0; ai < 2; ++ai)
#pragma unroll
            for (int m = 0; m < 4; ++m) { const int row = row0 + ai * HALF + m * 16; bf16_t* rowp = O + (size_t)row * ldc + col0; const float rs = ssq4 ? s * row_rstd(ssq4, row, inv_n, eps) : s;
#pragma unroll
                for (int bj = 0; bj < 2; ++bj) { const f32x4 v0 = acc[ai][bj][m][0] * rs, v1 = acc[ai][bj][m][1] * rs;
                    u32x4 w; w.x = cvt_pk_bf16(v0[0], v0[1]); w.y = cvt_pk_bf16(v0[2], v0[3]); w.z = cvt_pk_bf16(v1[0], v1[1]); w.w = cvt_pk_bf16(v1[2], v1[3]);
                    *(u32x4*)(rowp + bj * HALF) = w; } }
    }
};
struct EpiSwiglu {
    static constexpr bool PERM = true, AFTER_DRAIN = false;
    bf16_t* O; int ldc; const float* ssq4; float inv_n, eps; float f8s;
    __device__ __forceinline__ void operator()(const f32x4 (&acc)[2][2][4][2], const Unit& u, int wr, int wc, int fr, int fq) const {
        const int row0 = u.pm * BM + wr * 64 + fr, col0 = u.pn * HALF + wc * 32 + 8 * fq;
#pragma unroll
        for (int ai = 0; ai < 2; ++ai)
#pragma unroll
            for (int m = 0; m < 4; ++m) { const int row = row0 + ai * HALF + m * 16; bf16_t* rowp = O + (size_t)row * ldc + col0; const float rs = ssq4 ? row_rstd(ssq4, row, inv_n, eps) : 1.0f;
                float h[8];
#pragma unroll
                for (int n = 0; n < 2; ++n)
#pragma unroll
                    for (int i = 0; i < 4; ++i) { const float g = acc[ai][0][m][n][i] * rs, up = acc[ai][1][m][n][i] * rs; h[4 * n + i] = g * sigmoid_fast(g) * up; }
                if (f8s != 0.f) { typedef unsigned u32x2 __attribute__((ext_vector_type(2)));
#pragma unroll
                    for (int i = 0; i < 8; ++i) h[i] = __builtin_amdgcn_fmed3f(h[i] * f8s, -400.f, 400.f);
                    int w0 = __builtin_amdgcn_cvt_pk_fp8_f32(h[0], h[1], 0, false); w0 = __builtin_amdgcn_cvt_pk_fp8_f32(h[2], h[3], w0, true);
                    int w1 = __builtin_amdgcn_cvt_pk_fp8_f32(h[4], h[5], 0, false); w1 = __builtin_amdgcn_cvt_pk_fp8_f32(h[6], h[7], w1, true);
                    *(u32x2*)((unsigned char*)O + (size_t)row * ldc + col0) = (u32x2){(unsigned)w0, (unsigned)w1}; }
                else {
                u32x4 w; w.x = cvt_pk_bf16(h[0], h[1]); w.y = cvt_pk_bf16(h[2], h[3]); w.z = cvt_pk_bf16(h[4], h[5]); w.w = cvt_pk_bf16(h[6], h[7]);
                *(u32x4*)rowp = w; } }
    }
};
struct EpiGlu {
    static constexpr bool PERM = true, AFTER_DRAIN = false;
    bf16_t* O; int ldc; const float* bias; int nh; const float* ssq4; float inv_n, eps;
    __device__ __forceinline__ void operator()(const f32x4 (&acc)[2][2][4][2], const Unit& u, int wr, int wc, int fr, int fq) const {
        const int row0 = u.pm * BM + wr * 64 + fr, col0 = u.pn * HALF + wc * 32 + 8 * fq;
        const f32x4 ba0 = *(const f32x4*)(bias + col0), ba1 = *(const f32x4*)(bias + col0 + 4), bg0 = *(const f32x4*)(bias + nh + col0), bg1 = *(const f32x4*)(bias + nh + col0 + 4);
#pragma unroll
        for (int ai = 0; ai < 2; ++ai)
#pragma unroll
            for (int m = 0; m < 4; ++m) { const int row = row0 + ai * HALF + m * 16; bf16_t* rowp = O + (size_t)row * ldc + col0; const float rs = ssq4 ? row_rstd(ssq4, row, inv_n, eps) : 1.0f;
                const f32x4 a0 = acc[ai][0][m][0] * rs + ba0, a1 = acc[ai][0][m][1] * rs + ba1, g0 = acc[ai][1][m][0] * rs + bg0, g1 = acc[ai][1][m][1] * rs + bg1;
                float h[8];
#pragma unroll
                for (int i = 0; i < 4; ++i) { h[i] = a0[i] * sigmoid_fast(g0[i]); h[4 + i] = a1[i] * sigmoid_fast(g1[i]); }
                u32x4 w; w.x = cvt_pk_bf16(h[0], h[1]); w.y = cvt_pk_bf16(h[2], h[3]); w.z = cvt_pk_bf16(h[4], h[5]); w.w = cvt_pk_bf16(h[6], h[7]);
                *(u32x4*)rowp = w; }
    }
};
struct EpiResX {
    static constexpr bool PERM = false, AFTER_DRAIN = true;
    const bf16_t* baseb; const float* basef; bf16_t* out; int ldc; const float* bias; float* ssq4; unsigned char* x8; float x8s;
    __device__ __forceinline__ void fused(f32x4 (&acc)[2][2][4][2], const Unit& u, int wr, int wc, int fr, int fq, PG8_LAS unsigned char* lds, int wid, int lane) const {
        typedef unsigned u32x2 __attribute__((ext_vector_type(2)));
        PG8_LAS float* P = (PG8_LAS float*)lds;
        const int col0 = u.pn * BM + wc * 32 + 4 * fq;
        f32x4 bv[2][2];
#pragma unroll
        for (int bj = 0; bj < 2; ++bj)
#pragma unroll
            for (int n = 0; n < 2; ++n) bv[bj][n] = bias ? *(const f32x4*)(bias + col0 + bj * HALF + n * 16) : (f32x4){0.f, 0.f, 0.f, 0.f};
#pragma unroll
        for (int ai = 0; ai < 2; ++ai) {
            f32x4 bs[4][2][2];
            if (basef) {
#pragma unroll
                for (int m = 0; m < 4; ++m) { const size_t off = (size_t)(u.pm * BM + ai * HALF + wr * 64 + m * 16 + fr) * ldc + col0;
#pragma unroll
                    for (int bj = 0; bj < 2; ++bj)
#pragma unroll
                        for (int n = 0; n < 2; ++n) bs[m][bj][n] = *(const f32x4*)(basef + off + bj * HALF + n * 16); }
            } else {
                u32x2 bw[4][2][2];
#pragma unroll
                for (int m = 0; m < 4; ++m) { const size_t off = (size_t)(u.pm * BM + ai * HALF + wr * 64 + m * 16 + fr) * ldc + col0;
#pragma unroll
                    for (int bj = 0; bj < 2; ++bj)
#pragma unroll
                        for (int n = 0; n < 2; ++n) bw[m][bj][n] = *(const u32x2*)(baseb + off + bj * HALF + n * 16); }
#pragma unroll
                for (int m = 0; m < 4; ++m)
#pragma unroll
                    for (int bj = 0; bj < 2; ++bj)
#pragma unroll
                        for (int n = 0; n < 2; ++n) { const u32x2 w = bw[m][bj][n]; bs[m][bj][n] = (f32x4){__uint_as_float(w.x << 16), __uint_as_float(w.x & 0xffff0000u), __uint_as_float(w.y << 16), __uint_as_float(w.y & 0xffff0000u)}; }
            }
#pragma unroll
            for (int m = 0; m < 4; ++m) { const int rl = ai * HALF + wr * 64 + m * 16 + fr; const size_t off = (size_t)(u.pm * BM + rl) * ldc + col0; float ss = 0.f;
#pragma unroll
                for (int bj = 0; bj < 2; ++bj)
#pragma unroll
                    for (int n = 0; n < 2; ++n) { const f32x4 o = bs[m][bj][n] + acc[ai][bj][m][n] + bv[bj][n]; u32x2 w; w.x = cvt_pk_bf16(o[0], o[1]); w.y = cvt_pk_bf16(o[2], o[3]); *(u32x2*)(out + off + bj * HALF + n * 16) = w;
                        const float r0 = __uint_as_float(w.x << 16), r1 = __uint_as_float(w.x & 0xffff0000u), r2 = __uint_as_float(w.y << 16), r3 = __uint_as_float(w.y & 0xffff0000u); ss += (r0 * r0 + r1 * r1) + (r2 * r2 + r3 * r3);
                        if (x8) { int q8 = __builtin_amdgcn_cvt_pk_fp8_f32(__builtin_amdgcn_fmed3f(r0 * x8s, -440.f, 440.f), __builtin_amdgcn_fmed3f(r1 * x8s, -440.f, 440.f), 0, false); q8 = __builtin_amdgcn_cvt_pk_fp8_f32(__builtin_amdgcn_fmed3f(r2 * x8s, -440.f, 440.f), __builtin_amdgcn_fmed3f(r3 * x8s, -440.f, 440.f), q8, true);     *(int*)(x8 + off + bj * HALF + n * 16) = q8; } }
                ss += __shfl_xor(ss, 16); ss += __shfl_xor(ss, 32);
                if (fq == 0) P[rl * 4 + wc] = ss; }
            asm volatile("" ::: "memory"); }
        asm volatile("s_waitcnt lgkmcnt(0)" ::: "memory"); __builtin_amdgcn_s_barrier(); asm volatile("" ::: "memory");
        const int tid = wid * 64 + lane;
        if (tid < 256) { const f32x4 q = *(const PG8_LAS f32x4*)(P + tid * 4); ssq4[(size_t)(u.pm * BM + tid) * 4 + u.pn] = (q[0] + q[1]) + (q[2] + q[3]); }
    }
};

template <class Epi, class Sched, bool ALIGN_EPI = false, bool SP2 = false, bool F8 = false>
__device__ __forceinline__ void gemm_phase(PG8_LAS unsigned char* lds, const Gemm g, const Sched& S, const Epi& E, const int wid_in  ) {
    int lane_ = (int)__builtin_amdgcn_mbcnt_hi(~0u, __builtin_amdgcn_mbcnt_lo(~0u, 0u)); asm volatile("" : "+v"(lane_));
    const int wid = wid_in, lane = lane_, tid = wid * 64 + lane, wr = wid >> 2, wc = wid & 3, fr = lane & 15, fq = lane >> 4;
    const int K = g.ldk, nt = g.K / BK;
    unsigned voffA[2], voffB[2];
#pragma unroll
    for (int i = 0; i < 2; ++i) { int R, C; stage_rc(tid * 16 + i * 8192, R, C); const int Rb = Epi::PERM ? ((R & ~31) + perm32(R & 31)) : R;
        voffA[i] = (unsigned)(R * K + C) * 2u; voffB[i] = (unsigned)(Rb * K + C) * 2u; }
    const size_t kstep = (size_t)(BK * 2);
    const size_t hstep = (size_t)HALF * K * 2;
    const size_t tstep = 2 * hstep;
    const unsigned ldsw = (unsigned)wid * 1024u;
    const int fcol = fq * 8;
    const int aoff = lds_byte(wr * 64 + fr, fcol), boff = lds_byte(wc * 32 + fr, fcol);
#define PG8_SA(b, h) (((b) * 2 + (h)) * HTB)
#define PG8_SB(b, h) ((4 + (b) * 2 + (h)) * HTB)
#define PG8_STAGE(bufoff, gbase, voff) do { _Pragma("unroll") for (int _i = 0; _i < 2; ++_i) \
        __builtin_amdgcn_global_load_lds((const unsigned*)((const char*)(gbase) + (voff)[_i]), (PG8_LAS unsigned*)(lds + (bufoff) + ldsw + _i * 8192), 16, 0, 0); } while (0)
#define PG8_LD32(base_) __builtin_shufflevector(__builtin_bit_cast(i32x4, *(const PG8_LAS bf16x8*)(base_)), __builtin_bit_cast(i32x4, *(const PG8_LAS bf16x8*)((base_) + 1024)), 0, 1, 2, 3, 4, 5, 6, 7)
#define PG8_LDA(dst, b, h) do { if constexpr (F8) { _Pragma("unroll") for (int m = 0; m < 4; ++m) dst##_8[m] = PG8_LD32(lds + PG8_SA(b, h) + aoff + m * 2048); } \
        else { _Pragma("unroll") for (int m = 0; m < 4; ++m) _Pragma("unroll") for (int k = 0; k < 2; ++k) dst[m][k] = *(const PG8_LAS bf16x8*)(lds + PG8_SA(b, h) + aoff + m * 2048 + k * 1024); } } while (0)
#define PG8_LDB(dst, b, h) do { if constexpr (F8) { _Pragma("unroll") for (int n = 0; n < 2; ++n) dst##_8[n] = PG8_LD32(lds + PG8_SB(b, h) + boff + n * 2048); } \
        else { _Pragma("unroll") for (int n = 0; n < 2; ++n) _Pragma("unroll") for (int k = 0; k < 2; ++k) dst[n][k] = *(const PG8_LAS bf16x8*)(lds + PG8_SB(b, h) + boff + n * 2048 + k * 1024); } } while (0)
#define PG8_MMA(ai, bj, At, Bt) do { __builtin_amdgcn_s_setprio(1); \
        if constexpr (F8) { _Pragma("unroll") for (int m = 0; m < 4; ++m) _Pragma("unroll") for (int n = 0; n < 2; ++n) \
            asm volatile("v_mfma_scale_f32_16x16x128_f8f6f4 %0, %1, %2, %0, %3, %4 op_sel_hi:[0,0,0]" : "+v"(acc[ai][bj][m][n]) : "v"(Bt##_8[n]), "v"(At##_8[m]), "v"(f8sw), "v"(f8sa)); } \
        else { _Pragma("unroll") for (int m = 0; m < 4; ++m) _Pragma("unroll") for (int n = 0; n < 2; ++n) _Pragma("unroll") for (int k = 0; k < 2; ++k) \
            acc[ai][bj][m][n] = __builtin_amdgcn_mfma_f32_16x16x32_bf16(Bt[n][k], At[m][k], acc[ai][bj][m][n], 0, 0, 0); } \
        __builtin_amdgcn_s_setprio(0); } while (0)
#define PG8_WAIT_V(n) asm volatile("s_waitcnt vmcnt(" #n ")" ::: "memory")
#define PG8_WAIT_L(n) asm volatile("s_waitcnt lgkmcnt(" #n ")" ::: "memory")
#define PG8_BAR __builtin_amdgcn_s_barrier()
#define PG8_SCHED __builtin_amdgcn_sched_barrier(0)
    Unit cur, nxt; int ui = 0;
    if (!S.next(0, cur)) return;
    f32x4 acc[2][2][4][2];
#pragma unroll
    for (int a = 0; a < 2; ++a)
#pragma unroll
        for (int b = 0; b < 2; ++b)
#pragma unroll
            for (int m = 0; m < 4; ++m)
#pragma unroll
                for (int n = 0; n < 2; ++n) acc[a][b][m][n] = (f32x4){0.f, 0.f, 0.f, 0.f};
    int f8sw = g.f8sw, f8sa = g.f8sa; (void)f8sw; (void)f8sa;
    bf16x8 At[4][2], B0[2][2], B1[2][2]; i32x8 At_8[4], B0_8[2], B1_8[2];
    const char* cA = (const char*)g.A + (size_t)cur.am * tstep + cur.ea; const char* cB = (const char*)g.Bt + (size_t)cur.pn * tstep + cur.eb;
    S.a_ready(cur);
    if constexpr (SP2) {
        PG8_STAGE(PG8_SB(0, 0), cB, voffB); PG8_STAGE(PG8_SB(0, 1), cB + hstep, voffB); PG8_STAGE(PG8_SA(0, 0), cA, voffA); PG8_STAGE(PG8_SA(0, 1), cA + hstep, voffA);
        if (wr == 1) PG8_BAR;
        PG8_WAIT_V(2); PG8_BAR;
        PG8_STAGE(PG8_SB(1, 0), cB + kstep, voffB); PG8_STAGE(PG8_SA(1, 0), cA + kstep, voffA); PG8_STAGE(PG8_SB(1, 1), cB + hstep + kstep, voffB);
        PG8_WAIT_V(6); PG8_BAR;
    } else {
        PG8_STAGE(PG8_SB(0, 0), cB, voffB); PG8_STAGE(PG8_SA(0, 0), cA, voffA); PG8_STAGE(PG8_SB(0, 1), cB + hstep, voffB); PG8_STAGE(PG8_SA(0, 1), cA + hstep, voffA);
        if (wr == 1) PG8_BAR;
        PG8_WAIT_V(4); PG8_BAR;
        PG8_STAGE(PG8_SB(1, 0), cB + kstep, voffB); PG8_STAGE(PG8_SA(1, 0), cA + kstep, voffA); PG8_STAGE(PG8_SB(1, 1), cB + hstep + kstep, voffB);
        PG8_WAIT_V(6); PG8_BAR;
    }
    for (;;) {
        const bool has_next = S.next(ui + 1, nxt);
        const char* nA = has_next ? (const char*)g.A + (size_t)nxt.am * tstep + nxt.ea : cA; const char* nB = has_next ? (const char*)g.Bt + (size_t)nxt.pn * tstep + nxt.eb : cB;
        for (int t = 0; t < nt; t += 2) {
            const bool last = (t == nt - 2);
            const char* a1 = cA + (size_t)(t + 1) * kstep;
            const char* a2 = last ? nA : cA + (size_t)(t + 2) * kstep; const char* b2 = last ? nB : cB + (size_t)(t + 2) * kstep;
            const char* a3 = a2 + kstep; const char* b3 = b2 + kstep;
            if (last && has_next) S.a_ready(nxt);
            if constexpr (SP2) {
            PG8_LDB(B0, 0, 0); PG8_LDB(B1, 0, 1); PG8_SCHED; PG8_LDA(At, 0, 0); PG8_STAGE(PG8_SA(1, 1), a1 + hstep, voffA);
            PG8_WAIT_V(8); PG8_WAIT_L(0); PG8_BAR; PG8_MMA(0, 0, At, B0); PG8_MMA(0, 1, At, B1); PG8_BAR; PG8_SCHED;
            PG8_LDA(At, 0, 1); PG8_STAGE(PG8_SB(0, 0), b2, voffB); PG8_STAGE(PG8_SB(0, 1), b2 + hstep, voffB); PG8_STAGE(PG8_SA(0, 0), a2, voffA);
            PG8_WAIT_V(8); PG8_WAIT_L(0); PG8_BAR; PG8_MMA(1, 0, At, B0); PG8_MMA(1, 1, At, B1); PG8_BAR; PG8_SCHED;
            PG8_LDB(B0, 1, 0); PG8_LDB(B1, 1, 1); PG8_SCHED; PG8_LDA(At, 1, 0); PG8_STAGE(PG8_SA(0, 1), a2 + hstep, voffA);
            PG8_WAIT_V(8); PG8_WAIT_L(0); PG8_BAR; PG8_MMA(0, 0, At, B0); PG8_MMA(0, 1, At, B1); PG8_BAR; PG8_SCHED;
            PG8_LDA(At, 1, 1); PG8_STAGE(PG8_SB(1, 0), b3, voffB); PG8_STAGE(PG8_SB(1, 1), b3 + hstep, voffB); PG8_STAGE(PG8_SA(1, 0), a3, voffA);
            PG8_WAIT_V(8); PG8_WAIT_L(0); PG8_BAR; PG8_MMA(1, 0, At, B0); PG8_MMA(1, 1, At, B1); PG8_BAR; PG8_SCHED;
            } else {
            PG8_LDB(B0, 0, 0); PG8_SCHED; PG8_LDA(At, 0, 0); PG8_STAGE(PG8_SA(1, 1), a1 + hstep, voffA);
            PG8_WAIT_L(8); PG8_BAR; PG8_WAIT_L(0); PG8_MMA(0, 0, At, B0); PG8_BAR; PG8_SCHED;
            PG8_LDB(B1, 0, 1); PG8_STAGE(PG8_SB(0, 0), b2, voffB);
            PG8_BAR; PG8_WAIT_L(0); PG8_MMA(0, 1, At, B1); PG8_BAR;
            PG8_LDA(At, 0, 1); PG8_STAGE(PG8_SA(0, 0), a2, voffA);
            PG8_BAR; PG8_WAIT_L(0); PG8_MMA(1, 0, At, B0); PG8_BAR; PG8_SCHED;
            PG8_STAGE(PG8_SB(0, 1), b2 + hstep, voffB);
            PG8_WAIT_V(6); PG8_BAR; PG8_MMA(1, 1, At, B1); PG8_BAR;
            PG8_LDB(B0, 1, 0); PG8_SCHED; PG8_LDA(At, 1, 0); PG8_STAGE(PG8_SA(0, 1), a2 + hstep, voffA);
            PG8_WAIT_L(8); PG8_BAR; PG8_WAIT_L(0); PG8_MMA(0, 0, At, B0); PG8_BAR; PG8_SCHED;
            PG8_LDB(B1, 1, 1); PG8_STAGE(PG8_SB(1, 0), b3, voffB);
            PG8_BAR; PG8_WAIT_L(0); PG8_MMA(0, 1, At, B1); PG8_BAR;
            PG8_LDA(At, 1, 1); PG8_STAGE(PG8_SA(1, 0), a3, voffA);
            PG8_BAR; PG8_WAIT_L(0); PG8_MMA(1, 0, At, B0); PG8_BAR; PG8_SCHED;
            PG8_STAGE(PG8_SB(1, 1), b3 + hstep, voffB);
            PG8_WAIT_V(6); PG8_BAR; PG8_MMA(1, 1, At, B1); PG8_BAR;
            }
        }
        if constexpr (F8) asm volatile("s_nop 15\n\ts_nop 7" ::: "memory");
        if constexpr (ALIGN_EPI) { if (wr == 0) PG8_BAR; }
        if constexpr (!Epi::AFTER_DRAIN) { E(acc, cur, wr, wc, fr, fq); S.done(cur); }
        if (!has_next) break;
#pragma unroll
        for (int a = 0; a < 2; ++a)
#pragma unroll
            for (int b = 0; b < 2; ++b)
#pragma unroll
                for (int m = 0; m < 4; ++m)
#pragma unroll
                    for (int n = 0; n < 2; ++n) acc[a][b][m][n] = (f32x4){0.f, 0.f, 0.f, 0.f};
        cur = nxt; cA = nA; cB = nB; ++ui;
        if constexpr (ALIGN_EPI) { if (wr == 1) PG8_BAR; }
    }
    PG8_WAIT_V(0);
    if constexpr (!ALIGN_EPI) { if (wr == 0) PG8_BAR; }
    PG8_BAR;
    if constexpr (Epi::AFTER_DRAIN) { E.fused(acc, cur, wr, wc, fr, fq, lds, wid, lane); S.done(cur); }
#undef PG8_SA
#undef PG8_SB
#undef PG8_STAGE
#undef PG8_LDA
#undef PG8_LDB
#undef PG8_MMA
#undef PG8_LD32
#undef PG8_WAIT_V
#undef PG8_WAIT_L
#undef PG8_BAR
#undef PG8_SCHED
}
}
#include <hip/hip_bf16.h>
#include <cmath>
namespace attn_body {
using bf16=__hip_bfloat16;
using bf16x8=__attribute__((ext_vector_type(8)))short;
using s16x4=__attribute__((ext_vector_type(4)))short;
using f32x16=__attribute__((ext_vector_type(16)))float;
using u32x4=__attribute__((ext_vector_type(4)))unsigned;
constexpr int BATCH=2,SEQ=8192,D=64,DM=2304,DMO=1024;
constexpr int NW=8,QBLK=32,QB=QBLK*NW,KVBLK=64,NQB=SEQ/QB;
constexpr int ATTN_UNIT_ROWS=QB;
__device__ __forceinline__ int crow(int r,int hi){return (r&3)+8*(r>>2)+4*hi;}
#define SBAR() __builtin_amdgcn_sched_barrier(0)
__device__ __forceinline__ void cmask(f32x16&p0,f32x16&p1,int jb,int qrel,int hi){
  const float NEG=-INFINITY; int kb=64*jb+4*hi;
  #pragma unroll
  for(int r=0;r<16;++r){int kv=kb+(r&3)+8*(r>>2); if(kv>qrel)p0[r]=NEG; if(kv+32>qrel)p1[r]=NEG;}
}

constexpr int NSLOT=3, SLOTB=8192;
constexpr int LDS_K=0, LDS_V=NSLOT*SLOTB, LDS_WS=2*NSLOT*SLOTB, LDS_OST=LDS_WS+NW*64*4, LDS_BYTES=LDS_OST+NW*4096;
constexpr float C2=0.125f*1.4426950408889634f;
__device__ __forceinline__ void glds16(const void*sbase,unsigned voff,unsigned lds_dst){unsigned keep;
  asm volatile("s_mov_b32 %0, m0\n\ts_mov_b32 m0, %2\n\ts_nop 0\n\tglobal_load_lds_dwordx4 %1, %3\n\ts_mov_b32 m0, %0":"=&s"(keep):"v"(voff),"s"(lds_dst),"s"(sbase):"memory");}
__device__ __forceinline__ float max3f(float a,float b,float c){float r;asm("v_max3_f32 %0, %1, %2, %3":"=v"(r):"v"(a),"v"(b),"v"(c));return r;}
__device__ __forceinline__ float max2f(float a,float b){float r;asm("v_max_f32_e32 %0, %1, %2":"=v"(r):"v"(a),"v"(b));return r;}
__device__ __forceinline__ float fadd_s(float a,float b){float r;asm("v_add_f32_e32 %0, %1, %2":"=v"(r):"v"(a),"v"(b));return r;}
__device__ __forceinline__ float fsub_s(float a,float b){float r;asm("v_sub_f32_e32 %0, %1, %2":"=v"(r):"v"(a),"v"(b));return r;}
typedef float f32x2_t __attribute__((ext_vector_type(2))); typedef __bf16 bf16x2_t __attribute__((ext_vector_type(2)));
__device__ __forceinline__ unsigned cvtpk_s(float lo,float hi){f32x2_t v={lo,hi};bf16x2_t b=__builtin_convertvector(v,bf16x2_t);return __builtin_bit_cast(unsigned,b);}
#define WAIT_BAR(N) asm volatile("s_waitcnt vmcnt(" #N ") lgkmcnt(0)\n\ts_barrier":::"memory")

__device__ __forceinline__ void swmask(f32x16&p0,f32x16&p1,int tl,int ql,int hi){
  const float NEG=-INFINITY; int kb=64*tl+4*hi;
  #pragma unroll
  for(int r=0;r<16;++r){int kv=kb+(r&3)+8*(r>>2); if(kv>ql||kv+128<=ql)p0[r]=NEG; if(kv+32>ql||kv+160<=ql)p1[r]=NEG;}
}
__device__ __forceinline__ void qkt(f32x16&p0,f32x16&p1,const char*Kslot,const bf16x8*qr,const f32x16&negm,int r32,int hi){
  const char*kb=Kslot+hi*1024+r32*16;
  #pragma unroll
  for(int d0=0;d0<4;++d0){
    const bf16x8 b0=*reinterpret_cast<const bf16x8*>(kb+d0*2048);
    const bf16x8 b1=*reinterpret_cast<const bf16x8*>(kb+d0*2048+512);
    if(d0==0){p0=__builtin_amdgcn_mfma_f32_32x32x16_bf16(b0,qr[0],negm,0,0,0);p1=__builtin_amdgcn_mfma_f32_32x32x16_bf16(b1,qr[0],negm,0,0,0);}
    else{p0=__builtin_amdgcn_mfma_f32_32x32x16_bf16(b0,qr[d0],p0,0,0,0);p1=__builtin_amdgcn_mfma_f32_32x32x16_bf16(b1,qr[d0],p1,0,0,0);}}
}
typedef __attribute__((address_space(3))) const char* lds_cptr;
typedef short v4i16_t __attribute__((ext_vector_type(4)));
__device__ __forceinline__ void kload8(bf16x8*kf,lds_cptr kp){
  kf[0]=*(const __attribute__((address_space(3))) bf16x8*)(kp);      kf[1]=*(const __attribute__((address_space(3))) bf16x8*)(kp+512);
  kf[2]=*(const __attribute__((address_space(3))) bf16x8*)(kp+2048); kf[3]=*(const __attribute__((address_space(3))) bf16x8*)(kp+2560);
  kf[4]=*(const __attribute__((address_space(3))) bf16x8*)(kp+4096); kf[5]=*(const __attribute__((address_space(3))) bf16x8*)(kp+4608);
  kf[6]=*(const __attribute__((address_space(3))) bf16x8*)(kp+6144); kf[7]=*(const __attribute__((address_space(3))) bf16x8*)(kp+6656);
}
__device__ __forceinline__ void kload2(bf16x8*kf,lds_cptr kp,int j){ kf[2*j]=*(const __attribute__((address_space(3))) bf16x8*)(kp+j*2048); kf[2*j+1]=*(const __attribute__((address_space(3))) bf16x8*)(kp+j*2048+512); }
__device__ __forceinline__ s16x4 vtr(lds_cptr p){ return __builtin_bit_cast(s16x4,__builtin_amdgcn_ds_read_tr16_b64_v4i16((__attribute__((address_space(3))) v4i16_t*)p)); }
__device__ __forceinline__ float rowmax(const f32x16&p0,const f32x16&p1){
  float a=max3f(p0[0],p0[1],p1[0]),b=max3f(p0[2],p0[3],p1[1]);a=max3f(a,p1[2],p1[3]);
  #pragma unroll
  for(int r=4;r<16;r+=4){a=max3f(a,p0[r],p0[r+1]);b=max3f(b,p0[r+2],p0[r+3]);a=max3f(a,p1[r],p1[r+1]);b=max3f(b,p1[r+2],p1[r+3]);}
  const float m=max2f(a,b);
  auto rr=__builtin_amdgcn_permlane32_swap(__float_as_uint(m),__float_as_uint(m),false,false);
  return max2f(__uint_as_float(rr[0]),__uint_as_float(rr[1]));
}
__device__ __forceinline__ void pv(f32x16*o,int vb,bf16x8 pa0,bf16x8 pa1,bf16x8 pa2,bf16x8 pa3){
  #pragma unroll
  for(int d0=0;d0<2;++d0){s16x4 lo[4],hi[4];
    #pragma unroll
    for(int ks=0;ks<4;++ks){
      asm volatile("ds_read_b64_tr_b16 %0,%1 offset:%c2":"=&v"(lo[ks]):"v"(vb),"i"(d0*4096+ks*1024):"memory");
      asm volatile("ds_read_b64_tr_b16 %0,%1 offset:%c2":"=&v"(hi[ks]):"v"(vb),"i"(d0*4096+ks*1024+512):"memory");}
    asm volatile("s_waitcnt lgkmcnt(0)":::"memory");SBAR();
    #define PK(k) (bf16x8){lo[k][0],lo[k][1],lo[k][2],lo[k][3],hi[k][0],hi[k][1],hi[k][2],hi[k][3]}
    o[d0]=__builtin_amdgcn_mfma_f32_32x32x16_bf16(pa0,PK(0),o[d0],0,0,0);
    o[d0]=__builtin_amdgcn_mfma_f32_32x32x16_bf16(pa1,PK(1),o[d0],0,0,0);
    o[d0]=__builtin_amdgcn_mfma_f32_32x32x16_bf16(pa2,PK(2),o[d0],0,0,0);
    o[d0]=__builtin_amdgcn_mfma_f32_32x32x16_bf16(pa3,PK(3),o[d0],0,0,0);
    #undef PK
  }
}

#ifndef ATTN_STORE16
#define ATTN_STORE16(p,v) (*(u32x4*)(p)=(v))
#endif
template<int THRL,bool SWA> __device__ __forceinline__ void attn_unit(int qb,const bf16*Q,const bf16*__restrict__ K,const bf16*__restrict__ V,bf16*O,float sink2,char*shm,const int wid_in){
  int lane_=(int)__builtin_amdgcn_mbcnt_hi(~0u,__builtin_amdgcn_mbcnt_lo(~0u,0u)); asm volatile("":"+v"(lane_));
  const int wid=wid_in,lane=lane_,tid=wid*64+lane,r32=lane&31,hi=lane>>5; (void)tid;
  const int q0=qb*QB; const int t_lo=SWA?((q0>=128)?(q0/KVBLK-2):0):0;
  const bf16*Qw=Q+(long)(q0+wid*QBLK)*DM;
  const bf16*Kh=K+(long)t_lo*KVBLK*DM,*Vh=V+(long)t_lo*KVBLK*DM;
  const unsigned lds0=(unsigned)(uintptr_t)shm;
  float*wsf=(float*)(shm+LDS_WS)+wid*64;
  const unsigned koff=(unsigned)(lane*DM+wid*8)*2u;
  const unsigned voff=(unsigned)((16*(wid&3)+(lane>>2))*DM+(wid>>2)*32+(lane&3)*8)*2u;
  const unsigned kdst=lds0+LDS_K+wid*1024, vdst=lds0+LDS_V+wid*1024;
  #define DMA_K(t,slot) glds16(Kh+(long)(t)*KVBLK*DM,koff,(unsigned)__builtin_amdgcn_readfirstlane(kdst+(slot)))
  #define DMA_V(t,slot) glds16(Vh+(long)(t)*KVBLK*DM,voff,(unsigned)__builtin_amdgcn_readfirstlane(vdst+(slot)))
  const int vb0=(int)(lds0+LDS_V)+((lane>>4)&1)*32+(lane&3)*8+(4*hi+((lane&15)>>2))*64;
  const char*Kbase=shm+LDS_K; bf16x8 kf[8];
  const lds_cptr shm3=(lds_cptr)shm; const lds_cptr kp0=shm3+LDS_K+hi*1024+r32*16; const lds_cptr vp0=shm3+LDS_V+((lane>>4)&1)*32+(lane&3)*8+(4*hi+((lane&15)>>2))*64;
  const int NT=(q0+QB)/KVBLK-t_lo;
  DMA_K(0,0);DMA_V(0,0);DMA_K(1,SLOTB);
  bf16x8 qr[4];
  #pragma unroll
  for(int d0=0;d0<4;++d0)qr[d0]=*reinterpret_cast<const bf16x8*>(&Qw[(long)r32*DM+d0*16+hi*8]);
  float z_=0.f; asm volatile("":"+v"(z_));
  float mhat=z_,l_reg=z_;f32x16 o[2],negm;
  _Pragma("unroll") for(int r=0;r<16;++r){o[0][r]=z_;o[1][r]=z_;negm[r]=z_;} asm volatile("":"+v"(negm));
  const int qrel=wid*QBLK+r32; const int ql=q0-t_lo*KVBLK+qrel;
  #define CMASK(P0,P1,t) do{ if(SWA){swmask(P0,P1,(t),ql,hi);} else {int jb_=(t)-(NT-4); if(jb_>=0)cmask(P0,P1,jb_,qrel,hi);} }while(0)
  bool resc=false;
  #define START(P0,P1) do{ const float rm=rowmax(P0,P1); resc=false; \
    { const float dl=SWA?max2f(rm,sink2):rm; if(SWA){l_reg=(hi==0)?__builtin_amdgcn_exp2f(sink2-dl):0.f;} mhat=fadd_s(mhat,dl); \
      _Pragma("unroll") for(int r=0;r<16;++r){P0[r]=fsub_s(P0[r],dl);P1[r]=fsub_s(P1[r],dl);} \
      _Pragma("unroll") for(int r=0;r<16;++r)negm[r]=-mhat; asm volatile("":"+v"(negm)); } \
    _Pragma("unroll") for(int r=0;r<16;++r)P0[r]=__builtin_amdgcn_exp2f(P0[r]); }while(0)
  #define RESC() do{ if(resc){ asm volatile("s_waitcnt lgkmcnt(0)":::"memory"); \
      _Pragma("unroll") for(int d_=0;d_<2;++d_) _Pragma("unroll") for(int r=0;r<16;++r)o[d_][r]*=wsf[crow(r,hi)]; } }while(0)
  f32x16 pA0,pA1,pB0,pB1;
  int sl_prev=0,sl_cur=0,sl_next=SLOTB;
  #define ROT() do{sl_prev=sl_cur;sl_cur=sl_next;sl_next=(sl_next==(NSLOT-1)*SLOTB)?0:sl_next+SLOTB;}while(0)
  DMA_K(2,2*SLOTB);
  WAIT_BAR(3);
  qkt(pA0,pA1,Kbase,qr,negm,r32,hi);asm volatile("s_nop 15\n\ts_nop 7":"+v"(pA0),"+v"(pA1));CMASK(pA0,pA1,0);
  START(pA0,pA1);
  _Pragma("unroll") for(int r=0;r<16;++r)pA1[r]=__builtin_amdgcn_exp2f(pA1[r]);
  WAIT_BAR(0);
  DMA_K(3,0);DMA_V(1,SLOTB);
  ROT();
  kload8(kf,kp0+sl_cur);
  WAIT_BAR(2);
  s16x4 vlo[8],vhi[8]; u32x4 pw0,pw1,pw2,pw3;
  #define PKW(P,B) cvtpk_s(P[B],P[B+1])
  #define PAF(k) __builtin_bit_cast(bf16x8,pw##k)
  #define VFR(i) (bf16x8){vlo[i][0],vlo[i][1],vlo[i][2],vlo[i][3],vhi[i][0],vhi[i][1],vhi[i][2],vhi[i][3]}
  #define PIN(x) asm volatile("":"+v"(x))
  #define MX3(a,b,c) __builtin_fmaxf(__builtin_fmaxf((a),(b)),(c))
  #define GAPA(MF,A0,A1,A2,A3,W0,W1,PW) do{ MF; sacc+=A0; sacc+=A1; sacc+=A2; sacc+=A3; PIN(sacc); W0; W1; PIN(PW); SBAR(); }while(0)
  #define EX(v) __builtin_amdgcn_exp2f(v)
  #define GAPB(MF,X,B) do{ MF; X[B]=EX(X[B]); X[B+1]=EX(X[B+1]); X[B+2]=EX(X[B+2]); X[B+3]=EX(X[B+3]); PIN(X); SBAR(); }while(0)
  #define VRD(i) do{ vlo[i]=vtr(vp_+(((i)>>2)*4096+((i)&3)*1024)); vhi[i]=vtr(vp_+(((i)>>2)*4096+((i)&3)*1024+512)); }while(0)
  #define KRD(G,j) do{ if(G){ kload2(kf,kp0+sl_next,j); SBAR(); } }while(0)
  #define STEP(C0,C1,P0,P1,t,GK,GV,GL) do{ SBAR(); \
    const lds_cptr vp_=vp0+sl_prev; \
    VRD(0); SBAR(); float sacc=(P0[0]+P0[1]); \
    GAPA(C0=__builtin_amdgcn_mfma_f32_32x32x16_bf16(kf[0],qr[0],negm,0,0,0), P0[2],P0[3],P0[4],P0[5],     pw0[0]=PKW(P0,0), pw0[1]=PKW(P0,2), pw0); \
    VRD(4); SBAR(); GAPA(C1=__builtin_amdgcn_mfma_f32_32x32x16_bf16(kf[1],qr[0],negm,0,0,0), P0[6],P0[7],P0[8],P0[9],     pw0[2]=PKW(P0,4), pw0[3]=PKW(P0,6), pw0); \
    VRD(1); SBAR(); GAPA(C0=__builtin_amdgcn_mfma_f32_32x32x16_bf16(kf[2],qr[1],C0,0,0,0),   P0[10],P0[11],P0[12],P0[13], pw1[0]=PKW(P0,8), pw1[1]=PKW(P0,10), pw1); \
    VRD(5); SBAR(); GAPA(C1=__builtin_amdgcn_mfma_f32_32x32x16_bf16(kf[3],qr[1],C1,0,0,0),   P0[14],P0[15],P1[0],P1[1],   pw1[2]=PKW(P0,12),pw1[3]=PKW(P0,14), pw1); \
    VRD(2); SBAR(); GAPA(C0=__builtin_amdgcn_mfma_f32_32x32x16_bf16(kf[4],qr[2],C0,0,0,0),   P1[2],P1[3],P1[4],P1[5],     pw2[0]=PKW(P1,0), pw2[1]=PKW(P1,2), pw2); \
    VRD(6); SBAR(); GAPA(C1=__builtin_amdgcn_mfma_f32_32x32x16_bf16(kf[5],qr[2],C1,0,0,0),   P1[6],P1[7],P1[8],P1[9],     pw2[2]=PKW(P1,4), pw2[3]=PKW(P1,6), pw2); \
    VRD(3); SBAR(); GAPA(C0=__builtin_amdgcn_mfma_f32_32x32x16_bf16(kf[6],qr[3],C0,0,0,0),   P1[10],P1[11],P1[12],P1[13], pw3[0]=PKW(P1,8), pw3[1]=PKW(P1,10), pw3); \
    VRD(7); SBAR(); GAPA(C1=__builtin_amdgcn_mfma_f32_32x32x16_bf16(kf[7],qr[3],C1,0,0,0),   P1[14],P1[15],0.f,0.f,       pw3[2]=PKW(P1,12),pw3[3]=PKW(P1,14), pw3); \
    l_reg+=sacc; \
    if(GK){DMA_K((t)+3,sl_cur);} if(GV){DMA_V((t)+1,sl_next);} \
    CMASK(C0,C1,t); \
    { float a=MX3(C0[0],C0[1],C1[0]),b=MX3(C0[2],C0[3],C1[1]); a=MX3(a,C1[2],C1[3]); \
      _Pragma("unroll") for(int r=4;r<16;r+=4){a=MX3(a,C0[r],C0[r+1]);b=MX3(b,C0[r+2],C0[r+3]);a=MX3(a,C1[r],C1[r+1]);b=MX3(b,C1[r+2],C1[r+3]);} \
      float rm=__builtin_fmaxf(a,b); { auto rr=__builtin_amdgcn_permlane32_swap(__float_as_uint(rm),__float_as_uint(rm),false,false); rm=__builtin_fmaxf(__uint_as_float(rr[0]),__uint_as_float(rr[1])); } \
      resc=false; \
      if(__builtin_expect(__any(rm>(float)THRL),0)){ const float dl=__builtin_fmaxf(rm,0.f); mhat+=dl; \
        _Pragma("unroll") for(int r=0;r<16;++r){C0[r]-=dl;C1[r]-=dl;} \
        _Pragma("unroll") for(int r=0;r<16;++r)negm[r]=-mhat; asm volatile("":"+v"(negm)); \
        const float f=__builtin_amdgcn_exp2f(-dl); l_reg*=f; if(hi==0)wsf[r32]=f; resc=true; } } \
    SBAR(); \
    GAPB(o[0]=__builtin_amdgcn_mfma_f32_32x32x16_bf16(PAF(0),VFR(0),o[0],0,0,0), C0,0); \
    GAPB(o[1]=__builtin_amdgcn_mfma_f32_32x32x16_bf16(PAF(0),VFR(4),o[1],0,0,0), C0,4); \
    KRD(GL,0); GAPB(o[0]=__builtin_amdgcn_mfma_f32_32x32x16_bf16(PAF(1),VFR(1),o[0],0,0,0), C0,8); \
    KRD(GL,1); GAPB(o[1]=__builtin_amdgcn_mfma_f32_32x32x16_bf16(PAF(1),VFR(5),o[1],0,0,0), C0,12); \
    KRD(GL,2); GAPB(o[0]=__builtin_amdgcn_mfma_f32_32x32x16_bf16(PAF(2),VFR(2),o[0],0,0,0), C1,0); \
    KRD(GL,3); GAPB(o[1]=__builtin_amdgcn_mfma_f32_32x32x16_bf16(PAF(2),VFR(6),o[1],0,0,0), C1,4); \
    GAPB(o[0]=__builtin_amdgcn_mfma_f32_32x32x16_bf16(PAF(3),VFR(3),o[0],0,0,0), C1,8); \
    GAPB(o[1]=__builtin_amdgcn_mfma_f32_32x32x16_bf16(PAF(3),VFR(7),o[1],0,0,0), C1,12); \
    }while(0)
  int t=1;
  #undef CMASK
  #define CMASK(P0,P1,t) do{}while(0)
  for(;t+5<NT;t+=2){
    STEP(pB0,pB1,pA0,pA1,t,true,true,true);     WAIT_BAR(2); RESC(); ROT();
    STEP(pA0,pA1,pB0,pB1,t+1,true,true,true);   WAIT_BAR(2); RESC(); ROT();
  }
  #undef CMASK
  #define CMASK(P0,P1,t) do{ if(SWA){swmask(P0,P1,(t),ql,hi);} else {int jb_=(t)-(NT-4); if(jb_>=0)cmask(P0,P1,jb_,qrel,hi);} }while(0)
  #define ENDW(tt) do{ if((tt)+3<NT){WAIT_BAR(2);} else if((tt)+2<NT){WAIT_BAR(1);} else {WAIT_BAR(0);} }while(0)
  for(;t+1<NT;t+=2){
    STEP(pB0,pB1,pA0,pA1,t,(t+3<NT),(t+1<NT),(t+1<NT));       ENDW(t);   RESC(); ROT();
    STEP(pA0,pA1,pB0,pB1,t+1,(t+4<NT),(t+2<NT),(t+2<NT));     ENDW(t+1); RESC(); ROT();
  }
  STEP(pB0,pB1,pA0,pA1,NT-1,false,false,false); RESC();
  { float sacc=pB0[0]+pB0[1]; _Pragma("unroll") for(int r=2;r<16;++r)sacc+=pB0[r]; _Pragma("unroll") for(int r=0;r<16;++r)sacc+=pB1[r]; l_reg+=sacc;
    pw0=(u32x4){PKW(pB0,0),PKW(pB0,2),PKW(pB0,4),PKW(pB0,6)};pw1=(u32x4){PKW(pB0,8),PKW(pB0,10),PKW(pB0,12),PKW(pB0,14)};pw2=(u32x4){PKW(pB1,0),PKW(pB1,2),PKW(pB1,4),PKW(pB1,6)};pw3=(u32x4){PKW(pB1,8),PKW(pB1,10),PKW(pB1,12),PKW(pB1,14)};
    SBAR(); pv(o,vb0+sl_cur,PAF(0),PAF(1),PAF(2),PAF(3)); }
  #undef PKW
  #undef PAF
  #undef VFR
  #undef PIN
  #undef MX3
  #undef GAPA
  #undef GAPB
  #undef EX
  #undef VRD
  #undef KRD
  #undef STEP
  #undef ENDW
  {auto rr=__builtin_amdgcn_permlane32_swap(__float_as_uint(l_reg),__float_as_uint(l_reg),false,false);l_reg=__uint_as_float(rr[0])+__uint_as_float(rr[1]);}
  if(hi==0)wsf[32+r32]=l_reg;asm volatile("s_waitcnt lgkmcnt(0)":::"memory");
  float rli[16];
  #pragma unroll
  for(int r=0;r<16;++r)rli[r]=__builtin_amdgcn_rcpf(wsf[32+crow(r,hi)]);
  bf16*Ow=O+(long)(q0+wid*QBLK)*DMO;
  { bf16*stg=(bf16*)(shm+LDS_OST)+wid*2048;
    #pragma unroll
    for(int r=0;r<16;++r){const int orow=crow(r,hi);
      #pragma unroll
      for(int d0=0;d0<2;++d0)stg[orow*64+d0*32+r32]=__float2bfloat16(o[d0][r]*rli[r]);}
    asm volatile("s_waitcnt lgkmcnt(0)":::"memory");
    #pragma unroll
    for(int i=0;i<4;++i){const int row=i*8+(lane>>3),ch=lane&7; const u32x4 v=*(const u32x4*)(stg+row*64+ch*8); ATTN_STORE16(Ow+(long)row*DMO+ch*8,v);} }
  asm volatile("s_waitcnt lgkmcnt(0)\n\ts_barrier":::"memory");
  #undef DMA_K
  #undef DMA_V
  #undef CMASK
  #undef START
  #undef RESC
  #undef ROT
}
constexpr int ATTN_LDS_BYTES=LDS_BYTES;

constexpr int V2_SLOTB=16384, L2_K=0, L2_V=NSLOT*SLOTB, L2_WS=L2_V+NSLOT*V2_SLOTB, L2_OST=L2_WS+NW*64*4, ATTN128_LDS_BYTES=L2_OST+NW*8192;
template<int THRL> __device__ __forceinline__ void attn_unit128(int qb,const bf16*Q,const bf16*__restrict__ K,const bf16*__restrict__ V,bf16*O,char*shm,const int wid_in){
  int lane_=(int)__builtin_amdgcn_mbcnt_hi(~0u,__builtin_amdgcn_mbcnt_lo(~0u,0u)); asm volatile("":"+v"(lane_));
  int wid_=wid_in; asm volatile("":"+s"(wid_));
  const int wid=wid_,lane=lane_,r32=lane&31,hi=lane>>5;
  const int q0=qb*QB;
  const bf16*Qw=Q+(long)(q0+wid*QBLK)*DM;
  unsigned lds0_=(unsigned)(uintptr_t)shm; asm volatile("":"+s"(lds0_)); const unsigned lds0=lds0_;
  float*wsf=(float*)(shm+L2_WS)+wid*64;
  const unsigned koff=(unsigned)(lane*DM+wid*8)*2u;
  const unsigned voff=(unsigned)((16*(wid&3)+(lane>>2))*DM+(wid>>2)*32+(lane&3)*8)*2u;
  const unsigned kdst=lds0+L2_K+wid*1024, vdst=lds0+L2_V+wid*1024;
  #define DMA_K(t,slot) glds16(K+(long)(t)*KVBLK*DM,koff,(unsigned)__builtin_amdgcn_readfirstlane(kdst+(slot)))
  #define DMA_V(t,slot) do{ glds16(V+(long)(t)*KVBLK*DM,voff,(unsigned)__builtin_amdgcn_readfirstlane(vdst+2*(slot))); glds16(V+(long)(t)*KVBLK*DM+64,voff,(unsigned)__builtin_amdgcn_readfirstlane(vdst+2*(slot)+8192)); }while(0)
  const int vb0=(int)(lds0+L2_V)+((lane>>4)&1)*32+(lane&3)*8+(4*hi+((lane&15)>>2))*64;
  const char*Kbase=shm+L2_K; bf16x8 kf[8];
  const lds_cptr shm3=(lds_cptr)shm; const lds_cptr kp0=shm3+L2_K+hi*1024+r32*16; const lds_cptr vp0=shm3+L2_V+((lane>>4)&1)*32+(lane&3)*8+(4*hi+((lane&15)>>2))*64;
  const int NT=(q0+QB)/KVBLK;
  DMA_K(0,0);DMA_V(0,0);DMA_K(1,SLOTB);
  bf16x8 qr[4];
  #pragma unroll
  for(int d0=0;d0<4;++d0)qr[d0]=*reinterpret_cast<const bf16x8*>(&Qw[(long)r32*DM+d0*16+hi*8]);
  float z_=0.f; asm volatile("":"+v"(z_));
  float mhat=z_,l_reg=z_;f32x16 o[4];
  _Pragma("unroll") for(int r=0;r<16;++r){o[0][r]=z_;o[1][r]=z_;o[2][r]=z_;o[3][r]=z_;}
  const int qrel=wid*QBLK+r32;
  #define CMASK(P0,P1,t) do{ int jb_=(t)-(NT-4); if(jb_>=0)cmask(P0,P1,jb_,qrel,hi); }while(0)
  bool resc=false;
  #define RESC() do{ if(resc){ asm volatile("s_waitcnt lgkmcnt(0)":::"memory"); \
      _Pragma("unroll") for(int d_=0;d_<4;++d_) _Pragma("unroll") for(int r=0;r<16;++r)o[d_][r]*=wsf[crow(r,hi)]; } }while(0)
  f32x16 pA0,pA1,pB0,pB1;
  int sl_prev=0,sl_cur=0,sl_next=SLOTB;
  #define ROT() do{sl_prev=sl_cur;sl_cur=sl_next;sl_next=(sl_next==(NSLOT-1)*SLOTB)?0:sl_next+SLOTB;}while(0)
  DMA_K(2,2*SLOTB);
  WAIT_BAR(3);
  { const f32x16 zz={};
    const char*kb=Kbase+hi*1024+r32*16;
    #pragma unroll
    for(int d0=0;d0<4;++d0){
      const bf16x8 b0=*reinterpret_cast<const bf16x8*>(kb+d0*2048);
      const bf16x8 b1=*reinterpret_cast<const bf16x8*>(kb+d0*2048+512);
      if(d0==0){pA0=__builtin_amdgcn_mfma_f32_32x32x16_bf16(b0,qr[0],zz,0,0,0);pA1=__builtin_amdgcn_mfma_f32_32x32x16_bf16(b1,qr[0],zz,0,0,0);}
      else{pA0=__builtin_amdgcn_mfma_f32_32x32x16_bf16(b0,qr[d0],pA0,0,0,0);pA1=__builtin_amdgcn_mfma_f32_32x32x16_bf16(b1,qr[d0],pA1,0,0,0);}} }
  asm volatile("s_nop 15\n\ts_nop 7":"+v"(pA0),"+v"(pA1));CMASK(pA0,pA1,0);
  { const float rm=rowmax(pA0,pA1); mhat=fadd_s(mhat,rm);
    _Pragma("unroll") for(int r=0;r<16;++r){pA0[r]=__builtin_amdgcn_exp2f(fsub_s(pA0[r],mhat));pA1[r]=__builtin_amdgcn_exp2f(fsub_s(pA1[r],mhat));} }
  WAIT_BAR(0);
  DMA_K(3,0);DMA_V(1,SLOTB);
  ROT();
  kload8(kf,kp0+sl_cur);
  WAIT_BAR(3);
  s16x4 vl0,vh0,vl1,vh1,vl2,vh2,vl3,vh3; u32x4 pw0,pw1,pw2,pw3;
  #define PKW(P,B) cvtpk_s(P[B],P[B+1])
  #define PAF(k) __builtin_bit_cast(bf16x8,pw##k)
  #define VFRB(b) (bf16x8){vl##b[0],vl##b[1],vl##b[2],vl##b[3],vh##b[0],vh##b[1],vh##b[2],vh##b[3]}
  #define PIN(x) asm volatile("":"+v"(x))
  #define MX3(a,b,c) __builtin_fmaxf(__builtin_fmaxf((a),(b)),(c))
  #define GAPA(MF,A0,A1,A2,A3,W0,W1,PW) do{ MF; sacc+=A0; sacc+=A1; sacc+=A2; sacc+=A3; PIN(sacc); W0; W1; PIN(PW); SBAR(); }while(0)
  #define EX(v) __builtin_amdgcn_exp2f((v)-mhat)
  #define GAPB2(MF,X,B) do{ MF; X[B]=EX(X[B]); X[B+1]=EX(X[B+1]); PIN(X); SBAR(); }while(0)
  #define VRDB(b,n) do{ vl##b=vtr(vp_+((((n)&3))*4096+((n)>>2)*1024)); vh##b=vtr(vp_+((((n)&3))*4096+((n)>>2)*1024+512)); SBAR(); }while(0)
  #define KRD(G,j) do{ if(G){ kload2(kf,kp0+sl_next,j); SBAR(); } }while(0)
  #define ZZ (f32x16){0.f,0.f,0.f,0.f,0.f,0.f,0.f,0.f,0.f,0.f,0.f,0.f,0.f,0.f,0.f,0.f}
  #define PVB(n,b,k,d,X,B) do{ GAPB2(o[d]=__builtin_amdgcn_mfma_f32_32x32x16_bf16(PAF(k),VFRB(b),o[d],0,0,0), X,B); if((n)+4<16){ VRDB(b,(n)+4); } }while(0)
  #define STEP(C0,C1,P0,P1,t,GK,GV,GL) do{ SBAR(); \
    const lds_cptr vp_=vp0+2*sl_prev; \
    float sacc=(P0[0]+P0[1]); \
    GAPA(C0=__builtin_amdgcn_mfma_f32_32x32x16_bf16(kf[0],qr[0],ZZ,0,0,0), P0[2],P0[3],P0[4],P0[5],     pw0[0]=PKW(P0,0), pw0[1]=PKW(P0,2), pw0); \
    GAPA(C1=__builtin_amdgcn_mfma_f32_32x32x16_bf16(kf[1],qr[0],ZZ,0,0,0), P0[6],P0[7],P0[8],P0[9],     pw0[2]=PKW(P0,4), pw0[3]=PKW(P0,6), pw0); \
    GAPA(C0=__builtin_amdgcn_mfma_f32_32x32x16_bf16(kf[2],qr[1],C0,0,0,0),   P0[10],P0[11],P0[12],P0[13], pw1[0]=PKW(P0,8), pw1[1]=PKW(P0,10), pw1); \
    GAPA(C1=__builtin_amdgcn_mfma_f32_32x32x16_bf16(kf[3],qr[1],C1,0,0,0),   P0[14],P0[15],P1[0],P1[1],   pw1[2]=PKW(P0,12),pw1[3]=PKW(P0,14), pw1); \
    VRDB(0,0); GAPA(C0=__builtin_amdgcn_mfma_f32_32x32x16_bf16(kf[4],qr[2],C0,0,0,0),   P1[2],P1[3],P1[4],P1[5],     pw2[0]=PKW(P1,0), pw2[1]=PKW(P1,2), pw2); \
    VRDB(1,1); GAPA(C1=__builtin_amdgcn_mfma_f32_32x32x16_bf16(kf[5],qr[2],C1,0,0,0),   P1[6],P1[7],P1[8],P1[9],     pw2[2]=PKW(P1,4), pw2[3]=PKW(P1,6), pw2); \
    VRDB(2,2); GAPA(C0=__builtin_amdgcn_mfma_f32_32x32x16_bf16(kf[6],qr[3],C0,0,0,0),   P1[10],P1[11],P1[12],P1[13], pw3[0]=PKW(P1,8), pw3[1]=PKW(P1,10), pw3); \
    VRDB(3,3); GAPA(C1=__builtin_amdgcn_mfma_f32_32x32x16_bf16(kf[7],qr[3],C1,0,0,0),   P1[14],P1[15],0.f,0.f,       pw3[2]=PKW(P1,12),pw3[3]=PKW(P1,14), pw3); \
    l_reg+=sacc; \
    if(GK){DMA_K((t)+3,sl_cur);} if(GV){DMA_V((t)+1,sl_next);} \
    CMASK(C0,C1,t); \
    { float a=MX3(C0[0],C0[1],C1[0]),b=MX3(C0[2],C0[3],C1[1]); a=MX3(a,C1[2],C1[3]); \
      _Pragma("unroll") for(int r=4;r<16;r+=4){a=MX3(a,C0[r],C0[r+1]);b=MX3(b,C0[r+2],C0[r+3]);a=MX3(a,C1[r],C1[r+1]);b=MX3(b,C1[r+2],C1[r+3]);} \
      float rm=__builtin_fmaxf(a,b); { auto rr=__builtin_amdgcn_permlane32_swap(__float_as_uint(rm),__float_as_uint(rm),false,false); rm=__builtin_fmaxf(__uint_as_float(rr[0]),__uint_as_float(rr[1])); } \
      rm-=mhat; resc=false; \
      if(__builtin_expect(__any(rm>(float)THRL),0)){ const float dl=__builtin_fmaxf(rm,0.f); mhat+=dl; \
        const float f=__builtin_amdgcn_exp2f(-dl); l_reg*=f; if(hi==0)wsf[r32]=f; resc=true; } } \
    SBAR(); \
    PVB(0,0,0,0,C0,0);   PVB(1,1,0,1,C0,2);   PVB(2,2,0,2,C0,4);   PVB(3,3,0,3,C0,6); \
    KRD(GL,0); PVB(4,0,1,0,C0,8);   PVB(5,1,1,1,C0,10); \
    KRD(GL,1); PVB(6,2,1,2,C0,12);  PVB(7,3,1,3,C0,14); \
    KRD(GL,2); PVB(8,0,2,0,C1,0);   PVB(9,1,2,1,C1,2); \
    KRD(GL,3); PVB(10,2,2,2,C1,4);  PVB(11,3,2,3,C1,6); \
    PVB(12,0,3,0,C1,8);  PVB(13,1,3,1,C1,10); PVB(14,2,3,2,C1,12); PVB(15,3,3,3,C1,14); \
    }while(0)
  int t=1;
  #undef CMASK
  #define CMASK(P0,P1,t) do{}while(0)
  for(;t+5<NT;t+=2){
    STEP(pB0,pB1,pA0,pA1,t,true,true,true);     WAIT_BAR(3); RESC(); ROT();
    STEP(pA0,pA1,pB0,pB1,t+1,true,true,true);   WAIT_BAR(3); RESC(); ROT();
  }
  #undef CMASK
  #define CMASK(P0,P1,t) do{ int jb_=(t)-(NT-4); if(jb_>=0)cmask(P0,P1,jb_,qrel,hi); }while(0)
  #define ENDW(tt) do{ if((tt)+3<NT){WAIT_BAR(3);} else if((tt)+2<NT){WAIT_BAR(2);} else {WAIT_BAR(0);} }while(0)
  for(;t+1<NT;t+=2){
    STEP(pB0,pB1,pA0,pA1,t,(t+3<NT),(t+1<NT),(t+1<NT));       ENDW(t);   RESC(); ROT();
    STEP(pA0,pA1,pB0,pB1,t+1,(t+4<NT),(t+2<NT),(t+2<NT));     ENDW(t+1); RESC(); ROT();
  }
  STEP(pB0,pB1,pA0,pA1,NT-1,false,false,false); RESC();
  { float sacc=pB0[0]+pB0[1]; _Pragma("unroll") for(int r=2;r<16;++r)sacc+=pB0[r]; _Pragma("unroll") for(int r=0;r<16;++r)sacc+=pB1[r]; l_reg+=sacc;
    pw0=(u32x4){PKW(pB0,0),PKW(pB0,2),PKW(pB0,4),PKW(pB0,6)};pw1=(u32x4){PKW(pB0,8),PKW(pB0,10),PKW(pB0,12),PKW(pB0,14)};pw2=(u32x4){PKW(pB1,0),PKW(pB1,2),PKW(pB1,4),PKW(pB1,6)};pw3=(u32x4){PKW(pB1,8),PKW(pB1,10),PKW(pB1,12),PKW(pB1,14)};
    SBAR(); pv(o,vb0+2*sl_cur,PAF(0),PAF(1),PAF(2),PAF(3)); pv(o+2,vb0+2*sl_cur+8192,PAF(0),PAF(1),PAF(2),PAF(3)); }
  #undef PKW
  #undef PAF
  #undef VFRB
  #undef PIN
  #undef MX3
  #undef GAPA
  #undef GAPB2
  #undef EX
  #undef VRDB
  #undef PVB
  #undef KRD
  #undef ZZ
  #undef STEP
  #undef ENDW
  {auto rr=__builtin_amdgcn_permlane32_swap(__float_as_uint(l_reg),__float_as_uint(l_reg),false,false);l_reg=__uint_as_float(rr[0])+__uint_as_float(rr[1]);}
  if(hi==0)wsf[32+r32]=l_reg;asm volatile("s_waitcnt lgkmcnt(0)":::"memory");
  float rli[16];
  #pragma unroll
  for(int r=0;r<16;++r)rli[r]=__builtin_amdgcn_rcpf(wsf[32+crow(r,hi)]);
  bf16*Ow=O+(long)(q0+wid*QBLK)*DMO;
  { bf16*stg=(bf16*)(shm+L2_OST)+wid*4096;
    #pragma unroll
    for(int r=0;r<16;++r){const int orow=crow(r,hi);
      #pragma unroll
      for(int d0=0;d0<4;++d0)stg[orow*128+d0*32+r32]=__float2bfloat16(o[d0][r]*rli[r]);}
    asm volatile("s_waitcnt lgkmcnt(0)":::"memory");
    #pragma unroll
    for(int i=0;i<8;++i){const int row=i*4+(lane>>4),ch=lane&15; const u32x4 v=*(const u32x4*)(stg+row*128+ch*8); ATTN_STORE16(Ow+(long)row*DMO+ch*8,v);} }
  asm volatile("s_waitcnt lgkmcnt(0)\n\ts_barrier":::"memory");
  #undef DMA_K
  #undef DMA_V
  #undef CMASK
  #undef RESC
  #undef ROT
}
#undef SBAR
#undef WAIT_BAR
}
#define GAS __attribute__((address_space(1)))
#define LAS __attribute__((address_space(3)))
typedef unsigned short bf16;
typedef unsigned v4u __attribute__((ext_vector_type(4)));
typedef float f32x4 __attribute__((ext_vector_type(4)));
typedef short bf16x8 __attribute__((ext_vector_type(8)));
typedef GAS unsigned gu32;
typedef GAS unsigned long long gu64;
#define RLX_AGENT __ATOMIC_RELAXED, __HIP_MEMORY_SCOPE_AGENT
#define LDS_WAIT() asm volatile("s_waitcnt lgkmcnt(0)" ::: "memory")
#define VM_WAIT() asm volatile("s_waitcnt vmcnt(0)" ::: "memory")
__device__ __forceinline__ unsigned long long rt() { return __builtin_amdgcn_s_memrealtime(); }
__device__ __forceinline__ unsigned f2bf(float f) { unsigned u = __builtin_bit_cast(unsigned, f); return (u + 0x7fffu + ((u >> 16) & 1u)) >> 16; }
__device__ __forceinline__ unsigned pk2(float lo, float hi) { return f2bf(lo) | (f2bf(hi) << 16); }

#define XB_TMO      128
#define XB_XCNT(j)  (256  + 64 * (j))
#define XB_XSUB(j)  (1280 + 64 * (j))
#define XB_XGEN(j)  (2304 + 64 * (j))
#define XB_TOP      3328
#define XB_TOPGEN   3392
#define XCD_BAR_WORDS 3456
#define XB_SPIN_CAP (1u << 18)

__device__ __forceinline__ unsigned xb_ld(unsigned* p)              { return __hip_atomic_load(p, __ATOMIC_RELAXED, __HIP_MEMORY_SCOPE_AGENT); }
__device__ __forceinline__ unsigned xb_add(unsigned* p, unsigned v) { return __hip_atomic_fetch_add(p, v, __ATOMIC_RELAXED, __HIP_MEMORY_SCOPE_AGENT); }
__device__ __forceinline__ unsigned xb_xcc_id() { return (unsigned)__builtin_amdgcn_s_getreg((3 << 11) | 20) & 0xFu; }
#define XB_SPIN(cond, bar) do { unsigned _sp = 0; while (cond) { __builtin_amdgcn_s_sleep(1); \
    if ((++_sp & 255u) == 0u) { if (xb_ld(&(bar)[XB_TMO])) break; if (_sp > XB_SPIN_CAP) { atomicAdd(&(bar)[XB_TMO], 1u); break; } } } } while (0)

struct XcdBarrier {
    unsigned* bar; unsigned x;
    volatile LAS unsigned* st;
};

__device__ __forceinline__ XcdBarrier xcd_barrier_post(unsigned* bar, volatile LAS unsigned* st) {
    XcdBarrier b; b.bar = bar; b.x = xb_xcc_id(); b.st = st;
    if (threadIdx.x == 0) (void)xb_add(&bar[XB_XCNT(b.x)], 1u);
    return b;
}
__device__ __forceinline__ void xcd_barrier_complete(unsigned* bar, unsigned x, unsigned& nloc, unsigned& nx) {
    const unsigned G = gridDim.x * gridDim.y * gridDim.z;
    unsigned sum, cnt, mine, sp = 0u;
    for (;;) {
        sum = 0u; cnt = 0u; mine = 0u;
#pragma unroll
        for (unsigned j = 0; j < 16; ++j) { const unsigned c = xb_ld(&bar[XB_XCNT(j)]); sum += c; cnt += (c > 0u) ? 1u : 0u; mine = (j == x) ? c : mine; }
        if (sum == G) break;
        __builtin_amdgcn_s_sleep(1);
        if ((++sp & 255u) == 0u) { if (xb_ld(&bar[XB_TMO])) break; if (sp > XB_SPIN_CAP) { atomicAdd(&bar[XB_TMO], 1u); break; } }
    }
    nloc = mine > 0u ? mine : 1u; nx = cnt > 0u ? cnt : 1u;
}

__device__ __forceinline__ void xcd_barrier(const XcdBarrier& b) {
    asm volatile("s_waitcnt vmcnt(0)" ::: "memory");
    __syncthreads();
    if (threadIdx.x == 0) {
        unsigned* bar = b.bar;
        __builtin_amdgcn_s_waitcnt(0);
        unsigned nloc = b.st[0], nx = b.st[1];
        if (nloc == 0u) { xcd_barrier_complete(bar, b.x, nloc, nx); b.st[0] = nloc; b.st[1] = nx; }
        const unsigned old = xb_add(&bar[XB_XSUB(b.x)], 1u);
        const unsigned gen = old / nloc;
        if (old + 1u == (gen + 1u) * nloc) {
            __builtin_amdgcn_fence(__ATOMIC_RELEASE, "agent");
            asm volatile("s_waitcnt vmcnt(0)" ::: "memory");
            const unsigned og = xb_add(&bar[XB_TOP], 1u);
            const unsigned tg = og / nx;
            if (og + 1u == (tg + 1u) * nx) xb_add(&bar[XB_TOPGEN], 1u);
            else XB_SPIN(xb_ld(&bar[XB_TOPGEN]) == tg, bar);
            __builtin_amdgcn_fence(__ATOMIC_ACQUIRE, "agent");
            xb_add(&bar[XB_XGEN(b.x)], 1u);
            asm volatile("s_waitcnt vmcnt(0)" ::: "memory");
        } else {
            XB_SPIN(xb_ld(&bar[XB_XGEN(b.x)]) == gen, bar);
            __builtin_amdgcn_fence(__ATOMIC_ACQUIRE, "agent");
            asm volatile("s_waitcnt vmcnt(0)" ::: "memory");
        }
    }
    __syncthreads();
}
constexpr int NWAVES = 8;
constexpr int BATCH = 2, SEQ = 8192, D = 1024, T = BATCH * SEQ, NPROJ = 2304, DFF = 2816, DFE = 3584, NE = 8;
constexpr int NPAD = 2 * T + NE * 256;
constexpr int MAXCH = NPAD / 256;
constexpr float RMS_EPS = 1e-6f, LN_EPS = 1e-5f;
constexpr int NFC = 128, TAIL_KS = 7, TAIL_KSLICE = 512, TAIL_ROWS = 2048;
constexpr int NPH = 17;
constexpr float LOG2E = 1.4426950408889634f;

constexpr size_t MiB = 1u << 20;
constexpr size_t WS_CTL = 0, CTL_ZERO_BYTES = 1 * MiB;
constexpr size_t WS_RT = 1 * MiB;
constexpr size_t RT_SSQ = 1 * MiB;
constexpr size_t RT_SELE = 0, RT_SELL = 128 * 1024, RT_SELW = 256 * 1024, RT_TOKD = 384 * 1024, RT_CNTB = 512 * 1024, RT_CHE = 528 * 1024, RT_NCH = 532 * 1024, RT_CB = 533 * 1024;
constexpr size_t WS_WB = 4 * MiB;
constexpr size_t WB_IN = 0, WB_OUT = WB_IN + (size_t)NPROJ * D, WB_W13 = WB_OUT + (size_t)D * D, WB_W2 = WB_W13 + (size_t)2 * DFF * D, WB_PW1 = WB_W2 + (size_t)D * DFF,
                 WB_PW2 = WB_PW1 + (size_t)2 * D * D, WB_E13 = WB_PW2 + (size_t)D * D, WB_E2 = WB_E13 + (size_t)NE * 2 * DFE * D, WB_END = WB_E2 + (size_t)NE * D * DFE;
static_assert(WB_END * 2 <= 198 * MiB, "weight region");
constexpr size_t WS_X = 202 * MiB;
constexpr size_t WS_XB = 266 * MiB;
constexpr size_t WS_R1 = 298 * MiB;
constexpr size_t R1_PROJ = 0, R1_O16 = 72 * MiB, R1_MIX = 104 * MiB, R1_HB = 0, R1_U = 0, R1_V = 32 * MiB, R1_HN = 0, R1_HMOE = 0;
constexpr size_t WS_R2 = 536 * MiB;
constexpr size_t WS_FAST_END = 604 * MiB;
static_assert((size_t)NPAD * DFE * 2 <= 238 * MiB && (size_t)NPAD * D * 2 <= 68 * MiB, "big regions");
constexpr int CW_BAR = 4096;
constexpr int RING_BYTES = 143360, LDSCTL_OFF = RING_BYTES, MISC_OFF = LDSCTL_OFF + 320, LDS_BYTES = 147456;
static_assert(attn_body::ATTN128_LDS_BYTES <= RING_BYTES && attn_body::ATTN_LDS_BYTES <= RING_BYTES && MISC_OFF + 128 <= LDS_BYTES, "LDS map");

#ifndef FFN_F8_MASK
#define FFN_F8_MASK 2
#endif
#define FFN_F8(pair) (((FFN_F8_MASK) >> (pair)) & 1)
typedef float f32x2 __attribute__((ext_vector_type(2)));
typedef unsigned v2u __attribute__((ext_vector_type(2)));
#define KAS __attribute__((address_space(4)))
static_assert(true, "Args layout: in[26] at 0, out at 208, ws at 216, ph_lo 224, ph_hi 228, li 232, dbg 236");
struct Args { const float* in[26]; float* out; unsigned char* ws; unsigned char* part; int ph_lo, ph_hi, li, dbg; };
constexpr int KA_OUT = 208, KA_WS = 216, KA_PART = 224, KA_LO = 232, KA_HI = 236, KA_LI = 240, KA_DBG = 244;
static_assert(sizeof(Args) == 248, "Args layout");

struct Frame { LAS unsigned char* lds; volatile LAS unsigned* MISC; int tid, lane, wave, vcu, G; };

__device__ __forceinline__ float wave_sum(float v) {
#pragma unroll
    for (int o = 1; o < 64; o <<= 1) v += __shfl_xor(v, o);
    return v;
}
__device__ __forceinline__ unsigned pkbf(float lo, float hi) { return pg8::cvt_pk_bf16(lo, hi); }
__device__ __forceinline__ float bflo(unsigned w) { return __uint_as_float(w << 16); }
__device__ __forceinline__ float bfhi(unsigned w) { return __uint_as_float(w & 0xffff0000u); }

__device__ __forceinline__ unsigned pk4f8(float a, float b, float c, float d) { int w = __builtin_amdgcn_cvt_pk_fp8_f32(a, b, 0, false); w = __builtin_amdgcn_cvt_pk_fp8_f32(c, d, w, true); return (unsigned)w; }
struct CItem { const float* W; int ldw, k0, n0; bf16* WT; int K, drow0; const float* gk; float f8s; };
__device__ __forceinline__ void conv_issue(const CItem& c, f32x4 (&v)[16], int lane) {
    const int kq = lane >> 4, nq = lane & 15;
#pragma unroll
    for (int i = 0; i < 16; ++i) v[i] = __builtin_nontemporal_load((const f32x4*)(c.W + (size_t)(c.k0 + 4 * i + kq) * c.ldw + c.n0 + 4 * nq));
}
__device__ __forceinline__ void conv_finish(const CItem& c, const f32x4 (&v)[16], LAS float* scr, int lane) {
    const int kq = lane >> 4, nq = lane & 15;
#pragma unroll
    for (int i = 0; i < 16; ++i) { const int k = 4 * i + kq; f32x4 t = v[i]; if (c.gk) t = t * c.gk[c.k0 + k]; *(LAS f32x4*)(scr + k * 64 + 4 * (nq ^ (k >> 3))) = t; }
    LDS_WAIT(); asm volatile("" ::: "memory");
    const int cc = lane & 7;
    if (c.f8s != 0.f) { unsigned char* WT8 = (unsigned char*)c.WT; const float f8s = c.f8s;
#pragma unroll
        for (int j = 0; j < 8; ++j) { const int nn = (lane >> 3) + 8 * j; const LAS float* s = scr + (8 * cc) * 64 + (nn ^ (4 * cc));
            v2u o; o.x = pk4f8(s[0] * f8s, s[64] * f8s, s[128] * f8s, s[192] * f8s); o.y = pk4f8(s[256] * f8s, s[320] * f8s, s[384] * f8s, s[448] * f8s);
            *(GAS v2u*)(WT8 + (size_t)(c.drow0 + nn) * c.K + c.k0 + 8 * cc) = o; } }
    else {
#pragma unroll
    for (int j = 0; j < 8; ++j) { const int nn = (lane >> 3) + 8 * j; const LAS float* s = scr + (8 * cc) * 64 + (nn ^ (4 * cc));
        v4u o; o.x = pkbf(s[0], s[64]); o.y = pkbf(s[128], s[192]); o.z = pkbf(s[256], s[320]); o.w = pkbf(s[384], s[448]);
        *(GAS v4u*)(c.WT + (size_t)(c.drow0 + nn) * c.K + c.k0 + 8 * cc) = o; } }
    LDS_WAIT(); asm volatile("" ::: "memory");
}
__device__ __forceinline__ CItem conv_job(const float* W, int ldw, int K, int N, bf16* WT, int half  , int r, const float* gk = nullptr, float f8s = 0.f) {
    const int nblk = N / 64, kb = r / nblk, nb = r % nblk, n0 = 64 * nb;
    const int drow0 = half < 0 ? n0 : ((n0 >> 7) * 256 + half * 128 + (n0 & 127));
    CItem c; c.W = W; c.ldw = ldw; c.k0 = 64 * kb; c.n0 = n0; c.WT = WT; c.K = K; c.drow0 = drow0; c.gk = gk; c.f8s = f8s; return c;
}
__device__ __forceinline__ void rms_row_to_bf16(const float* xrow, const float* g, bf16* orow, int lane) {
    const GAS f32x4* xr = (const GAS f32x4*)xrow + lane; const GAS f32x4* gr = (const GAS f32x4*)g + lane;
    f32x4 v[4]; float s = 0.f;
#pragma unroll
    for (int j = 0; j < 4; ++j) { v[j] = xr[64 * j]; s += (v[j].x * v[j].x + v[j].y * v[j].y) + (v[j].z * v[j].z + v[j].w * v[j].w); }
    const float rstd = 1.f / sqrtf(wave_sum(s) * (1.f / D) + RMS_EPS);
    GAS unsigned long long* o8 = (GAS unsigned long long*)orow + lane;
#pragma unroll
    for (int j = 0; j < 4; ++j) { const f32x4 gg = gr[64 * j]; o8[64 * j] = (unsigned long long)pkbf(v[j].x * rstd * gg.x, v[j].y * rstd * gg.y) | ((unsigned long long)pkbf(v[j].z * rstd * gg.z, v[j].w * rstd * gg.w) << 32); }
}
__device__ __forceinline__ void prep_x(Frame& F, const float* xin, bf16* X, float* ssq4) {
    const int gw = F.vcu * NWAVES + F.wave, NGW = F.G * NWAVES, lane = F.lane;
    for (int m0 = gw; m0 < T; m0 += 4 * NGW) {
        f32x4 v[4][4];
#pragma unroll
        for (int q = 0; q < 4; ++q) { const int m = m0 + q * NGW < T ? m0 + q * NGW : m0; const GAS f32x4* xr = (const GAS f32x4*)(xin + (size_t)m * D) + lane;
#pragma unroll
            for (int j = 0; j < 4; ++j) v[q][j] = xr[64 * j]; }
#pragma unroll
        for (int q = 0; q < 4; ++q) { const int m = m0 + q * NGW; float s = 0.f; unsigned long long w[4];
#pragma unroll
            for (int j = 0; j < 4; ++j) { const unsigned lo = pkbf(v[q][j].x, v[q][j].y), hi = pkbf(v[q][j].z, v[q][j].w); w[j] = (unsigned long long)lo | ((unsigned long long)hi << 32);
                const float r0 = bflo(lo), r1 = bfhi(lo), r2 = bflo(hi), r3 = bfhi(hi); s += (r0 * r0 + r1 * r1) + (r2 * r2 + r3 * r3); }
            s = wave_sum(s);
            if (m < T) { GAS unsigned long long* o8 = (GAS unsigned long long*)(X + (size_t)m * D) + lane;
#pragma unroll
                for (int j = 0; j < 4; ++j) o8[64 * j] = w[j];
                if (lane < 4) ssq4[(size_t)m * 4 + lane] = lane == 0 ? s : 0.f; } }
    }
}
__device__ __forceinline__ void p0_convert(Frame& F, const KAS char* ka, int pair, bf16* WB) {
#define INP(i) (*(const float* const KAS*)(ka + 8 * (i)))
    LAS float* scr = (LAS float*)(F.lds + F.wave * 16384);
    const int gw = F.vcu * NWAVES + F.wave, NGW = F.G * NWAVES;
    constexpr int I_IN = 16 * 36, I_OUT = 256, I_G = 16 * 44, I_DN = 44 * 16, I_PW1H = 256, I_PW2 = 256, I_EG = 16 * 56, I_ED = 56 * 16;
    constexpr int NITEMS = I_IN + I_OUT + 2 * I_G + I_DN + 2 * I_PW1H + I_PW2 + NE * (2 * I_EG + I_ED);
    const float* w_in = INP(2) + (size_t)pair * D * NPROJ; const float* w_out = INP(6) + (size_t)pair * D * D;
    const float* w_fg = INP(8) + (size_t)pair * D * DFF; const float* w_fu = INP(9) + (size_t)pair * D * DFF; const float* w_fd = INP(10) + (size_t)pair * DFF * D;
    const float* w_p1 = INP(12) + (size_t)pair * D * 2 * D; const float* w_p2 = INP(18) + (size_t)pair * D * D;
    const float* g_att = INP(1) + pair * D; const float* g_ffn = INP(7) + pair * D; const float* g_conv = INP(11) + pair * D;
    const bool ffn8 = FFN_F8(pair);
    const float* w_eg = INP(22) + (size_t)pair * NE * D * DFE; const float* w_eu = INP(23) + (size_t)pair * NE * D * DFE; const float* w_ed = INP(24) + (size_t)pair * NE * DFE * D;
#define P0_ITEM(it_) [&]() -> CItem { int r = (it_); \
        if (r < I_IN) return conv_job(w_in, NPROJ, D, NPROJ, WB + WB_IN, -1, r, g_att); r -= I_IN; \
        if (r < I_OUT) return conv_job(w_out, D, D, D, WB + WB_OUT, -1, r); r -= I_OUT; \
        if (r < I_G) return conv_job(w_fg, DFF, D, DFF, WB + WB_W13, 0, r, g_ffn, ffn8 ? (float)(1 << pg8::F8_WSHIFT) : 0.f); r -= I_G; \
        if (r < I_G) return conv_job(w_fu, DFF, D, DFF, WB + WB_W13, 1, r, g_ffn, ffn8 ? (float)(1 << pg8::F8_WSHIFT) : 0.f); r -= I_G; \
        if (r < I_DN) return conv_job(w_fd, D, DFF, D, WB + WB_W2, -1, r, nullptr, ffn8 ? (float)(1 << pg8::F8_FW2SHIFT) : 0.f); r -= I_DN; \
        if (r < I_PW1H) return conv_job(w_p1, 2 * D, D, D, WB + WB_PW1, 0, r, g_conv); r -= I_PW1H; \
        if (r < I_PW1H) return conv_job(w_p1 + D, 2 * D, D, D, WB + WB_PW1, 1, r, g_conv); r -= I_PW1H; \
        if (r < I_PW2) return conv_job(w_p2, D, D, D, WB + WB_PW2, -1, r); r -= I_PW2; \
        if (r < NE * I_EG) { const int e = r / I_EG; return conv_job(w_eg + (size_t)e * D * DFE, DFE, D, DFE, WB + WB_E13 + (size_t)e * DFE * D  , 0, r % I_EG, nullptr, (float)(1 << pg8::F8_WSHIFT)); } r -= NE * I_EG; \
        if (r < NE * I_EG) { const int e = r / I_EG; return conv_job(w_eu + (size_t)e * D * DFE, DFE, D, DFE, WB + WB_E13 + (size_t)e * DFE * D, 1, r % I_EG, nullptr, (float)(1 << pg8::F8_WSHIFT)); } r -= NE * I_EG; \
        { const int e = r / I_ED; return conv_job(w_ed + (size_t)e * DFE * D, D, DFE, D, WB + WB_E2 + (size_t)e * D * DFE / 2  , -1, r % I_ED, nullptr, (float)(1 << pg8::F8_W2SHIFT)); } }()
    if (gw < NITEMS) {
        CItem c0 = P0_ITEM(gw); f32x4 va[16]; conv_issue(c0, va, F.lane);
        for (int it = gw;;) { const int nx = it + NGW; const bool has = nx < NITEMS; CItem c1 = c0; f32x4 vb[16];
            if (has) { c1 = P0_ITEM(nx); conv_issue(c1, vb, F.lane); }
            conv_finish(c0, va, scr, F.lane);
            if (!has) break;
            c0 = c1; it = nx;
#pragma unroll
            for (int i = 0; i < 16; ++i) va[i] = vb[i]; }
    }
#undef P0_ITEM
#undef INP
}
__device__ __forceinline__ void p3_diffcombine(Frame& F, const bf16* O16, bf16* MIX, const float* lamp, const float* subg, float lam_init) {
    const int gw = F.vcu * NWAVES + F.wave, NGW = F.G * NWAVES, lane = F.lane;
    const float pa = wave_sum(lamp[lane] * lamp[64 + lane]), pb = wave_sum(lamp[128 + lane] * lamp[192 + lane]);
    const float lam = expf(pa) - expf(pb) + lam_init;
    const int h = lane >> 4, dvl = (lane & 15) * 8;
    float gsc[8];
#pragma unroll
    for (int i = 0; i < 8; ++i) gsc[i] = subg[dvl + i] * (1.0f - lam_init);
    for (int m0 = gw; m0 < T; m0 += 4 * NGW) {
        v4u a[4], b[4];
#pragma unroll
        for (int q = 0; q < 4; ++q) { const int m = m0 + q * NGW < T ? m0 + q * NGW : m0;
            a[q] = *(const GAS v4u*)(O16 + (size_t)m * D + h * 256 + dvl); b[q] = *(const GAS v4u*)(O16 + (size_t)m * D + h * 256 + 128 + dvl); }
#pragma unroll
        for (int q = 0; q < 4; ++q) { const int m = m0 + q * NGW;
            float v[8];
            v[0] = bflo(a[q].x) - lam * bflo(b[q].x); v[1] = bfhi(a[q].x) - lam * bfhi(b[q].x); v[2] = bflo(a[q].y) - lam * bflo(b[q].y); v[3] = bfhi(a[q].y) - lam * bfhi(b[q].y);
            v[4] = bflo(a[q].z) - lam * bflo(b[q].z); v[5] = bfhi(a[q].z) - lam * bfhi(b[q].z); v[6] = bflo(a[q].w) - lam * bflo(b[q].w); v[7] = bfhi(a[q].w) - lam * bfhi(b[q].w);
            float ss = 0.f;
#pragma unroll
            for (int i = 0; i < 8; ++i) ss += v[i] * v[i];
            ss += __shfl_xor(ss, 1); ss += __shfl_xor(ss, 2); ss += __shfl_xor(ss, 4); ss += __shfl_xor(ss, 8);
            const float r = 1.f / sqrtf(ss * (1.f / 128.f) + RMS_EPS);
            v4u o; o.x = pkbf(v[0] * r * gsc[0], v[1] * r * gsc[1]); o.y = pkbf(v[2] * r * gsc[2], v[3] * r * gsc[3]); o.z = pkbf(v[4] * r * gsc[4], v[5] * r * gsc[5]); o.w = pkbf(v[6] * r * gsc[6], v[7] * r * gsc[7]);
            if (m < T) *(GAS v4u*)(MIX + (size_t)m * D + h * 128 + dvl) = o; }
    }
}
__device__ __forceinline__ void p10_conv(Frame& F, const bf16* U, bf16* V, const float* wdw, const float* bdw, const float* lng, const float* lnb) {
    const int tid = F.tid, lane = F.lane, wave = F.wave;
    LAS unsigned char* tile = F.lds;
    f32x2 w[31];
#pragma unroll
    for (int k = 0; k < 31; ++k) w[k] = *(const GAS f32x2*)(wdw + k * D + 2 * tid);
    const f32x2 bia = *(const GAS f32x2*)(bdw + 2 * tid);
    f32x2 lg_[8], lb_[8];
#pragma unroll
    for (int j = 0; j < 8; ++j) { lg_[j] = *(const GAS f32x2*)(lng + 16 * lane + 2 * j); lb_[j] = *(const GAS f32x2*)(lnb + 16 * lane + 2 * j); }
    for (int u = F.vcu; u < T / 32; u += F.G) {
        const int t0 = u * 32, tp0 = t0 % SEQ;
        { v4u val[16];
#pragma unroll
            for (int i = 0; i < 16; ++i) { const int idx = tid + 512 * i, row = idx >> 7, cc = idx & 127; const bool ok = (tp0 - 30 + row >= 0) && (idx < 62 * 128);
                val[i] = *(const GAS v4u*)(U + (size_t)(ok ? t0 - 30 + row : t0) * D + cc * 8); }
#pragma unroll
            for (int i = 0; i < 16; ++i) { const int idx = tid + 512 * i, row = idx >> 7, cc = idx & 127; const bool ok = (tp0 - 30 + row >= 0);
                if (idx < 62 * 128) *(LAS v4u*)(tile + row * 2048 + cc * 16) = ok ? val[i] : (v4u){0u, 0u, 0u, 0u}; } }
        __syncthreads();
        for (int g = 0; g < 4; ++g) {
            f32x2 acc[8];
#pragma unroll
            for (int o = 0; o < 8; ++o) acc[o] = bia;
            LAS unsigned char* base = tile + (8 * g) * 2048 + 4 * tid;
#pragma unroll
            for (int r = 0; r < 38; ++r) { const unsigned xw = *(LAS unsigned*)(base + r * 2048); const f32x2 xv = (f32x2){bflo(xw), bfhi(xw)};
#pragma unroll
                for (int o = 0; o < 8; ++o) { const int k = r - o; if (k >= 0 && k <= 30) acc[o] += w[k] * xv; } }
#pragma unroll
            for (int o = 0; o < 8; ++o) *(LAS unsigned*)(base + o * 2048) = pkbf(acc[o].x, acc[o].y);
        }
        __syncthreads();
#pragma unroll
        for (int i = 0; i < 4; ++i) { const int tl = 4 * wave + i;
            const v4u a = *(LAS v4u*)(tile + tl * 2048 + lane * 32), b = *(LAS v4u*)(tile + tl * 2048 + lane * 32 + 16);
            float v[16];
            v[0] = bflo(a.x); v[1] = bfhi(a.x); v[2] = bflo(a.y); v[3] = bfhi(a.y); v[4] = bflo(a.z); v[5] = bfhi(a.z); v[6] = bflo(a.w); v[7] = bfhi(a.w);
            v[8] = bflo(b.x); v[9] = bfhi(b.x); v[10] = bflo(b.y); v[11] = bfhi(b.y); v[12] = bflo(b.z); v[13] = bfhi(b.z); v[14] = bflo(b.w); v[15] = bfhi(b.w);
            float s = 0.f;
#pragma unroll
            for (int j = 0; j < 16; ++j) s += v[j];
            const float mu = wave_sum(s) * (1.f / D); float q = 0.f;
#pragma unroll
            for (int j = 0; j < 16; ++j) { v[j] -= mu; q += v[j] * v[j]; }
            const float rstd = 1.f / sqrtf(wave_sum(q) * (1.f / D) + LN_EPS);
            unsigned ow[8];
#pragma unroll
            for (int j = 0; j < 8; ++j) { const f32x2 gg = lg_[j], bb = lb_[j];
                const float y0 = v[2 * j] * rstd * gg.x + bb.x, y1 = v[2 * j + 1] * rstd * gg.y + bb.y;
                ow[j] = pkbf(y0 * pg8::sigmoid_fast(y0), y1 * pg8::sigmoid_fast(y1)); }
            bf16* vp = V + (size_t)(t0 + tl) * D + 16 * lane;
            *(GAS v4u*)vp = (v4u){ow[0], ow[1], ow[2], ow[3]}; *(GAS v4u*)(vp + 8) = (v4u){ow[4], ow[5], ow[6], ow[7]}; }
        __syncthreads();
    }
}
__device__ __forceinline__ void p12_route1(Frame& F, const bf16* X, const float* g, const float* wr, bf16* HN, unsigned char* rt) {
    const int lane = F.lane, wave = F.wave, tid = F.tid;
    LAS int* tok_e = (LAS int*)F.lds; LAS int* loc = tok_e + 64;
    int2* SELE = (int2*)(rt + RT_SELE); int2* SELL = (int2*)(rt + RT_SELL); float2* SELW = (float2*)(rt + RT_SELW); int* CNTB = (int*)(rt + RT_CNTB);
    f32x4 wa[16], wb[16];
#pragma unroll
    for (int j = 0; j < 4; ++j)
#pragma unroll
        for (int i = 0; i < 4; ++i) { const int k = 4 * lane + 256 * j + i; wa[4 * j + i] = *(const GAS f32x4*)(wr + k * 8); wb[4 * j + i] = *(const GAS f32x4*)(wr + k * 8 + 4); }
    f32x4 gg[4];
#pragma unroll
    for (int j = 0; j < 4; ++j) gg[j] = ((const GAS f32x4*)g)[lane + 64 * j];
    for (int blk = F.vcu; blk < T / 64; blk += F.G) {
        for (int i0 = 0; i0 < 8; i0 += 2) {
            f32x4 vv[2][4];
            { unsigned long long xw[2][4];
#pragma unroll
            for (int q = 0; q < 2; ++q) { const GAS unsigned long long* xr = (const GAS unsigned long long*)(X + (size_t)(blk * 64 + 8 * wave + i0 + q) * D) + lane;
#pragma unroll
                for (int j = 0; j < 4; ++j) xw[q][j] = xr[64 * j]; }
#pragma unroll
            for (int q = 0; q < 2; ++q)
#pragma unroll
                for (int j = 0; j < 4; ++j) { const unsigned lo = (unsigned)xw[q][j], hi = (unsigned)(xw[q][j] >> 32); vv[q][j] = (f32x4){bflo(lo), bfhi(lo), bflo(hi), bfhi(hi)}; } }
#pragma unroll
            for (int q = 0; q < 2; ++q) { const int tl = 8 * wave + i0 + q, t = blk * 64 + tl;
            f32x4 v[4]; float s = 0.f;
#pragma unroll
            for (int j = 0; j < 4; ++j) { v[j] = vv[q][j]; s += (v[j].x * v[j].x + v[j].y * v[j].y) + (v[j].z * v[j].z + v[j].w * v[j].w); }
            const float rstd = 1.f / sqrtf(wave_sum(s) * (1.f / D) + RMS_EPS);
            f32x4 la = (f32x4){0.f, 0.f, 0.f, 0.f}, lb = la;
            GAS unsigned long long* o8 = (GAS unsigned long long*)(HN + (size_t)t * D) + lane;
#pragma unroll
            for (int j = 0; j < 4; ++j) { v[j] = v[j] * rstd * gg[j];
                la += wa[4 * j] * v[j].x + wa[4 * j + 1] * v[j].y + wa[4 * j + 2] * v[j].z + wa[4 * j + 3] * v[j].w;
                lb += wb[4 * j] * v[j].x + wb[4 * j + 1] * v[j].y + wb[4 * j + 2] * v[j].z + wb[4 * j + 3] * v[j].w;
                o8[64 * j] = (unsigned long long)pkbf(v[j].x, v[j].y) | ((unsigned long long)pkbf(v[j].z, v[j].w) << 32); }
            float lg[8] = {la.x, la.y, la.z, la.w, lb.x, lb.y, lb.z, lb.w};
#pragma unroll
            for (int e = 0; e < 8; ++e) lg[e] = wave_sum(lg[e]);
            int e0 = 0; float b0 = lg[0];
#pragma unroll
            for (int e = 1; e < 8; ++e) if (lg[e] > b0) { b0 = lg[e]; e0 = e; }
            int e1 = -1; float b1 = -INFINITY;
#pragma unroll
            for (int e = 0; e < 8; ++e) if (e != e0 && lg[e] > b1) { b1 = lg[e]; e1 = e; }
            const float w0 = 1.0f / (1.0f + expf(b1 - b0));
            if (lane == 0) { SELE[t] = make_int2(e0, e1); SELW[t] = make_float2(w0, 1.0f - w0); tok_e[tl] = e0 | (e1 << 8); }
            } }
        __syncthreads();
        if (tid < 8) { int c = 0;
            for (int tl = 0; tl < 64; ++tl) { const int ee = tok_e[tl]; if ((ee & 255) == tid) loc[2 * tl] = c++; if ((ee >> 8) == tid) loc[2 * tl + 1] = c++; }
            CNTB[blk * 8 + tid] = c; }
        __syncthreads();
        if (tid < 64) SELL[blk * 64 + tid] = make_int2(loc[2 * tid], loc[2 * tid + 1]);
        __syncthreads();
    }
}
__device__ __forceinline__ void p13_route2(Frame& F, const bf16* HN, bf16* XS, unsigned char* rt) {
    const int lane = F.lane, wave = F.wave, tid = F.tid;
    LAS int* tot = (LAS int*)F.lds; LAS int* bas = tot + 8; LAS int* pst = tot + 16;
    const int2* SELE = (const int2*)(rt + RT_SELE); const int2* SELL = (const int2*)(rt + RT_SELL); int2* TOKD = (int2*)(rt + RT_TOKD); const int* CNTB = (const int*)(rt + RT_CNTB);
    int* CHE = (int*)(rt + RT_CHE); int* NCH = (int*)(rt + RT_NCH);
    const int c0 = CNTB[(4 * lane + 0) * 8 + wave], c1 = CNTB[(4 * lane + 1) * 8 + wave], c2 = CNTB[(4 * lane + 2) * 8 + wave], c3 = CNTB[(4 * lane + 3) * 8 + wave];
    const int sl = c0 + c1 + c2 + c3; int inc = sl;
#pragma unroll
    for (int o = 1; o < 64; o <<= 1) { const int t = __shfl_up(inc, o); if (lane >= o) inc += t; }
    const int ex = inc - sl, total = __shfl(inc, 63);
    for (int blk = F.vcu; blk < T / 64; blk += F.G) {
        const int j = blk & 3; const int pj = ex + (j > 0 ? c0 : 0) + (j > 1 ? c1 : 0) + (j > 2 ? c2 : 0);
        const int mybase = __shfl(pj, blk >> 2);
        __syncthreads();
        if (lane == 0) { tot[wave] = total; bas[wave] = mybase; }
        __syncthreads();
        if (tid == 0) { int ps = 0;
            for (int e = 0; e < 8; ++e) { pst[e] = ps; const int nc = (tot[e] + 255) >> 8;
                if (blockIdx.x == 0 && blk == F.vcu) for (int c = 0; c < nc; ++c) CHE[(ps >> 8) + c] = e;
                ps += nc << 8; if (blockIdx.x == 0 && blk == F.vcu) ((int*)(rt + RT_CB))[e] = ps >> 8; }
            if (blockIdx.x == 0 && blk == F.vcu) NCH[0] = ps >> 8; }
        __syncthreads();
        for (int i0 = 0; i0 < 8; i0 += 4) {
            v4u ra[4], rb[4]; int d0[4], d1[4];
#pragma unroll
            for (int q = 0; q < 4; ++q) { const int t = blk * 64 + 8 * wave + i0 + q; const int2 ee = SELE[t], ll = SELL[t];
                d0[q] = pst[ee.x] + bas[ee.x] + ll.x; d1[q] = pst[ee.y] + bas[ee.y] + ll.y;
                const GAS v4u* src = (const GAS v4u*)(HN + (size_t)t * D); ra[q] = src[lane]; rb[q] = src[lane + 64]; }
#pragma unroll
            for (int q = 0; q < 4; ++q) { const int t = blk * 64 + 8 * wave + i0 + q;
                if (lane == 0) TOKD[t] = make_int2(d0[q], d1[q]);
                v2u fa, fb; fa.x = pk4f8(bflo(ra[q].x), bfhi(ra[q].x), bflo(ra[q].y), bfhi(ra[q].y)); fa.y = pk4f8(bflo(ra[q].z), bfhi(ra[q].z), bflo(ra[q].w), bfhi(ra[q].w));
                fb.x = pk4f8(bflo(rb[q].x), bfhi(rb[q].x), bflo(rb[q].y), bfhi(rb[q].y)); fb.y = pk4f8(bflo(rb[q].z), bfhi(rb[q].z), bflo(rb[q].w), bfhi(rb[q].w));
                GAS v2u* q0 = (GAS v2u*)((unsigned char*)XS + (size_t)d0[q] * D); GAS v2u* q1 = (GAS v2u*)((unsigned char*)XS + (size_t)d1[q] * D);
                q0[lane] = fa; q0[lane + 64] = fb; q1[lane] = fa; q1[lane + 64] = fb; } }
    }
}
__device__ __forceinline__ void p16_combine(Frame& F, bf16* X, const bf16* YS, const bf16* PART, const unsigned char* rt, const float* g, float* ssq4, float* out, bool last, bool poison) {
    const int gw = F.vcu * NWAVES + F.wave, NGW = F.G * NWAVES, lane = F.lane;
    const int2* TOKD = (const int2*)(rt + RT_TOKD); const float2* SELW = (const float2*)(rt + RT_SELW);
    f32x4 gg[4];
#pragma unroll
    for (int j = 0; j < 4; ++j) gg[j] = ((const GAS f32x4*)g)[lane + 64 * j];
    for (int m0 = gw; m0 < T; m0 += 4 * NGW) {
        int2 dd[4]; float2 ww[4];
#pragma unroll
        for (int q = 0; q < 4; ++q) { const int m = m0 + q * NGW < T ? m0 + q * NGW : m0; dd[q] = TOKD[m]; ww[q] = SELW[m]; }
        f32x4 v[4][4]; unsigned long long xa[4][4], ya[4][4], yb[4][4];
#pragma unroll
        for (int q = 0; q < 4; ++q) { const int m = m0 + q * NGW < T ? m0 + q * NGW : m0;
            const int d0 = dd[q].x < NFC * 256 ? dd[q].x : 0, d1 = dd[q].y < NFC * 256 ? dd[q].y : 0;
            const GAS unsigned long long* xr = (const GAS unsigned long long*)(X + (size_t)m * D) + lane;
            const GAS unsigned long long* y0 = (const GAS unsigned long long*)(YS + (size_t)d0 * D) + lane; const GAS unsigned long long* y1 = (const GAS unsigned long long*)(YS + (size_t)d1 * D) + lane;
#pragma unroll
            for (int j = 0; j < 4; ++j) { xa[q][j] = xr[64 * j]; ya[q][j] = y0[64 * j]; yb[q][j] = y1[64 * j]; } }
#pragma unroll
        for (int q = 0; q < 4; ++q)
#pragma unroll
            for (int j = 0; j < 4; ++j) { const unsigned lo = (unsigned)xa[q][j], hi = (unsigned)(xa[q][j] >> 32); v[q][j] = (f32x4){bflo(lo), bfhi(lo), bflo(hi), bfhi(hi)}; }
#pragma unroll
        for (int q = 0; q < 4; ++q) { const int m = m0 + q * NGW;
#pragma unroll
            for (int e = 0; e < 2; ++e) { const int d = e ? dd[q].y : dd[q].x; const float w = e ? ww[q].y : ww[q].x;
                if (d < NFC * 256) {
#pragma unroll
                    for (int j = 0; j < 4; ++j) { const unsigned long long a = e ? yb[q][j] : ya[q][j]; const unsigned al = (unsigned)a, ah = (unsigned)(a >> 32);
                        v[q][j].x += w * bflo(al); v[q][j].y += w * bfhi(al); v[q][j].z += w * bflo(ah); v[q][j].w += w * bfhi(ah); } }
                else { f32x4 t[4];
#pragma unroll
                    for (int j = 0; j < 4; ++j) t[j] = (f32x4){0.f, 0.f, 0.f, 0.f};
                    for (int ks = 0; ks < TAIL_KS; ++ks) { const GAS unsigned long long* y = (const GAS unsigned long long*)(PART + ((size_t)ks * TAIL_ROWS + (d - NFC * 256)) * D) + lane;
#pragma unroll
                        for (int j = 0; j < 4; ++j) { const unsigned long long a = y[64 * j]; const unsigned al = (unsigned)a, ah = (unsigned)(a >> 32);
                            t[j].x += bflo(al); t[j].y += bfhi(al); t[j].z += bflo(ah); t[j].w += bfhi(ah); } }
#pragma unroll
                    for (int j = 0; j < 4; ++j) v[q][j] += t[j] * w; } }
            if (last) {
                float s = 0.f;
#pragma unroll
                for (int j = 0; j < 4; ++j) s += (v[q][j].x * v[q][j].x + v[q][j].y * v[q][j].y) + (v[q][j].z * v[q][j].z + v[q][j].w * v[q][j].w);
                const float rstd = 1.f / sqrtf(wave_sum(s) * (1.f / D) + RMS_EPS);
                if (m < T) { GAS f32x4* orow = (GAS f32x4*)(out + (size_t)m * D) + lane; const float qn = __builtin_nanf("");
#pragma unroll
                    for (int j = 0; j < 4; ++j) { f32x4 o = v[q][j] * rstd * gg[j]; if (poison) o = (f32x4){qn, qn, qn, qn}; orow[64 * j] = o; } } }
            else {
                float s = 0.f; unsigned long long w[4];
#pragma unroll
                for (int j = 0; j < 4; ++j) { const unsigned lo = pkbf(v[q][j].x, v[q][j].y), hi = pkbf(v[q][j].z, v[q][j].w); w[j] = (unsigned long long)lo | ((unsigned long long)hi << 32);
                    const float r0 = bflo(lo), r1 = bfhi(lo), r2 = bflo(hi), r3 = bfhi(hi); s += (r0 * r0 + r1 * r1) + (r2 * r2 + r3 * r3); }
                s = wave_sum(s);
                if (m < T) { GAS unsigned long long* o8 = (GAS unsigned long long*)(X + (size_t)m * D) + lane;
#pragma unroll
                    for (int j = 0; j < 4; ++j) o8[64 * j] = w[j];
                    if (lane < 4) ssq4[(size_t)m * 4 + lane] = lane == 0 ? s : 0.f; } }
        }
    }
}
template <int pair> __device__ __forceinline__ void layer_pair(Frame& F) {
    const KAS char* const ka0 = (const KAS char*)__builtin_amdgcn_kernarg_segment_ptr();
    extern __shared__ __attribute__((aligned(16))) unsigned char lds[];
        const int pb = pair * NPH;
#define PLO() (*(const int KAS*)(ka0 + KA_LO))
#define PHI() (*(const int KAS*)(ka0 + KA_HI))
#define IN(k) (PLO() <= pb + (k) && pb + (k) < PHI())
#define SEAM(k) do { if (pb + (k) + 1 < PHI()) { XcdBarrier b_; b_.bar = (unsigned*)((gu32*)(ws + WS_CTL) + CW_BAR) + (size_t)(*(const int KAS*)(ka + KA_LI)) * XCD_BAR_WORDS; b_.x = xb_xcc_id(); b_.st = F.MISC + 8; xcd_barrier(b_); } } while (0)
#define REFRESH() int l_ = (int)__builtin_amdgcn_mbcnt_hi(~0u, __builtin_amdgcn_mbcnt_lo(~0u, 0u)); asm volatile("" : "+v"(l_)); F.lane = l_; F.tid = F.wave * 64 + l_; \
        const KAS char* ka = (const KAS char*)__builtin_amdgcn_kernarg_segment_ptr(); asm volatile("" : "+s"(ka)); unsigned char* const ws = *(unsigned char* const KAS*)(ka + KA_WS); (void)ws
#define INP(i) (*(const float* const KAS*)(ka + 8 * (i)))
#define WSP(T_, off) ((T_*)(ws + (off)))
        const float lam_init = pair == 0 ? 0.2f : 0.47071302f;

        if (IN(0)) { REFRESH();
            if (pair == 0 || *(const int KAS*)(ka + KA_DBG) != 0) p0_convert(F, ka, pair, WSP(bf16, WS_WB));
            if (pair == 0 && *(const int KAS*)(ka + KA_DBG) == 0) prep_x(F, INP(0), WSP(bf16, WS_X), WSP(float, WS_RT + RT_SSQ));
            if (pair == 0 || *(const int KAS*)(ka + KA_DBG) != 0) SEAM(0);
        }
        if (IN(1)) { REFRESH();
            pg8::Gemm g{WSP(bf16, WS_X), WSP(bf16, WS_WB) + WB_IN, T, NPROJ, D, D, 0, 0}; pg8::StaticOrder S; S.init(T, NPROJ, F.G, (int)blockIdx.x);
            pg8::EpiProj E{WSP(bf16, WS_R1 + R1_PROJ), NPROJ, 0xC3u, attn_body::C2, WSP(const float, WS_RT + RT_SSQ), 1.0f / D, RMS_EPS};
            pg8::gemm_phase<pg8::EpiProj, pg8::StaticOrder, true, true>(F.lds, g, S, E, F.wave);
            SEAM(1);
        }
        if (IN(2)) { REFRESH();
            const attn_body::bf16* PJ = WSP(const attn_body::bf16, WS_R1 + R1_PROJ); attn_body::bf16* O16 = WSP(attn_body::bf16, WS_R1 + R1_O16); attn_body::bf16* MIX = WSP(attn_body::bf16, WS_R1 + R1_MIX); const float* sinks = INP(5) + pair * 8;
#if defined(PROBE_SKIP_DIFF)
            if (F.vcu < 256 && *(const int KAS*)(ka + KA_LI) == 0) { const int k = F.vcu;
#else
            if (F.vcu < 256) { const int k = F.vcu;
#endif
                const int bhc = k >> 4, s = k & 15, b = bhc >> 3, h = (bhc >> 1) & 3, c = bhc & 1;
                const attn_body::bf16* base = PJ + (size_t)b * SEQ * NPROJ;
                for (int i = 0; i < 2; ++i) { const int qb = (i == 0) ? s : 31 - s;
                    attn_body::attn_unit128<8>(qb, base + h * 128 + c * 64, base + 512 + h * 128 + c * 64, base + 1024 + h * 128,
                                               O16 + (size_t)b * SEQ * D + (h * 2 + c) * 128, (char*)lds, F.wave); }
            }
#if defined(PROBE_SKIP_SWA)
            if (F.vcu < 256 && *(const int KAS*)(ka + KA_LI) == 0)
#else
            if (F.vcu < 256)
#endif
                for (int i = 0; i < 2; ++i) { const int su = F.vcu * 2 + i, b = su >> 8, hq = (su >> 5) & 7, qb = su & 31, kvh = hq >> 2;
                    const attn_body::bf16* base = PJ + (size_t)b * SEQ * NPROJ;
                    const float sink2 = sinks[hq] * LOG2E;
                    attn_body::attn_unit<8, true>(qb, base + 1536 + hq * 64, base + 2048 + kvh * 64, base + 2176 + kvh * 64,
                                                  MIX + (size_t)b * SEQ * D + 512 + hq * 64, sink2, (char*)lds, F.wave); }
            SEAM(2);
        }
        if (IN(3)) { REFRESH(); p3_diffcombine(F, WSP(bf16, WS_R1 + R1_O16), WSP(bf16, WS_R1 + R1_MIX), INP(3) + pair * 256, INP(4) + pair * 128, lam_init); SEAM(3); }
        if (IN(4)) { REFRESH();
            pg8::Gemm g{WSP(bf16, WS_R1 + R1_MIX), WSP(bf16, WS_WB) + WB_OUT, T, D, D, D, 0, 0}; pg8::StaticOrder S; S.init(T, D, F.G, (int)blockIdx.x);
            pg8::EpiResX E{WSP(const bf16, WS_X), nullptr, WSP(bf16, WS_X), D, nullptr, WSP(float, WS_RT + RT_SSQ), FFN_F8(pair) ? ws + WS_XB : nullptr, (float)(1 << pg8::F8_XSHIFT)};
            pg8::gemm_phase<pg8::EpiResX, pg8::StaticOrder, false, true>(F.lds, g, S, E, F.wave);
            SEAM(4);
        }
        if (IN(6)) { REFRESH();
            pg8::Gemm g{FFN_F8(pair) ? WSP(bf16, WS_XB) : WSP(bf16, WS_X), WSP(bf16, WS_WB) + WB_W13, T, 2 * DFF, FFN_F8(pair) ? D / 2 : D, FFN_F8(pair) ? D / 2 : D, pg8::f8_scale(pg8::F8_WSHIFT), pg8::f8_scale(pg8::F8_XSHIFT)}; pg8::StaticOrder S; S.init(T, 2 * DFF, F.G, (int)blockIdx.x);
            pg8::EpiSwiglu E{WSP(bf16, WS_R1 + R1_HB), DFF, WSP(const float, WS_RT + RT_SSQ), 1.0f / D, RMS_EPS, FFN_F8(pair) ? (float)(1 << pg8::F8_HSHIFT) : 0.f};
            pg8::gemm_phase<pg8::EpiSwiglu, pg8::StaticOrder, true, true, FFN_F8(pair) != 0>(F.lds, g, S, E, F.wave);
            SEAM(6);
        }
        if (IN(7)) { REFRESH();
            pg8::Gemm g{WSP(bf16, WS_R1 + R1_HB), WSP(bf16, WS_WB) + WB_W2, T, D, FFN_F8(pair) ? DFF / 2 : DFF, FFN_F8(pair) ? DFF / 2 : DFF, pg8::f8_scale(pg8::F8_FW2SHIFT), pg8::f8_scale(pg8::F8_HSHIFT)}; pg8::StaticOrder S; S.init(T, D, F.G, (int)blockIdx.x);
            pg8::EpiResX E{WSP(const bf16, WS_X), nullptr, WSP(bf16, WS_X), D, nullptr, WSP(float, WS_RT + RT_SSQ), nullptr, 0.f};
            pg8::gemm_phase<pg8::EpiResX, pg8::StaticOrder, false, true, FFN_F8(pair) != 0>(F.lds, g, S, E, F.wave);
            SEAM(7);
        }
        if (IN(9)) { REFRESH();
            pg8::Gemm g{WSP(bf16, WS_X), WSP(bf16, WS_WB) + WB_PW1, T, 2 * D, D, D, 0, 0}; pg8::StaticOrder S; S.init(T, 2 * D, F.G, (int)blockIdx.x);
            pg8::EpiGlu E{WSP(bf16, WS_R1 + R1_U), D, INP(13) + pair * 2 * D, D, WSP(const float, WS_RT + RT_SSQ), 1.0f / D, RMS_EPS};
            pg8::gemm_phase<pg8::EpiGlu, pg8::StaticOrder, true, true>(F.lds, g, S, E, F.wave);
            SEAM(9);
        }
        if (IN(10)) { REFRESH(); p10_conv(F, WSP(bf16, WS_R1 + R1_U), WSP(bf16, WS_R1 + R1_V), INP(14) + pair * 31 * D, INP(15) + pair * D, INP(16) + pair * D, INP(17) + pair * D); SEAM(10); }
        if (IN(11)) { REFRESH();
            pg8::Gemm g{WSP(bf16, WS_R1 + R1_V), WSP(bf16, WS_WB) + WB_PW2, T, D, D, D, 0, 0}; pg8::StaticOrder S; S.init(T, D, F.G, (int)blockIdx.x);
            pg8::EpiResX E{WSP(const bf16, WS_X), nullptr, WSP(bf16, WS_X), D, INP(19) + pair * D, WSP(float, WS_RT + RT_SSQ), nullptr, 0.f};
            pg8::gemm_phase<pg8::EpiResX, pg8::StaticOrder, false, true>(F.lds, g, S, E, F.wave);
            SEAM(11);
        }
        if (IN(12)) { REFRESH(); p12_route1(F, WSP(bf16, WS_X), INP(20) + pair * D, INP(21) + (size_t)pair * D * NE, WSP(bf16, WS_R1 + R1_HN), ws + WS_RT); SEAM(12); }
        if (IN(13)) { REFRESH(); p13_route2(F, WSP(bf16, WS_R1 + R1_HN), WSP(bf16, WS_R2), ws + WS_RT); SEAM(13); }
        if (IN(14)) { REFRESH();
            const unsigned char* rt = ws + WS_RT; const int nch = __builtin_amdgcn_readfirstlane(*(const int*)(rt + RT_NCH));
            pg8::Gemm g{WSP(bf16, WS_R2), WSP(bf16, WS_WB) + WB_E13, nch * 256, 2 * DFE, D / 2, D / 2, pg8::f8_scale(pg8::F8_WSHIFT), pg8::f8_scale(0)};     pg8::MoeOrder S; S.so.init(nch * 256, 2 * DFE, F.G, (int)blockIdx.x); S.load_cb((const int*)(rt + RT_CB)); S.estride = (size_t)2 * DFE * D;
            pg8::EpiSwiglu E{WSP(bf16, WS_R1 + R1_HMOE), DFE, nullptr, 0.f, 0.f, (float)(1 << pg8::F8_HSHIFT)};
            pg8::gemm_phase<pg8::EpiSwiglu, pg8::MoeOrder, true, true, true>(F.lds, g, S, E, F.wave);
            SEAM(14);
        }
        if (IN(15)) { REFRESH();
            const unsigned char* rt = ws + WS_RT; const int nch = __builtin_amdgcn_readfirstlane(*(const int*)(rt + RT_NCH)); const int nfc = nch < NFC ? nch : NFC;
            { pg8::Gemm g{WSP(bf16, WS_R1 + R1_HMOE), WSP(bf16, WS_WB) + WB_E2, nfc * 256, D, DFE / 2, DFE / 2, pg8::f8_scale(pg8::F8_W2SHIFT), pg8::f8_scale(pg8::F8_HSHIFT)};     pg8::MoeOrder S; S.so.init(nfc * 256, D, F.G, (int)blockIdx.x); S.load_cb((const int*)(rt + RT_CB)); S.estride = (size_t)D * DFE;
              pg8::EpiProj E{WSP(bf16, WS_R2), D, 0u, 1.f, nullptr, 0.f, 0.f};
              pg8::gemm_phase<pg8::EpiProj, pg8::MoeOrder, true, true, true>(F.lds, g, S, E, F.wave); }
            if (nch > NFC) {
              pg8::Gemm g{WSP(bf16, WS_R1 + R1_HMOE), WSP(bf16, WS_WB) + WB_E2, 0, D, TAIL_KSLICE / 2, DFE / 2, pg8::f8_scale(pg8::F8_W2SHIFT), pg8::f8_scale(pg8::F8_HSHIFT)}; pg8::TailOrder S; S.nsu = (nch - NFC) * 4 * TAIL_KS; S.G = F.G; S.c = (int)blockIdx.x; S.nfc = NFC; S.KS = TAIL_KS; S.kslice = TAIL_KSLICE / 2; { const int* CB = (const int*)(rt + RT_CB);
#pragma unroll
                for (int e = 0; e < 7; ++e) S.cb[e] = __builtin_amdgcn_readfirstlane(CB[e]); } S.estride = (size_t)D * DFE;
              pg8::EpiProj E{(bf16*)(*(unsigned char* const KAS*)(ka + KA_PART)), D, 0u, 1.f, nullptr, 0.f, 0.f};
              pg8::gemm_phase<pg8::EpiProj, pg8::TailOrder, true, true, true>(F.lds, g, S, E, F.wave); }
            SEAM(15);
        }
        if (IN(16)) { REFRESH();
            const bool last = (pair == 1);
            const bool poison = last && (__hip_atomic_load((gu32*)(ws + WS_CTL) + CW_BAR + (size_t)(*(const int KAS*)(ka + KA_LI)) * XCD_BAR_WORDS + XB_TMO, RLX_AGENT) != 0u);
            p16_combine(F, WSP(bf16, WS_X), WSP(bf16, WS_R2), (const bf16*)(*(unsigned char* const KAS*)(ka + KA_PART)), ws + WS_RT, INP(25), WSP(float, WS_RT + RT_SSQ), *(float* const KAS*)(ka + KA_OUT), last, poison);
            if (pair == 0 && *(const int KAS*)(ka + KA_DBG) == 0 && pb + 17 < PHI()) p0_convert(F, ka, 1, WSP(bf16, WS_WB));
            SEAM(16);
        }
#undef IN
#undef PLO
#undef PHI
#undef SEAM
#undef REFRESH
#undef INP
#undef WSP
}
__global__ void __launch_bounds__(NWAVES * 64, 2) mk_fwd(Args args) {
    extern __shared__ __attribute__((aligned(16))) unsigned char lds[];
    Frame F;
    F.lds = (LAS unsigned char*)lds;
    F.MISC = (volatile LAS unsigned*)(F.lds + MISC_OFF);
    F.tid = threadIdx.x; F.lane = F.tid & 63; F.wave = __builtin_amdgcn_readfirstlane(F.tid >> 6);
    F.G = gridDim.x; { const int bx = blockIdx.x; F.vcu = (F.G % 8 == 0) ? (bx % 8) * (F.G / 8) + bx / 8 : bx; }
    for (int u = F.tid; u < (LDS_BYTES - LDSCTL_OFF) / 4; u += NWAVES * 64) ((LAS unsigned*)(F.lds + LDSCTL_OFF))[u] = 0u;
    __syncthreads();
    unsigned* barw = (unsigned*)((gu32*)(args.ws + WS_CTL) + CW_BAR) + (size_t)args.li * XCD_BAR_WORDS;
    (void)xcd_barrier_post(barw, F.MISC + 8);

    layer_pair<0>(F);
    layer_pair<1>(F);
}
#ifndef MK_DEBUG
#define MK_DEBUG 0
#endif
#ifndef MK_REPORT
#define MK_REPORT -1
#endif
static int mk_grid(size_t ws_need, size_t ws_size, int n_in) {
    static int grid = 0;
    if (grid == 0) {
        if (n_in != 26 || ws_size < ws_need) { fprintf(stderr, "kernel_launch: built for 26 inputs and >= %zu bytes of workspace; got n_in %d, ws %zu; nothing launched\n", ws_need, n_in, ws_size); grid = -1; return grid; }
        int dev = 0, cus = 0, per_cu = 0;
        if (hipGetDevice(&dev) != hipSuccess || hipDeviceGetAttribute(&cus, hipDeviceAttributeMultiprocessorCount, dev) != hipSuccess) { grid = -1; return grid; }
        if (hipFuncSetAttribute((const void*)mk_fwd, hipFuncAttributeMaxDynamicSharedMemorySize, LDS_BYTES) != hipSuccess) { fprintf(stderr, "kernel_launch: hipFuncSetAttribute failed\n"); grid = -1; return grid; }
        if (hipOccupancyMaxActiveBlocksPerMultiprocessor(&per_cu, (const void*)mk_fwd, NWAVES * 64, LDS_BYTES) != hipSuccess || per_cu < 1) { fprintf(stderr, "kernel_launch: occupancy query reports %d\n", per_cu); }
        (void)hipGetLastError();
        grid = cus;
    }
    return grid;
}
#if MK_DEBUG
namespace dbg {
__global__ void __launch_bounds__(256) k_cmp(const void* a, int a_bf16, int lda, float sa, const float* b, int ldb, int rows, int cols, float* acc) {
    const size_t n = (size_t)rows * cols; float d2 = 0.f, b2 = 0.f;
    for (size_t i = (size_t)blockIdx.x * 256 + threadIdx.x; i < n; i += (size_t)gridDim.x * 256) { const size_t r = i / cols, c = i % cols;
        const float av = (a_bf16 ? __uint_as_float((unsigned)((const unsigned short*)a)[r * lda + c] << 16) : ((const float*)a)[r * lda + c]) * sa; const float bv = b[r * ldb + c];
        const float d = av - bv; d2 += d * d; b2 += bv * bv; }
    d2 = orc::wsum(d2); b2 = orc::wsum(b2);
    if ((threadIdx.x & 63) == 0) { atomicAdd(acc, d2); atomicAdd(acc + 1, b2); }
}
__global__ void k_report(float* out, const float* acc, int n, float tol, int which) {
    if (threadIdx.x != 0 || blockIdx.x != 0) return;
    float pert = 0.f;
    if (which < 0) { for (int i = 0; i < n; ++i) { const float e = sqrtf(acc[2 * i] / acc[2 * i + 1]); if (!(e <= tol)) { pert = exp2f((float)(i + 1)); break; } } }
    else { const float e = sqrtf(acc[2 * which] / acc[2 * which + 1]); pert = (e == e) ? e * 1024.f : 3e4f; }
    out[0] += pert;
}
__global__ void __launch_bounds__(256) k_prep(const float* xo, unsigned short* X, float* ssq4) {
    const int row = blockIdx.x * 4 + (threadIdx.x >> 6), lane = threadIdx.x & 63; float s = 0.f;
    for (int j = 0; j < 16; ++j) { const int c = lane + 64 * j; const float v = xo[(size_t)row * 1024 + c]; unsigned u = __float_as_uint(v); u = (u + 0x7fffu + ((u >> 16) & 1u)) >> 16; X[(size_t)row * 1024 + c] = (unsigned short)u; const float r = __uint_as_float(u << 16); s += r * r; }
    s = orc::wsum(s); if (lane < 4) ssq4[(size_t)row * 4 + lane] = lane == 0 ? s : 0.f;
}
static void cmp(hipStream_t st, const void* a, int a_bf16, int lda, float sa, const float* b, int ldb, int rows, int cols, float* acc) {
    hipLaunchKernelGGL(k_cmp, dim3(2048), dim3(256), 0, st, a, a_bf16, lda, sa, b, ldb, rows, cols, acc);
}
}
#endif

extern "C" void kernel_launch(void* const* d_in, const int* in_sizes, int n_in, void* d_out, int out_size, void* d_ws, size_t ws_size, hipStream_t stream) {
#if !MK_DEBUG
    const int grid = mk_grid(WS_FAST_END + (size_t)TAIL_KS * TAIL_ROWS * D * 2, ws_size, n_in); if (grid < 0) return;
    (void)hipMemsetAsync((char*)d_ws + WS_CTL, 0, 65536, stream);
    Args a{};
    for (int i = 0; i < 26; ++i) a.in[i] = (const float*)d_in[i];
    a.out = (float*)d_out; a.ws = (unsigned char*)d_ws; a.part = (unsigned char*)d_ws + WS_FAST_END; a.ph_lo = 0; a.ph_hi = 2 * NPH; a.li = 0; a.dbg = 0;
    hipLaunchKernelGGL(mk_fwd, dim3(grid), dim3(NWAVES * 64), LDS_BYTES, stream, a);
#if defined(PROBE_LO)
    a.ph_lo = PROBE_LO; a.ph_hi = PROBE_HI; a.li = 1; a.out = (float*)((unsigned char*)d_ws + WS_R1);
    hipLaunchKernelGGL(mk_fwd, dim3(grid), dim3(NWAVES * 64), LDS_BYTES, stream, a);
#endif
#else
    const int grid = mk_grid(WS_FAST_END + orc::O_END, ws_size, n_in); if (grid < 0) return;
    (void)hipMemsetAsync((char*)d_ws + WS_CTL, 0, CTL_ZERO_BYTES, stream);
    unsigned char* ws = (unsigned char*)d_ws; unsigned char* ob = ws + WS_FAST_END;
    const orc::In I = orc::make_in(d_in);
    float* Xo = (float*)(ob + orc::O_X); float* Ho = (float*)(ob + orc::O_H); float* BIGo = (float*)(ob + orc::O_BIG);
    unsigned short* Xf = (unsigned short*)(ws + WS_X);
    float* acc = (float*)(ws + WS_CTL + 512 * 1024);
    float* fout = (float*)(ws + WS_R1);
    hipLaunchKernelGGL(orc::k_copy, dim3(T * D / 4 / 256), dim3(256), 0, stream, (const float4*)I.x, (float4*)Xo, (size_t)T * D / 4);
    Args a{};
    for (int i = 0; i < 26; ++i) a.in[i] = (const float*)d_in[i];
    a.out = fout; a.ws = ws; a.part = (unsigned char*)d_out; a.dbg = 1;
    const int plo[4] = {0, 5, 8, 12}, phi[4] = {5, 8, 12, 17};
    for (int sub = 0; sub < 8; ++sub) {
        const int pair = sub >> 2, s4 = sub & 3; float* ac = acc + 2 * 10 * pair;
        hipLaunchKernelGGL(dbg::k_prep, dim3(T / 4), dim3(256), 0, stream, (const float*)Xo, Xf, (float*)(ws + WS_RT + RT_SSQ));
        a.ph_lo = pair * NPH + plo[s4]; a.ph_hi = pair * NPH + phi[s4]; a.li = sub;
        hipLaunchKernelGGL(mk_fwd, dim3(grid), dim3(NWAVES * 64), LDS_BYTES, stream, a);
        orc::sublayer(stream, I, ob, sub);
        if (s4 == 0) {
            const unsigned short* PROJ = (const unsigned short*)(ws + WS_R1 + R1_PROJ); const unsigned short* MIX = (const unsigned short*)(ws + WS_R1 + R1_MIX);
            dbg::cmp(stream, PROJ + 512, 1, NPROJ, 1.f, BIGo + 512, NPROJ, T, 1024, ac + 0);
            dbg::cmp(stream, PROJ, 1, NPROJ, 1.f / attn_body::C2, BIGo, NPROJ, T, 512, ac + 2);
            dbg::cmp(stream, MIX + 512, 1, D, 1.f, Ho + 512, D, T, 512, ac + 4);
            dbg::cmp(stream, MIX, 1, D, 1.f, Ho, D, T, 512, ac + 6);
            dbg::cmp(stream, Xf, 1, D, 1.f, Xo, D, T, D, ac + 8);
        } else if (s4 == 1) {
            const unsigned short* HB = (const unsigned short*)(ws + WS_R1 + R1_HB);
            dbg::cmp(stream, HB + (size_t)8192 * DFF, 1, DFF, 1.f, BIGo, DFF, 8192, DFF, ac + 10);
            dbg::cmp(stream, Xf, 1, D, 1.f, Xo, D, T, D, ac + 12);
        } else if (s4 == 2) {
            const unsigned short* V = (const unsigned short*)(ws + WS_R1 + R1_V);
            dbg::cmp(stream, V, 1, D, 1.f, Ho, D, T, D, ac + 14);
            dbg::cmp(stream, Xf, 1, D, 1.f, Xo, D, T, D, ac + 16);
        } else if (pair == 0) {
            dbg::cmp(stream, Xf, 1, D, 1.f, Xo, D, T, D, ac + 18);
        }
    }
    hipLaunchKernelGGL(orc::k_rmsnorm, dim3(T / 4), dim3(256), 0, stream, (const float*)Xo, I.final_norm_g, (float*)d_out, T);
    dbg::cmp(stream, fout, 0, D, 1.f, (const float*)d_out, D, T, D, acc + 2 * 19);
    hipLaunchKernelGGL(dbg::k_report, dim3(1), dim3(64), 0, stream, (float*)d_out, (const float*)acc, 20, 0.03f, (int)MK_REPORT);
#endif
}
```

```cpp
#include <hip/hip_runtime.h>
#include <cstdio>
#include <cstdint>
#include <cmath>
namespace pg8 {
#define PG8_LAS __attribute__((address_space(3)))
typedef unsigned short bf16_t;
typedef short bf16x8 __attribute__((ext_vector_type(8)));
typedef float f32x4 __attribute__((ext_vector_type(4)));
typedef unsigned u32x4 __attribute__((ext_vector_type(4)));
typedef int i32x4 __attribute__((ext_vector_type(4)));
typedef int i32x8 __attribute__((ext_vector_type(8)));
typedef float f32x8 __attribute__((ext_vector_type(8)));
constexpr int F8_WSHIFT = 5, F8_W2SHIFT = 6, F8_HSHIFT = 4, F8_XSHIFT = 2, F8_FW2SHIFT = 5;
__host__ __device__ constexpr int f8_scale(int shift) { return (127 - shift) * 0x01010101; }
constexpr int BM = 256, BK = 64, HALF = 128, HTB = HALF * BK * 2  , STAGE_BYTES = 8 * HTB, NXCD = 8, WGM = 8;

__host__ __device__ __forceinline__ int lds_byte(int r, int c) { const int st = (r >> 4) * 2 + (c >> 5), rr = r & 15, cc = c & 31, ob = rr * 64 + cc * 2; return st * 1024 + (ob ^ (((ob >> 9) & 1) << 5)); }
__host__ __device__ __forceinline__ void stage_rc(int b, int& R, int& C) { const int st = b / 1024, sb = b % 1024, swz = sb ^ (((sb >> 9) & 1) << 5); R = (st >> 1) * 16 + swz / 64; C = (st & 1) * 32 + (swz % 64) / 2; }
__host__ __device__ __forceinline__ int perm32(int rho) { const int n = rho >> 4, i = rho & 15; return 8 * (i >> 2) + 4 * n + (i & 3); }

struct Unit { int pm, pn, am; size_t ea, eb; };
struct Gemm { const bf16_t* A; const bf16_t* Bt; int M, N, K, ldk; int f8sw, f8sa; };

struct StaticOrder {
    int nM, nN, nwg, G, c;
    __host__ __device__ void init(int M, int N, int G_, int c_) { nM = M / BM; nN = N / BM; nwg = nM * nN; G = G_; c = c_; }
    __host__ __device__ bool next(int i, Unit& u) const {
        const long L = (long)i * G + c; if (L >= nwg) return false;
        int wgid = (int)L; { const int q = nwg / NXCD, r = nwg % NXCD, xcd = wgid % NXCD, off = wgid / NXCD; wgid = (xcd < r ? xcd * (q + 1) : r * (q + 1) + (xcd - r) * q) + off; }
        const int nig = WGM * nN, gid = wgid / nig, fm = gid * WGM, gsz = (nM - fm) < WGM ? (nM - fm) : WGM;
        u.pm = fm + ((wgid % nig) % gsz); u.pn = (wgid % nig) / gsz; u.am = u.pm; u.ea = 0; u.eb = 0; return true;
    }
    __device__ __forceinline__ void a_ready(const Unit&) const {}
    __device__ __forceinline__ void done(const Unit&) const {}
};

__device__ __forceinline__ unsigned cvt_pk_bf16(float lo, float hi) { unsigned r; asm volatile("v_cvt_pk_bf16_f32 %0, %1, %2" : "=v"(r) : "v"(lo), "v"(hi)); return r; }
__device__ __forceinline__ float sigmoid_fast(float x) { return __builtin_amdgcn_rcpf(1.0f + __builtin_amdgcn_exp2f(-1.4426950408889634f * x)); }

struct MoeOrder {
    StaticOrder so; int cb[7]; size_t estride;
    __device__ __forceinline__ void load_cb(const int* CB) {
#pragma unroll
        for (int e = 0; e < 7; ++e) cb[e] = __builtin_amdgcn_readfirstlane(CB[e]); }
    __device__ __forceinline__ int expert_of(int pm) const { int e = 0;
#pragma unroll
        for (int j = 0; j < 7; ++j) e += (pm >= cb[j]) ? 1 : 0;
        return e; }
    __device__ bool next(int i, Unit& u) const { if (!so.next(i, u)) return false; u.eb = (size_t)expert_of(u.pm) * estride; return true; }
    __device__ __forceinline__ void a_ready(const Unit&) const {}
    __device__ __forceinline__ void done(const Unit&) const {}
};

struct TailOrder {
    int nsu, G, c, nfc, KS, kslice; int cb[7]; size_t estride;
    __device__ bool next(int i, Unit& u) const {
        const int L = i * G + c; if (L >= nsu) return false;
        const int ks = L % KS, r = L / KS, pn = r & 3, tc = r >> 2;
        u.pm = ks * 8 + tc; u.pn = pn; u.am = nfc + tc; u.ea = (size_t)ks * kslice * 2; int e = 0;
#pragma unroll
        for (int j = 0; j < 7; ++j) e += (nfc + tc >= cb[j]) ? 1 : 0;
        u.eb = (size_t)e * estride + (size_t)ks * kslice * 2; return true;
    }
    __device__ __forceinline__ void a_ready(const Unit&) const {}
    __device__ __forceinline__ void done(const Unit&) const {}
};

__device__ __forceinline__ float row_rstd(const float* ssq4, int row, float inv_n, float eps) {
    const f32x4 a = *(const f32x4*)(ssq4 + (size_t)row * 4);
    return 1.0f / sqrtf(((a[0] + a[1]) + (a[2] + a[3])) * inv_n + eps);
}
struct EpiProj {
    static constexpr bool PERM = true, AFTER_DRAIN = false;
    bf16_t* O; int ldc; unsigned smask; float sc; const float* ssq4; float inv_n, eps;
    __device__ __forceinline__ void operator()(const f32x4 (&acc)[2][2][4][2], const Unit& u, int wr, int wc, int fr, int fq) const {
        const int row0 = u.pm * BM + wr * 64 + fr, col0 = u.pn * BM + wc * 32 + 8 * fq; const float s = ((smask >> u.pn) & 1u) ? sc : 1.f;
#pragma unroll
        for (int ai = 0; ai < 2; ++ai)
#pragma unroll
            for (int m = 0; m < 4; ++m) { const int row = row0 + ai * HALF + m * 16; bf16_t* rowp = O + (size_t)row * ldc + col0; const float rs = ssq4 ? s * row_rstd(ssq4, row, inv_n, eps) : s;
#pragma unroll
                for (int bj = 0; bj < 2; ++bj) { const f32x4 v0 = acc[ai][bj][m][0] * rs, v1 = acc[ai][bj][m][1] * rs;
                    u32x4 w; w.x = cvt_pk_bf16(v0[0], v0[1]); w.y = cvt_pk_bf16(v0[2], v0[3]); w.z = cvt_pk_bf16(v1[0], v1[1]); w.w = cvt_pk_bf16(v1[2], v1[3]);
                    *(u32x4*)(rowp + bj * HALF) = w; } }
    }
};
struct EpiSwiglu {
    static constexpr bool PERM = true, AFTER_DRAIN = false;
    bf16_t* O; int ldc; const float* ssq4; float inv_n, eps; float f8s;
    __device__ __forceinline__ void operator()(const f32x4 (&acc)[2][2][4][2], const Unit& u, int wr, int wc, int fr, int fq) const {
        const int row0 = u.pm * BM + wr * 64 + fr, col0 = u.pn * HALF + wc * 32 + 8 * fq;
#pragma unroll
        for (int ai = 0; ai < 2; ++ai)
#pragma unroll
            for (int m = 0; m < 4; ++m) { const int row = row0 + ai * HALF + m * 16; bf16_t* rowp = O + (size_t)row * ldc + col0; const float rs = ssq4 ? row_rstd(ssq4, row, inv_n, eps) : 1.0f;
                float h[8];
#pragma unroll
                for (int n = 0; n < 2; ++n)
#pragma unroll
                    for (int i = 0; i < 4; ++i) { const float g = acc[ai][0][m][n][i] * rs, up = acc[ai][1][m][n][i] * rs; h[4 * n + i] = g * sigmoid_fast(g) * up; }
                if (f8s != 0.f) { typedef unsigned u32x2 __attribute__((ext_vector_type(2)));
#pragma unroll
                    for (int i = 0; i < 8; ++i) h[i] = __builtin_amdgcn_fmed3f(h[i] * f8s, -400.f, 400.f);
                    int w0 = __builtin_amdgcn_cvt_pk_fp8_f32(h[0], h[1], 0, false); w0 = __builtin_amdgcn_cvt_pk_fp8_f32(h[2], h[3], w0, true);
                    int w1 = __builtin_amdgcn_cvt_pk_fp8_f32(h[4], h[5], 0, false); w1 = __builtin_amdgcn_cvt_pk_fp8_f32(h[6], h[7], w1, true);
                    *(u32x2*)((unsigned char*)O + (size_t)row * ldc + col0) = (u32x2){(unsigned)w0, (unsigned)w1}; }
                else {
                u32x4 w; w.x = cvt_pk_bf16(h[0], h[1]); w.y = cvt_pk_bf16(h[2], h[3]); w.z = cvt_pk_bf16(h[4], h[5]); w.w = cvt_pk_bf16(h[6], h[7]);
                *(u32x4*)rowp = w; } }
    }
};
struct EpiGlu {
    static constexpr bool PERM = true, AFTER_DRAIN = false;
    bf16_t* O; int ldc; const float* bias; int nh; const float* ssq4; float inv_n, eps;
    __device__ __forceinline__ void operator()(const f32x4 (&acc)[2][2][4][2], const Unit& u, int wr, int wc, int fr, int fq) const {
        const int row0 = u.pm * BM + wr * 64 + fr, col0 = u.pn * HALF + wc * 32 + 8 * fq;
        const f32x4 ba0 = *(const f32x4*)(bias + col0), ba1 = *(const f32x4*)(bias + col0 + 4), bg0 = *(const f32x4*)(bias + nh + col0), bg1 = *(const f32x4*)(bias + nh + col0 + 4);
#pragma unroll
        for (int ai = 0; ai < 2; ++ai)
#pragma unroll
            for (int m = 0; m < 4; ++m) { const int row = row0 + ai * HALF + m * 16; bf16_t* rowp = O + (size_t)row * ldc + col0; const float rs = ssq4 ? row_rstd(ssq4, row, inv_n, eps) : 1.0f;
                const f32x4 a0 = acc[ai][0][m][0] * rs + ba0, a1 = acc[ai][0][m][1] * rs + ba1, g0 = acc[ai][1][m][0] * rs + bg0, g1 = acc[ai][1][m][1] * rs + bg1;
                float h[8];
#pragma unroll
                for (int i = 0; i < 4; ++i) { h[i] = a0[i] * sigmoid_fast(g0[i]); h[4 + i] = a1[i] * sigmoid_fast(g1[i]); }
                u32x4 w; w.x = cvt_pk_bf16(h[0], h[1]); w.y = cvt_pk_bf16(h[2], h[3]); w.z = cvt_pk_bf16(h[4], h[5]); w.w = cvt_pk_bf16(h[6], h[7]);
                *(u32x4*)rowp = w; }
    }
};
struct EpiResX {
    static constexpr bool PERM = false, AFTER_DRAIN = true;
    const bf16_t* baseb; const float* basef; bf16_t* out; int ldc; const float* bias; float* ssq4; unsigned char* x8; float x8s;
    __device__ __forceinline__ void fused(f32x4 (&acc)[2][2][4][2], const Unit& u, int wr, int wc, int fr, int fq, PG8_LAS unsigned char* lds, int wid, int lane) const {
        typedef unsigned u32x2 __attribute__((ext_vector_type(2)));
        PG8_LAS float* P = (PG8_LAS float*)lds;
        const int col0 = u.pn * BM + wc * 32 + 4 * fq;
        f32x4 bv[2][2];
#pragma unroll
        for (int bj = 0; bj < 2; ++bj)
#pragma unroll
            for (int n = 0; n < 2; ++n) bv[bj][n] = bias ? *(const f32x4*)(bias + col0 + bj * HALF + n * 16) : (f32x4){0.f, 0.f, 0.f, 0.f};
#pragma unroll
        for (int ai = 0; ai < 2; ++ai) {
            f32x4 bs[4][2][2];
            if (basef) {
#pragma unroll
                for (int m = 0; m < 4; ++m) { const size_t off = (size_t)(u.pm * BM + ai * HALF + wr * 64 + m * 16 + fr) * ldc + col0;
#pragma unroll
                    for (int bj = 0; bj < 2; ++bj)
#pragma unroll
                        for (int n = 0; n < 2; ++n) bs[m][bj][n] = *(const f32x4*)(basef + off + bj * HALF + n * 16); }
            } else {
                u32x2 bw[4][2][2];
#pragma unroll
                for (int m = 0; m < 4; ++m) { const size_t off = (size_t)(u.pm * BM + ai * HALF + wr * 64 + m * 16 + fr) * ldc + col0;
#pragma unroll
                    for (int bj = 0; bj < 2; ++bj)
#pragma unroll
                        for (int n = 0; n < 2; ++n) bw[m][bj][n] = *(const u32x2*)(baseb + off + bj * HALF + n * 16); }
#pragma unroll
                for (int m = 0; m < 4; ++m)
#pragma unroll
                    for (int bj = 0; bj < 2; ++bj)
#pragma unroll
                        for (int n = 0; n < 2; ++n) { const u32x2 w = bw[m][bj][n]; bs[m][bj][n] = (f32x4){__uint_as_float(w.x << 16), __uint_as_float(w.x & 0xffff0000u), __uint_as_float(w.y << 16), __uint_as_float(w.y & 0xffff0000u)}; }
            }
#pragma unroll
            for (int m = 0; m < 4; ++m) { const int rl = ai * HALF + wr * 64 + m * 16 + fr; const size_t off = (size_t)(u.pm * BM + rl) * ldc + col0; float ss = 0.f;
#pragma unroll
                for (int bj = 0; bj < 2; ++bj)
#pragma unroll
                    for (int n = 0; n < 2; ++n) { const f32x4 o = bs[m][bj][n] + acc[ai][bj][m][n] + bv[bj][n]; u32x2 w; w.x = cvt_pk_bf16(o[0], o[1]); w.y = cvt_pk_bf16(o[2], o[3]); *(u32x2*)(out + off + bj * HALF + n * 16) = w;
                        const float r0 = __uint_as_float(w.x << 16), r1 = __uint_as_float(w.x & 0xffff0000u), r2 = __uint_as_float(w.y << 16), r3 = __uint_as_float(w.y & 0xffff0000u); ss += (r0 * r0 + r1 * r1) + (r2 * r2 + r3 * r3);
                        if (x8) { int q8 = __builtin_amdgcn_cvt_pk_fp8_f32(__builtin_amdgcn_fmed3f(r0 * x8s, -440.f, 440.f), __builtin_amdgcn_fmed3f(r1 * x8s, -440.f, 440.f), 0, false); q8 = __builtin_amdgcn_cvt_pk_fp8_f32(__builtin_amdgcn_fmed3f(r2 * x8s, -440.f, 440.f), __builtin_amdgcn_fmed3f(r3 * x8s, -440.f, 440.f), q8, true);     *(int*)(x8 + off + bj * HALF + n * 16) = q8; } }
                ss += __shfl_xor(ss, 16); ss += __shfl_xor(ss, 32);
                if (fq == 0) P[rl * 4 + wc] = ss; }
            asm volatile("" ::: "memory"); }
        asm volatile("s_waitcnt lgkmcnt(0)" ::: "memory"); __builtin_amdgcn_s_barrier(); asm volatile("" ::: "memory");
        const int tid = wid * 64 + lane;
        if (tid < 256) { const f32x4 q = *(const PG8_LAS f32x4*)(P + tid * 4); ssq4[(size_t)(u.pm * BM + tid) * 4 + u.pn] = (q[0] + q[1]) + (q[2] + q[3]); }
    }
};

template <class Epi, class Sched, bool ALIGN_EPI = false, bool SP2 = false, bool F8 = false>
__device__ __forceinline__ void gemm_phase(PG8_LAS unsigned char* lds, const Gemm g, const Sched& S, const Epi& E, const int wid_in  ) {
    int lane_ = (int)__builtin_amdgcn_mbcnt_hi(~0u, __builtin_amdgcn_mbcnt_lo(~0u, 0u)); asm volatile("" : "+v"(lane_));
    const int wid = wid_in, lane = lane_, tid = wid * 64 + lane, wr = wid >> 2, wc = wid & 3, fr = lane & 15, fq = lane >> 4;
    const int K = g.ldk, nt = g.K / BK;
    unsigned voffA[2], voffB[2];
#pragma unroll
    for (int i = 0; i < 2; ++i) { int R, C; stage_rc(tid * 16 + i * 8192, R, C); const int Rb = Epi::PERM ? ((R & ~31) + perm32(R & 31)) : R;
        voffA[i] = (unsigned)(R * K + C) * 2u; voffB[i] = (unsigned)(Rb * K + C) * 2u; }
    const size_t kstep = (size_t)(BK * 2);
    const size_t hstep = (size_t)HALF * K * 2;
    const size_t tstep = 2 * hstep;
    const unsigned ldsw = (unsigned)wid * 1024u;
    const int fcol = fq * 8;
    const int aoff = lds_byte(wr * 64 + fr, fcol), boff = lds_byte(wc * 32 + fr, fcol);
#define PG8_SA(b, h) (((b) * 2 + (h)) * HTB)
#define PG8_SB(b, h) ((4 + (b) * 2 + (h)) * HTB)
#define PG8_STAGE(bufoff, gbase, voff) do { _Pragma("unroll") for (int _i = 0; _i < 2; ++_i) \
        __builtin_amdgcn_global_load_lds((const unsigned*)((const char*)(gbase) + (voff)[_i]), (PG8_LAS unsigned*)(lds + (bufoff) + ldsw + _i * 8192), 16, 0, 0); } while (0)
#define PG8_LD32(base_) __builtin_shufflevector(__builtin_bit_cast(i32x4, *(const PG8_LAS bf16x8*)(base_)), __builtin_bit_cast(i32x4, *(const PG8_LAS bf16x8*)((base_) + 1024)), 0, 1, 2, 3, 4, 5, 6, 7)
#define PG8_LDA(dst, b, h) do { if constexpr (F8) { _Pragma("unroll") for (int m = 0; m < 4; ++m) dst##_8[m] = PG8_LD32(lds + PG8_SA(b, h) + aoff + m * 2048); } \
        else { _Pragma("unroll") for (int m = 0; m < 4; ++m) _Pragma("unroll") for (int k = 0; k < 2; ++k) dst[m][k] = *(const PG8_LAS bf16x8*)(lds + PG8_SA(b, h) + aoff + m * 2048 + k * 1024); } } while (0)
#define PG8_LDB(dst, b, h) do { if constexpr (F8) { _Pragma("unroll") for (int n = 0; n < 2; ++n) dst##_8[n] = PG8_LD32(lds + PG8_SB(b, h) + boff + n * 2048); } \
        else { _Pragma("unroll") for (int n = 0; n < 2; ++n) _Pragma("unroll") for (int k = 0; k < 2; ++k) dst[n][k] = *(const PG8_LAS bf16x8*)(lds + PG8_SB(b, h) + boff + n * 2048 + k * 1024); } } while (0)
#define PG8_MMA(ai, bj, At, Bt) do { __builtin_amdgcn_s_setprio(1); \
        if constexpr (F8) { _Pragma("unroll") for (int m = 0; m < 4; ++m) _Pragma("unroll") for (int n = 0; n < 2; ++n) \
            asm volatile("v_mfma_scale_f32_16x16x128_f8f6f4 %0, %1, %2, %0, %3, %4 op_sel_hi:[0,0,0]" : "+v"(acc[ai][bj][m][n]) : "v"(Bt##_8[n]), "v"(At##_8[m]), "v"(f8sw), "v"(f8sa)); } \
        else { _Pragma("unroll") for (int m = 0; m < 4; ++m) _Pragma("unroll") for (int n = 0; n < 2; ++n) _Pragma("unroll") for (int k = 0; k < 2; ++k) \
            acc[ai][bj][m][n] = __builtin_amdgcn_mfma_f32_16x16x32_bf16(Bt[n][k], At[m][k], acc[ai][bj][m][n], 0, 0, 0); } \
        __builtin_amdgcn_s_setprio(0); } while (0)
#define PG8_WAIT_V(n) asm volatile("s_waitcnt vmcnt(" #n ")" ::: "memory")
#define PG8_WAIT_L(n) asm volatile("s_waitcnt lgkmcnt(" #n ")" ::: "memory")
#define PG8_BAR __builtin_amdgcn_s_barrier()
#define PG8_SCHED __builtin_amdgcn_sched_barrier(0)
    Unit cur, nxt; int ui = 0;
    if (!S.next(0, cur)) return;
    f32x4 acc[2][2][4][2];
#pragma unroll
    for (int a = 0; a < 2; ++a)
#pragma unroll
        for (int b = 0; b < 2; ++b)
#pragma unroll
            for (int m = 0; m < 4; ++m)
#pragma unroll
                for (int n = 0; n < 2; ++n) acc[a][b][m][n] = (f32x4){0.f, 0.f, 0.f, 0.f};
    int f8sw = g.f8sw, f8sa = g.f8sa; (void)f8sw; (void)f8sa;
    bf16x8 At[4][2], B0[2][2], B1[2][2]; i32x8 At_8[4], B0_8[2], B1_8[2];
    const char* cA = (const char*)g.A + (size_t)cur.am * tstep + cur.ea; const char* cB = (const char*)g.Bt + (size_t)cur.pn * tstep + cur.eb;
    S.a_ready(cur);
    if constexpr (SP2) {
        PG8_STAGE(PG8_SB(0, 0), cB, voffB); PG8_STAGE(PG8_SB(0, 1), cB + hstep, voffB); PG8_STAGE(PG8_SA(0, 0), cA, voffA); PG8_STAGE(PG8_SA(0, 1), cA + hstep, voffA);
        if (wr == 1) PG8_BAR;
        PG8_WAIT_V(2); PG8_BAR;
        PG8_STAGE(PG8_SB(1, 0), cB + kstep, voffB); PG8_STAGE(PG8_SA(1, 0), cA + kstep, voffA); PG8_STAGE(PG8_SB(1, 1), cB + hstep + kstep, voffB);
        PG8_WAIT_V(6); PG8_BAR;
    } else {
        PG8_STAGE(PG8_SB(0, 0), cB, voffB); PG8_STAGE(PG8_SA(0, 0), cA, voffA); PG8_STAGE(PG8_SB(0, 1), cB + hstep, voffB); PG8_STAGE(PG8_SA(0, 1), cA + hstep, voffA);
        if (wr == 1) PG8_BAR;
        PG8_WAIT_V(4); PG8_BAR;
        PG8_STAGE(PG8_SB(1, 0), cB + kstep, voffB); PG8_STAGE(PG8_SA(1, 0), cA + kstep, voffA); PG8_STAGE(PG8_SB(1, 1), cB + hstep + kstep, voffB);
        PG8_WAIT_V(6); PG8_BAR;
    }
    for (;;) {
        const bool has_next = S.next(ui + 1, nxt);
        const char* nA = has_next ? (const char*)g.A + (size_t)nxt.am * tstep + nxt.ea : cA; const char* nB = has_next ? (const char*)g.Bt + (size_t)nxt.pn * tstep + nxt.eb : cB;
        for (int t = 0; t < nt; t += 2) {
            const bool last = (t == nt - 2);
            const char* a1 = cA + (size_t)(t + 1) * kstep;
            const char* a2 = last ? nA : cA + (size_t)(t + 2) * kstep; const char* b2 = last ? nB : cB + (size_t)(t + 2) * kstep;
            const char* a3 = a2 + kstep; const char* b3 = b2 + kstep;
            if (last && has_next) S.a_ready(nxt);
            if constexpr (SP2) {
            PG8_LDB(B0, 0, 0); PG8_LDB(B1, 0, 1); PG8_SCHED; PG8_LDA(At, 0, 0); PG8_STAGE(PG8_SA(1, 1), a1 + hstep, voffA);
            PG8_WAIT_V(8); PG8_WAIT_L(0); PG8_BAR; PG8_MMA(0, 0, At, B0); PG8_MMA(0, 1, At, B1); PG8_BAR; PG8_SCHED;
            PG8_LDA(At, 0, 1); PG8_STAGE(PG8_SB(0, 0), b2, voffB); PG8_STAGE(PG8_SB(0, 1), b2 + hstep, voffB); PG8_STAGE(PG8_SA(0, 0), a2, voffA);
            PG8_WAIT_V(8); PG8_WAIT_L(0); PG8_BAR; PG8_MMA(1, 0, At, B0); PG8_MMA(1, 1, At, B1); PG8_BAR; PG8_SCHED;
            PG8_LDB(B0, 1, 0); PG8_LDB(B1, 1, 1); PG8_SCHED; PG8_LDA(At, 1, 0); PG8_STAGE(PG8_SA(0, 1), a2 + hstep, voffA);
            PG8_WAIT_V(8); PG8_WAIT_L(0); PG8_BAR; PG8_MMA(0, 0, At, B0); PG8_MMA(0, 1, At, B1); PG8_BAR; PG8_SCHED;
            PG8_LDA(At, 1, 1); PG8_STAGE(PG8_SB(1, 0), b3, voffB); PG8_STAGE(PG8_SB(1, 1), b3 + hstep, voffB); PG8_STAGE(PG8_SA(1, 0), a3, voffA);
            PG8_WAIT_V(8); PG8_WAIT_L(0); PG8_BAR; PG8_MMA(1, 0, At, B0); PG8_MMA(1, 1, At, B1); PG8_BAR; PG8_SCHED;
            } else {
            PG8_LDB(B0, 0, 0); PG8_SCHED; PG8_LDA(At, 0, 0); PG8_STAGE(PG8_SA(1, 1), a1 + hstep, voffA);
            PG8_WAIT_L(8); PG8_BAR; PG8_WAIT_L(0); PG8_MMA(0, 0, At, B0); PG8_BAR; PG8_SCHED;
            PG8_LDB(B1, 0, 1); PG8_STAGE(PG8_SB(0, 0), b2, voffB);
            PG8_BAR; PG8_WAIT_L(0); PG8_MMA(0, 1, At, B1); PG8_BAR;
            PG8_LDA(At, 0, 1); PG8_STAGE(PG8_SA(0, 0), a2, voffA);
            PG8_BAR; PG8_WAIT_L(0); PG8_MMA(1, 0, At, B0); PG8_BAR; PG8_SCHED;
            PG8_STAGE(PG8_SB(0, 1), b2 + hstep, voffB);
            PG8_WAIT_V(6); PG8_BAR; PG8_MMA(1, 1, At, B1); PG8_BAR;
            PG8_LDB(B0, 1, 0); PG8_SCHED; PG8_LDA(At, 1, 0); PG8_STAGE(PG8_SA(0, 1), a2 + hstep, voffA);
            PG8_WAIT_L(8); PG8_BAR; PG8_WAIT_L(0); PG8_MMA(0, 0, At, B0); PG8_BAR; PG8_SCHED;
            PG8_LDB(B1, 1, 1); PG8_STAGE(PG8_SB(1, 0), b3, voffB);
            PG8_BAR; PG8_WAIT_L(0); PG8_MMA(0, 1, At, B1); PG8_BAR;
            PG8_LDA(At, 1, 1); PG8_STAGE(PG8_SA(1, 0), a3, voffA);
            PG8_BAR; PG8_WAIT_L(0); PG8_MMA(1, 0, At, B0); PG8_BAR; PG8_SCHED;
            PG8_STAGE(PG8_SB(1, 1), b3 + hstep, voffB);
            PG8_WAIT_V(6); PG8_BAR; PG8_MMA(1, 1, At, B1); PG8_BAR;
            }
        }
        if constexpr (F8) asm volatile("s_nop 15\n\ts_nop 7" ::: "memory");
        if constexpr (ALIGN_EPI) { if (wr == 0) PG8_BAR; }
        if constexpr (!Epi::AFTER_DRAIN) { E(acc, cur, wr, wc, fr, fq); S.done(cur); }
        if (!has_next) break;
#pragma unroll
        for (int a = 0; a < 2; ++a)
#pragma unroll
            for (int b = 0; b < 2; ++b)
#pragma unroll
                for (int m = 0; m < 4; ++m)
#pragma unroll
                    for (int n = 0; n < 2; ++n) acc[a][b][m][n] = (f32x4){0.f, 0.f, 0.f, 0.f};
        cur = nxt; cA = nA; cB = nB; ++ui;
        if constexpr (ALIGN_EPI) { if (wr == 1) PG8_BAR; }
    }
    PG8_WAIT_V(0);
    if constexpr (!ALIGN_EPI) { if (wr == 0) PG8_BAR; }
    PG8_BAR;
    if constexpr (Epi::AFTER_DRAIN) { E.fused(acc, cur, wr, wc, fr, fq, lds, wid, lane); S.done(cur); }
#undef PG8_SA
#undef PG8_SB
#undef PG8_STAGE
#undef PG8_LDA
#undef PG8_LDB
#undef PG8_MMA
#undef PG8_LD32
#undef PG8_WAIT_V
#undef PG8_WAIT_L
#undef PG8_BAR
#undef PG8_SCHED
}
}
#include <hip/hip_bf16.h>
#include <cmath>
namespace attn_body {
using bf16=__hip_bfloat16;
using bf16x8=__attribute__((ext_vector_type(8)))short;
using s16x4=__attribute__((ext_vector_type(4)))short;
using f32x16=__attribute__((ext_vector_type(16)))float;
using u32x4=__attribute__((ext_vector_type(4)))unsigned;
constexpr int BATCH=2,SEQ=8192,D=64,DM=2304,DMO=1024;
constexpr int NW=8,QBLK=32,QB=QBLK*NW,KVBLK=64,NQB=SEQ/QB;
constexpr int ATTN_UNIT_ROWS=QB;
__device__ __forceinline__ int crow(int r,int hi){return (r&3)+8*(r>>2)+4*hi;}
#define SBAR() __builtin_amdgcn_sched_barrier(0)
__device__ __forceinline__ void cmask(f32x16&p0,f32x16&p1,int jb,int qrel,int hi){
  const float NEG=-INFINITY; int kb=64*jb+4*hi;
  #pragma unroll
  for(int r=0;r<16;++r){int kv=kb+(r&3)+8*(r>>2); if(kv>qrel)p0[r]=NEG; if(kv+32>qrel)p1[r]=NEG;}
}

constexpr int NSLOT=3, SLOTB=8192;
constexpr int LDS_K=0, LDS_V=NSLOT*SLOTB, LDS_WS=2*NSLOT*SLOTB, LDS_OST=LDS_WS+NW*64*4, LDS_BYTES=LDS_OST+NW*4096;
constexpr float C2=0.125f*1.4426950408889634f;
__device__ __forceinline__ void glds16(const void*sbase,unsigned voff,unsigned lds_dst){unsigned keep;
  asm volatile("s_mov_b32 %0, m0\n\ts_mov_b32 m0, %2\n\ts_nop 0\n\tglobal_load_lds_dwordx4 %1, %3\n\ts_mov_b32 m0, %0":"=&s"(keep):"v"(voff),"s"(lds_dst),"s"(sbase):"memory");}
__device__ __forceinline__ float max3f(float a,float b,float c){float r;asm("v_max3_f32 %0, %1, %2, %3":"=v"(r):"v"(a),"v"(b),"v"(c));return r;}
__device__ __forceinline__ float max2f(float a,float b){float r;asm("v_max_f32_e32 %0, %1, %2":"=v"(r):"v"(a),"v"(b));return r;}
__device__ __forceinline__ float fadd_s(float a,float b){float r;asm("v_add_f32_e32 %0, %1, %2":"=v"(r):"v"(a),"v"(b));return r;}
__device__ __forceinline__ float fsub_s(float a,float b){float r;asm("v_sub_f32_e32 %0, %1, %2":"=v"(r):"v"(a),"v"(b));return r;}
typedef float f32x2_t __attribute__((ext_vector_type(2))); typedef __bf16 bf16x2_t __attribute__((ext_vector_type(2)));
__device__ __forceinline__ unsigned cvtpk_s(float lo,float hi){f32x2_t v={lo,hi};bf16x2_t b=__builtin_convertvector(v,bf16x2_t);return __builtin_bit_cast(unsigned,b);}
#define WAIT_BAR(N) asm volatile("s_waitcnt vmcnt(" #N ") lgkmcnt(0)\n\ts_barrier":::"memory")

__device__ __forceinline__ void swmask(f32x16&p0,f32x16&p1,int tl,int ql,int hi){
  const float NEG=-INFINITY; int kb=64*tl+4*hi;
  #pragma unroll
  for(int r=0;r<16;++r){int kv=kb+(r&3)+8*(r>>2); if(kv>ql||kv+128<=ql)p0[r]=NEG; if(kv+32>ql||kv+160<=ql)p1[r]=NEG;}
}
__device__ __forceinline__ void qkt(f32x16&p0,f32x16&p1,const char*Kslot,const bf16x8*qr,const f32x16&negm,int r32,int hi){
  const char*kb=Kslot+hi*1024+r32*16;
  #pragma unroll
  for(int d0=0;d0<4;++d0){
    const bf16x8 b0=*reinterpret_cast<const bf16x8*>(kb+d0*2048);
    const bf16x8 b1=*reinterpret_cast<const bf16x8*>(kb+d0*2048+512);
    if(d0==0){p0=__builtin_amdgcn_mfma_f32_32x32x16_bf16(b0,qr[0],negm,0,0,0);p1=__builtin_amdgcn_mfma_f32_32x32x16_bf16(b1,qr[0],negm,0,0,0);}
    else{p0=__builtin_amdgcn_mfma_f32_32x32x16_bf16(b0,qr[d0],p0,0,0,0);p1=__builtin_amdgcn_mfma_f32_32x32x16_bf16(b1,qr[d0],p1,0,0,0);}}
}
typedef __attribute__((address_space(3))) const char* lds_cptr;
typedef short v4i16_t __attribute__((ext_vector_type(4)));
__device__ __forceinline__ void kload8(bf16x8*kf,lds_cptr kp){
  kf[0]=*(const __attribute__((address_space(3))) bf16x8*)(kp);      kf[1]=*(const __attribute__((address_space(3))) bf16x8*)(kp+512);
  kf[2]=*(const __attribute__((address_space(3))) bf16x8*)(kp+2048); kf[3]=*(const __attribute__((address_space(3))) bf16x8*)(kp+2560);
  kf[4]=*(const __attribute__((address_space(3))) bf16x8*)(kp+4096); kf[5]=*(const __attribute__((address_space(3))) bf16x8*)(kp+4608);
  kf[6]=*(const __attribute__((address_space(3))) bf16x8*)(kp+6144); kf[7]=*(const __attribute__((address_space(3))) bf16x8*)(kp+6656);
}
__device__ __forceinline__ void kload2(bf16x8*kf,lds_cptr kp,int j){ kf[2*j]=*(const __attribute__((address_space(3))) bf16x8*)(kp+j*2048); kf[2*j+1]=*(const __attribute__((address_space(3))) bf16x8*)(kp+j*2048+512); }
__device__ __forceinline__ s16x4 vtr(lds_cptr p){ return __builtin_bit_cast(s16x4,__builtin_amdgcn_ds_read_tr16_b64_v4i16((__attribute__((address_space(3))) v4i16_t*)p)); }
__device__ __forceinline__ float rowmax(const f32x16&p0,const f32x16&p1){
  float a=max3f(p0[0],p0[1],p1[0]),b=max3f(p0[2],p0[3],p1[1]);a=max3f(a,p1[2],p1[3]);
  #pragma unroll
  for(int r=4;r<16;r+=4){a=max3f(a,p0[r],p0[r+1]);b=max3f(b,p0[r+2],p0[r+3]);a=max3f(a,p1[r],p1[r+1]);b=max3f(b,p1[r+2],p1[r+3]);}
  const float m=max2f(a,b);
  auto rr=__builtin_amdgcn_permlane32_swap(__float_as_uint(m),__float_as_uint(m),false,false);
  return max2f(__uint_as_float(rr[0]),__uint_as_float(rr[1]));
}
__device__ __forceinline__ void pv(f32x16*o,int vb,bf16x8 pa0,bf16x8 pa1,bf16x8 pa2,bf16x8 pa3){
  #pragma unroll
  for(int d0=0;d0<2;++d0){s16x4 lo[4],hi[4];
    #pragma unroll
    for(int ks=0;ks<4;++ks){
      asm volatile("ds_read_b64_tr_b16 %0,%1 offset:%c2":"=&v"(lo[ks]):"v"(vb),"i"(d0*4096+ks*1024):"memory");
      asm volatile("ds_read_b64_tr_b16 %0,%1 offset:%c2":"=&v"(hi[ks]):"v"(vb),"i"(d0*4096+ks*1024+512):"memory");}
    asm volatile("s_waitcnt lgkmcnt(0)":::"memory");SBAR();
    #define PK(k) (bf16x8){lo[k][0],lo[k][1],lo[k][2],lo[k][3],hi[k][0],hi[k][1],hi[k][2],hi[k][3]}
    o[d0]=__builtin_amdgcn_mfma_f32_32x32x16_bf16(pa0,PK(0),o[d0],0,0,0);
    o[d0]=__builtin_amdgcn_mfma_f32_32x32x16_bf16(pa1,PK(1),o[d0],0,0,0);
    o[d0]=__builtin_amdgcn_mfma_f32_32x32x16_bf16(pa2,PK(2),o[d0],0,0,0);
    o[d0]=__builtin_amdgcn_mfma_f32_32x32x16_bf16(pa3,PK(3),o[d0],0,0,0);
    #undef PK
  }
}

#ifndef ATTN_STORE16
#define ATTN_STORE16(p,v) (*(u32x4*)(p)=(v))
#endif
template<int THRL,bool SWA> __device__ __forceinline__ void attn_unit(int qb,const bf16*Q,const bf16*__restrict__ K,const bf16*__restrict__ V,bf16*O,float sink2,char*shm,const int wid_in){
  int lane_=(int)__builtin_amdgcn_mbcnt_hi(~0u,__builtin_amdgcn_mbcnt_lo(~0u,0u)); asm volatile("":"+v"(lane_));
  const int wid=wid_in,lane=lane_,tid=wid*64+lane,r32=lane&31,hi=lane>>5; (void)tid;
  const int q0=qb*QB; const int t_lo=SWA?((q0>=128)?(q0/KVBLK-2):0):0;
  const bf16*Qw=Q+(long)(q0+wid*QBLK)*DM;
  const bf16*Kh=K+(long)t_lo*KVBLK*DM,*Vh=V+(long)t_lo*KVBLK*DM;
  const unsigned lds0=(unsigned)(uintptr_t)shm;
  float*wsf=(float*)(shm+LDS_WS)+wid*64;
  const unsigned koff=(unsigned)(lane*DM+wid*8)*2u;
  const unsigned voff=(unsigned)((16*(wid&3)+(lane>>2))*DM+(wid>>2)*32+(lane&3)*8)*2u;
  const unsigned kdst=lds0+LDS_K+wid*1024, vdst=lds0+LDS_V+wid*1024;
  #define DMA_K(t,slot) glds16(Kh+(long)(t)*KVBLK*DM,koff,(unsigned)__builtin_amdgcn_readfirstlane(kdst+(slot)))
  #define DMA_V(t,slot) glds16(Vh+(long)(t)*KVBLK*DM,voff,(unsigned)__builtin_amdgcn_readfirstlane(vdst+(slot)))
  const int vb0=(int)(lds0+LDS_V)+((lane>>4)&1)*32+(lane&3)*8+(4*hi+((lane&15)>>2))*64;
  const char*Kbase=shm+LDS_K; bf16x8 kf[8];
  const lds_cptr shm3=(lds_cptr)shm; const lds_cptr kp0=shm3+LDS_K+hi*1024+r32*16; const lds_cptr vp0=shm3+LDS_V+((lane>>4)&1)*32+(lane&3)*8+(4*hi+((lane&15)>>2))*64;
  const int NT=(q0+QB)/KVBLK-t_lo;
  DMA_K(0,0);DMA_V(0,0);DMA_K(1,SLOTB);
  bf16x8 qr[4];
  #pragma unroll
  for(int d0=0;d0<4;++d0)qr[d0]=*reinterpret_cast<const bf16x8*>(&Qw[(long)r32*DM+d0*16+hi*8]);
  float z_=0.f; asm volatile("":"+v"(z_));
  float mhat=z_,l_reg=z_;f32x16 o[2],negm;
  _Pragma("unroll") for(int r=0;r<16;++r){o[0][r]=z_;o[1][r]=z_;negm[r]=z_;} asm volatile("":"+v"(negm));
  const int qrel=wid*QBLK+r32; const int ql=q0-t_lo*KVBLK+qrel;
  #define CMASK(P0,P1,t) do{ if(SWA){swmask(P0,P1,(t),ql,hi);} else {int jb_=(t)-(NT-4); if(jb_>=0)cmask(P0,P1,jb_,qrel,hi);} }while(0)
  bool resc=false;
  #define START(P0,P1) do{ const float rm=rowmax(P0,P1); resc=false; \
    { const float dl=SWA?max2f(rm,sink2):rm; if(SWA){l_reg=(hi==0)?__builtin_amdgcn_exp2f(sink2-dl):0.f;} mhat=fadd_s(mhat,dl); \
      _Pragma("unroll") for(int r=0;r<16;++r){P0[r]=fsub_s(P0[r],dl);P1[r]=fsub_s(P1[r],dl);} \
      _Pragma("unroll") for(int r=0;r<16;++r)negm[r]=-mhat; asm volatile("":"+v"(negm)); } \
    _Pragma("unroll") for(int r=0;r<16;++r)P0[r]=__builtin_amdgcn_exp2f(P0[r]); }while(0)
  #define RESC() do{ if(resc){ asm volatile("s_waitcnt lgkmcnt(0)":::"memory"); \
      _Pragma("unroll") for(int d_=0;d_<2;++d_) _Pragma("unroll") for(int r=0;r<16;++r)o[d_][r]*=wsf[crow(r,hi)]; } }while(0)
  f32x16 pA0,pA1,pB0,pB1;
  int sl_prev=0,sl_cur=0,sl_next=SLOTB;
  #define ROT() do{sl_prev=sl_cur;sl_cur=sl_next;sl_next=(sl_next==(NSLOT-1)*SLOTB)?0:sl_next+SLOTB;}while(0)
  DMA_K(2,2*SLOTB);
  WAIT_BAR(3);
  qkt(pA0,pA1,Kbase,qr,negm,r32,hi);asm volatile("s_nop 15\n\ts_nop 7":"+v"(pA0),"+v"(pA1));CMASK(pA0,pA1,0);
  START(pA0,pA1);
  _Pragma("unroll") for(int r=0;r<16;++r)pA1[r]=__builtin_amdgcn_exp2f(pA1[r]);
  WAIT_BAR(0);
  DMA_K(3,0);DMA_V(1,SLOTB);
  ROT();
  kload8(kf,kp0+sl_cur);
  WAIT_BAR(2);
  s16x4 vlo[8],vhi[8]; u32x4 pw0,pw1,pw2,pw3;
  #define PKW(P,B) cvtpk_s(P[B],P[B+1])
  #define PAF(k) __builtin_bit_cast(bf16x8,pw##k)
  #define VFR(i) (bf16x8){vlo[i][0],vlo[i][1],vlo[i][2],vlo[i][3],vhi[i][0],vhi[i][1],vhi[i][2],vhi[i][3]}
  #define PIN(x) asm volatile("":"+v"(x))
  #define MX3(a,b,c) __builtin_fmaxf(__builtin_fmaxf((a),(b)),(c))
  #define GAPA(MF,A0,A1,A2,A3,W0,W1,PW) do{ MF; sacc+=A0; sacc+=A1; sacc+=A2; sacc+=A3; PIN(sacc); W0; W1; PIN(PW); SBAR(); }while(0)
  #define EX(v) __builtin_amdgcn_exp2f(v)
  #define GAPB(MF,X,B) do{ MF; X[B]=EX(X[B]); X[B+1]=EX(X[B+1]); X[B+2]=EX(X[B+2]); X[B+3]=EX(X[B+3]); PIN(X); SBAR(); }while(0)
  #define VRD(i) do{ vlo[i]=vtr(vp_+(((i)>>2)*4096+((i)&3)*1024)); vhi[i]=vtr(vp_+(((i)>>2)*4096+((i)&3)*1024+512)); }while(0)
  #define KRD(G,j) do{ if(G){ kload2(kf,kp0+sl_next,j); SBAR(); } }while(0)
  #define STEP(C0,C1,P0,P1,t,GK,GV,GL) do{ SBAR(); \
    const lds_cptr vp_=vp0+sl_prev; \
    VRD(0); SBAR(); float sacc=(P0[0]+P0[1]); \
    GAPA(C0=__builtin_amdgcn_mfma_f32_32x32x16_bf16(kf[0],qr[0],negm,0,0,0), P0[2],P0[3],P0[4],P0[5],     pw0[0]=PKW(P0,0), pw0[1]=PKW(P0,2), pw0); \
    VRD(4); SBAR(); GAPA(C1=__builtin_amdgcn_mfma_f32_32x32x16_bf16(kf[1],qr[0],negm,0,0,0), P0[6],P0[7],P0[8],P0[9],     pw0[2]=PKW(P0,4), pw0[3]=PKW(P0,6), pw0); \
    VRD(1); SBAR(); GAPA(C0=__builtin_amdgcn_mfma_f32_32x32x16_bf16(kf[2],qr[1],C0,0,0,0),   P0[10],P0[11],P0[12],P0[13], pw1[0]=PKW(P0,8), pw1[1]=PKW(P0,10), pw1); \
    VRD(5); SBAR(); GAPA(C1=__builtin_amdgcn_mfma_f32_32x32x16_bf16(kf[3],qr[1],C1,0,0,0),   P0[14],P0[15],P1[0],P1[1],   pw1[2]=PKW(P0,12),pw1[3]=PKW(P0,14), pw1); \
    VRD(2); SBAR(); GAPA(C0=__builtin_amdgcn_mfma_f32_32x32x16_bf16(kf[4],qr[2],C0,0,0,0),   P1[2],P1[3],P1[4],P1[5],     pw2[0]=PKW(P1,0), pw2[1]=PKW(P1,2), pw2); \
    VRD(6); SBAR(); GAPA(C1=__builtin_amdgcn_mfma_f32_32x32x16_bf16(kf[5],qr[2],C1,0,0,0),   P1[6],P1[7],P1[8],P1[9],     pw2[2]=PKW(P1,4), pw2[3]=PKW(P1,6), pw2); \
    VRD(3); SBAR(); GAPA(C0=__builtin_amdgcn_mfma_f32_32x32x16_bf16(kf[6],qr[3],C0,0,0,0),   P1[10],P1[11],P1[12],P1[13], pw3[0]=PKW(P1,8), pw3[1]=PKW(P1,10), pw3); \
    VRD(7); SBAR(); GAPA(C1=__builtin_amdgcn_mfma_f32_32x32x16_bf16(kf[7],qr[3],C1,0,0,0),   P1[14],P1[15],0.f,0.f,       pw3[2]=PKW(P1,12),pw3[3]=PKW(P1,14), pw3); \
    l_reg+=sacc; \
    if(GK){DMA_K((t)+3,sl_cur);} if(GV){DMA_V((t)+1,sl_next);} \
    CMASK(C0,C1,t); \
    { float a=MX3(C0[0],C0[1],C1[0]),b=MX3(C0[2],C0[3],C1[1]); a=MX3(a,C1[2],C1[3]); \
      _Pragma("unroll") for(int r=4;r<16;r+=4){a=MX3(a,C0[r],C0[r+1]);b=MX3(b,C0[r+2],C0[r+3]);a=MX3(a,C1[r],C1[r+1]);b=MX3(b,C1[r+2],C1[r+3]);} \
      float rm=__builtin_fmaxf(a,b); { auto rr=__builtin_amdgcn_permlane32_swap(__float_as_uint(rm),__float_as_uint(rm),false,false); rm=__builtin_fmaxf(__uint_as_float(rr[0]),__uint_as_float(rr[1])); } \
      resc=false; \
      if(__builtin_expect(__any(rm>(float)THRL),0)){ const float dl=__builtin_fmaxf(rm,0.f); mhat+=dl; \
        _Pragma("unroll") for(int r=0;r<16;++r){C0[r]-=dl;C1[r]-=dl;} \
        _Pragma("unroll") for(int r=0;r<16;++r)negm[r]=-mhat; asm volatile("":"+v"(negm)); \
        const float f=__builtin_amdgcn_exp2f(-dl); l_reg*=f; if(hi==0)wsf[r32]=f; resc=true; } } \
    SBAR(); \
    GAPB(o[0]=__builtin_amdgcn_mfma_f32_32x32x16_bf16(PAF(0),VFR(0),o[0],0,0,0), C0,0); \
    GAPB(o[1]=__builtin_amdgcn_mfma_f32_32x32x16_bf16(PAF(0),VFR(4),o[1],0,0,0), C0,4); \
    KRD(GL,0); GAPB(o[0]=__builtin_amdgcn_mfma_f32_32x32x16_bf16(PAF(1),VFR(1),o[0],0,0,0), C0,8); \
    KRD(GL,1); GAPB(o[1]=__builtin_amdgcn_mfma_f32_32x32x16_bf16(PAF(1),VFR(5),o[1],0,0,0), C0,12); \
    KRD(GL,2); GAPB(o[0]=__builtin_amdgcn_mfma_f32_32x32x16_bf16(PAF(2),VFR(2),o[0],0,0,0), C1,0); \
    KRD(GL,3); GAPB(o[1]=__builtin_amdgcn_mfma_f32_32x32x16_bf16(PAF(2),VFR(6),o[1],0,0,0), C1,4); \
    GAPB(o[0]=__builtin_amdgcn_mfma_f32_32x32x16_bf16(PAF(3),VFR(3),o[0],0,0,0), C1,8); \
    GAPB(o[1]=__builtin_amdgcn_mfma_f32_32x32x16_bf16(PAF(3),VFR(7),o[1],0,0,0), C1,12); \
    }while(0)
  int t=1;
  #undef CMASK
  #define CMASK(P0,P1,t) do{}while(0)
  for(;t+5<NT;t+=2){
    STEP(pB0,pB1,pA0,pA1,t,true,true,true);     WAIT_BAR(2); RESC(); ROT();
    STEP(pA0,pA1,pB0,pB1,t+1,true,true,true);   WAIT_BAR(2); RESC(); ROT();
  }
  #undef CMASK
  #define CMASK(P0,P1,t) do{ if(SWA){swmask(P0,P1,(t),ql,hi);} else {int jb_=(t)-(NT-4); if(jb_>=0)cmask(P0,P1,jb_,qrel,hi);} }while(0)
  #define ENDW(tt) do{ if((tt)+3<NT){WAIT_BAR(2);} else if((tt)+2<NT){WAIT_BAR(1);} else {WAIT_BAR(0);} }while(0)
  for(;t+1<NT;t+=2){
    STEP(pB0,pB1,pA0,pA1,t,(t+3<NT),(t+1<NT),(t+1<NT));       ENDW(t);   RESC(); ROT();
    STEP(pA0,pA1,pB0,pB1,t+1,(t+4<NT),(t+2<NT),(t+2<NT));     ENDW(t+1); RESC(); ROT();
  }
  STEP(pB0,pB1,pA0,pA1,NT-1,false,false,false); RESC();
  { float sacc=pB0[0]+pB0[1]; _Pragma("unroll") for(int r=2;r<16;++r)sacc+=pB0[r]; _Pragma("unroll") for(int r=0;r<16;++r)sacc+=pB1[r]; l_reg+=sacc;
    pw0=(u32x4){PKW(pB0,0),PKW(pB0,2),PKW(pB0,4),PKW(pB0,6)};pw1=(u32x4){PKW(pB0,8),PKW(pB0,10),PKW(pB0,12),PKW(pB0,14)};pw2=(u32x4){PKW(pB1,0),PKW(pB1,2),PKW(pB1,4),PKW(pB1,6)};pw3=(u32x4){PKW(pB1,8),PKW(pB1,10),PKW(pB1,12),PKW(pB1,14)};
    SBAR(); pv(o,vb0+sl_cur,PAF(0),PAF(1),PAF(2),PAF(3)); }
  #undef PKW
  #undef PAF
  #undef VFR
  #undef PIN
  #undef MX3
  #undef GAPA
  #undef GAPB
  #undef EX
  #undef VRD
  #undef KRD
  #undef STEP
  #undef ENDW
  {auto rr=__builtin_amdgcn_permlane32_swap(__float_as_uint(l_reg),__float_as_uint(l_reg),false,false);l_reg=__uint_as_float(rr[0])+__uint_as_float(rr[1]);}
  if(hi==0)wsf[32+r32]=l_reg;asm volatile("s_waitcnt lgkmcnt(0)":::"memory");
  float rli[16];
  #pragma unroll
  for(int r=0;r<16;++r)rli[r]=__builtin_amdgcn_rcpf(wsf[32+crow(r,hi)]);
  bf16*Ow=O+(long)(q0+wid*QBLK)*DMO;
  { bf16*stg=(bf16*)(shm+LDS_OST)+wid*2048;
    #pragma unroll
    for(int r=0;r<16;++r){const int orow=crow(r,hi);
      #pragma unroll
      for(int d0=0;d0<2;++d0)stg[orow*64+d0*32+r32]=__float2bfloat16(o[d0][r]*rli[r]);}
    asm volatile("s_waitcnt lgkmcnt(0)":::"memory");
    #pragma unroll
    for(int i=0;i<4;++i){const int row=i*8+(lane>>3),ch=lane&7; const u32x4 v=*(const u32x4*)(stg+row*64+ch*8); ATTN_STORE16(Ow+(long)row*DMO+ch*8,v);} }
  asm volatile("s_waitcnt lgkmcnt(0)\n\ts_barrier":::"memory");
  #undef DMA_K
  #undef DMA_V
  #undef CMASK
  #undef START
  #undef RESC
  #undef ROT
}
constexpr int ATTN_LDS_BYTES=LDS_BYTES;

constexpr int V2_SLOTB=16384, L2_K=0, L2_V=NSLOT*SLOTB, L2_WS=L2_V+NSLOT*V2_SLOTB, L2_OST=L2_WS+NW*64*4, ATTN128_LDS_BYTES=L2_OST+NW*8192;
template<int THRL> __device__ __forceinline__ void attn_unit128(int qb,const bf16*Q,const bf16*__restrict__ K,const bf16*__restrict__ V,bf16*O,char*shm,const int wid_in){
  int lane_=(int)__builtin_amdgcn_mbcnt_hi(~0u,__builtin_amdgcn_mbcnt_lo(~0u,0u)); asm volatile("":"+v"(lane_));
  int wid_=wid_in; asm volatile("":"+s"(wid_));
  const int wid=wid_,lane=lane_,r32=lane&31,hi=lane>>5;
  const int q0=qb*QB;
  const bf16*Qw=Q+(long)(q0+wid*QBLK)*DM;
  unsigned lds0_=(unsigned)(uintptr_t)shm; asm volatile("":"+s"(lds0_)); const unsigned lds0=lds0_;
  float*wsf=(float*)(shm+L2_WS)+wid*64;
  const unsigned koff=(unsigned)(lane*DM+wid*8)*2u;
  const unsigned voff=(unsigned)((16*(wid&3)+(lane>>2))*DM+(wid>>2)*32+(lane&3)*8)*2u;
  const unsigned kdst=lds0+L2_K+wid*1024, vdst=lds0+L2_V+wid*1024;
  #define DMA_K(t,slot) glds16(K+(long)(t)*KVBLK*DM,koff,(unsigned)__builtin_amdgcn_readfirstlane(kdst+(slot)))
  #define DMA_V(t,slot) do{ glds16(V+(long)(t)*KVBLK*DM,voff,(unsigned)__builtin_amdgcn_readfirstlane(vdst+2*(slot))); glds16(V+(long)(t)*KVBLK*DM+64,voff,(unsigned)__builtin_amdgcn_readfirstlane(vdst+2*(slot)+8192)); }while(0)
  const int vb0=(int)(lds0+L2_V)+((lane>>4)&1)*32+(lane&3)*8+(4*hi+((lane&15)>>2))*64;
  const char*Kbase=shm+L2_K; bf16x8 kf[8];
  const lds_cptr shm3=(lds_cptr)shm; const lds_cptr kp0=shm3+L2_K+hi*1024+r32*16; const lds_cptr vp0=shm3+L2_V+((lane>>4)&1)*32+(lane&3)*8+(4*hi+((lane&15)>>2))*64;
  const int NT=(q0+QB)/KVBLK;
  DMA_K(0,0);DMA_V(0,0);DMA_K(1,SLOTB);
  bf16x8 qr[4];
  #pragma unroll
  for(int d0=0;d0<4;++d0)qr[d0]=*reinterpret_cast<const bf16x8*>(&Qw[(long)r32*DM+d0*16+hi*8]);
  float z_=0.f; asm volatile("":"+v"(z_));
  float mhat=z_,l_reg=z_;f32x16 o[4];
  _Pragma("unroll") for(int r=0;r<16;++r){o[0][r]=z_;o[1][r]=z_;o[2][r]=z_;o[3][r]=z_;}
  const int qrel=wid*QBLK+r32;
  #define CMASK(P0,P1,t) do{ int jb_=(t)-(NT-4); if(jb_>=0)cmask(P0,P1,jb_,qrel,hi); }while(0)
  bool resc=false;
  #define RESC() do{ if(resc){ asm volatile("s_waitcnt lgkmcnt(0)":::"memory"); \
      _Pragma("unroll") for(int d_=0;d_<4;++d_) _Pragma("unroll") for(int r=0;r<16;++r)o[d_][r]*=wsf[crow(r,hi)]; } }while(0)
  f32x16 pA0,pA1,pB0,pB1;
  int sl_prev=0,sl_cur=0,sl_next=SLOTB;
  #define ROT() do{sl_prev=sl_cur;sl_cur=sl_next;sl_next=(sl_next==(NSLOT-1)*SLOTB)?0:sl_next+SLOTB;}while(0)
  DMA_K(2,2*SLOTB);
  WAIT_BAR(3);
  { const f32x16 zz={};
    const char*kb=Kbase+hi*1024+r32*16;
    #pragma unroll
    for(int d0=0;d0<4;++d0){
      const bf16x8 b0=*reinterpret_cast<const bf16x8*>(kb+d0*2048);
      const bf16x8 b1=*reinterpret_cast<const bf16x8*>(kb+d0*2048+512);
      if(d0==0){pA0=__builtin_amdgcn_mfma_f32_32x32x16_bf16(b0,qr[0],zz,0,0,0);pA1=__builtin_amdgcn_mfma_f32_32x32x16_bf16(b1,qr[0],zz,0,0,0);}
      else{pA0=__builtin_amdgcn_mfma_f32_32x32x16_bf16(b0,qr[d0],pA0,0,0,0);pA1=__builtin_amdgcn_mfma_f32_32x32x16_bf16(b1,qr[d0],pA1,0,0,0);}} }
  asm volatile("s_nop 15\n\ts_nop 7":"+v"(pA0),"+v"(pA1));CMASK(pA0,pA1,0);
  { const float rm=rowmax(pA0,pA1); mhat=fadd_s(mhat,rm);
    _Pragma("unroll") for(int r=0;r<16;++r){pA0[r]=__builtin_amdgcn_exp2f(fsub_s(pA0[r],mhat));pA1[r]=__builtin_amdgcn_exp2f(fsub_s(pA1[r],mhat));} }
  WAIT_BAR(0);
  DMA_K(3,0);DMA_V(1,SLOTB);
  ROT();
  kload8(kf,kp0+sl_cur);
  WAIT_BAR(3);
  s16x4 vl0,vh0,vl1,vh1,vl2,vh2,vl3,vh3; u32x4 pw0,pw1,pw2,pw3;
  #define PKW(P,B) cvtpk_s(P[B],P[B+1])
  #define PAF(k) __builtin_bit_cast(bf16x8,pw##k)
  #define VFRB(b) (bf16x8){vl##b[0],vl##b[1],vl##b[2],vl##b[3],vh##b[0],vh##b[1],vh##b[2],vh##b[3]}
  #define PIN(x) asm volatile("":"+v"(x))
  #define MX3(a,b,c) __builtin_fmaxf(__builtin_fmaxf((a),(b)),(c))
  #define GAPA(MF,A0,A1,A2,A3,W0,W1,PW) do{ MF; sacc+=A0; sacc+=A1; sacc+=A2; sacc+=A3; PIN(sacc); W0; W1; PIN(PW); SBAR(); }while(0)
  #define EX(v) __builtin_amdgcn_exp2f((v)-mhat)
  #define GAPB2(MF,X,B) do{ MF; X[B]=EX(X[B]); X[B+1]=EX(X[B+1]); PIN(X); SBAR(); }while(0)
  #define VRDB(b,n) do{ vl##b=vtr(vp_+((((n)&3))*4096+((n)>>2)*1024)); vh##b=vtr(vp_+((((n)&3))*4096+((n)>>2)*1024+512)); SBAR(); }while(0)
  #define KRD(G,j) do{ if(G){ kload2(kf,kp0+sl_next,j); SBAR(); } }while(0)
  #define ZZ (f32x16){0.f,0.f,0.f,0.f,0.f,0.f,0.f,0.f,0.f,0.f,0.f,0.f,0.f,0.f,0.f,0.f}
  #define PVB(n,b,k,d,X,B) do{ GAPB2(o[d]=__builtin_amdgcn_mfma_f32_32x32x16_bf16(PAF(k),VFRB(b),o[d],0,0,0), X,B); if((n)+4<16){ VRDB(b,(n)+4); } }while(0)
  #define STEP(C0,C1,P0,P1,t,GK,GV,GL) do{ SBAR(); \
    const lds_cptr vp_=vp0+2*sl_prev; \
    float sacc=(P0[0]+P0[1]); \
    GAPA(C0=__builtin_amdgcn_mfma_f32_32x32x16_bf16(kf[0],qr[0],ZZ,0,0,0), P0[2],P0[3],P0[4],P0[5],     pw0[0]=PKW(P0,0), pw0[1]=PKW(P0,2), pw0); \
    GAPA(C1=__builtin_amdgcn_mfma_f32_32x32x16_bf16(kf[1],qr[0],ZZ,0,0,0), P0[6],P0[7],P0[8],P0[9],     pw0[2]=PKW(P0,4), pw0[3]=PKW(P0,6), pw0); \
    GAPA(C0=__builtin_amdgcn_mfma_f32_32x32x16_bf16(kf[2],qr[1],C0,0,0,0),   P0[10],P0[11],P0[12],P0[13], pw1[0]=PKW(P0,8), pw1[1]=PKW(P0,10), pw1); \
    GAPA(C1=__builtin_amdgcn_mfma_f32_32x32x16_bf16(kf[3],qr[1],C1,0,0,0),   P0[14],P0[15],P1[0],P1[1],   pw1[2]=PKW(P0,12),pw1[3]=PKW(P0,14), pw1); \
    VRDB(0,0); GAPA(C0=__builtin_amdgcn_mfma_f32_32x32x16_bf16(kf[4],qr[2],C0,0,0,0),   P1[2],P1[3],P1[4],P1[5],     pw2[0]=PKW(P1,0), pw2[1]=PKW(P1,2), pw2); \
    VRDB(1,1); GAPA(C1=__builtin_amdgcn_mfma_f32_32x32x16_bf16(kf[5],qr[2],C1,0,0,0),   P1[6],P1[7],P1[8],P1[9],     pw2[2]=PKW(P1,4), pw2[3]=PKW(P1,6), pw2); \
    VRDB(2,2); GAPA(C0=__builtin_amdgcn_mfma_f32_32x32x16_bf16(kf[6],qr[3],C0,0,0,0),   P1[10],P1[11],P1[12],P1[13], pw3[0]=PKW(P1,8), pw3[1]=PKW(P1,10), pw3); \
    VRDB(3,3); GAPA(C1=__builtin_amdgcn_mfma_f32_32x32x16_bf16(kf[7],qr[3],C1,0,0,0),   P1[14],P1[15],0.f,0.f,       pw3[2]=PKW(P1,12),pw3[3]=PKW(P1,14), pw3); \
    l_reg+=sacc; \
    if(GK){DMA_K((t)+3,sl_cur);} if(GV){DMA_V((t)+1,sl_next);} \
    CMASK(C0,C1,t); \
    { float a=MX3(C0[0],C0[1],C1[0]),b=MX3(C0[2],C0[3],C1[1]); a=MX3(a,C1[2],C1[3]); \
      _Pragma("unroll") for(int r=4;r<16;r+=4){a=MX3(a,C0[r],C0[r+1]);b=MX3(b,C0[r+2],C0[r+3]);a=MX3(a,C1[r],C1[r+1]);b=MX3(b,C1[r+2],C1[r+3]);} \
      float rm=__builtin_fmaxf(a,b); { auto rr=__builtin_amdgcn_permlane32_swap(__float_as_uint(rm),__float_as_uint(rm),false,false); rm=__builtin_fmaxf(__uint_as_float(rr[0]),__uint_as_float(rr[1])); } \
      rm-=mhat; resc=false; \
      if(__builtin_expect(__any(rm>(float)THRL),0)){ const float dl=__builtin_fmaxf(rm,0.f); mhat+=dl; \
        const float f=__builtin_amdgcn_exp2f(-dl); l_reg*=f; if(hi==0)wsf[r32]=f; resc=true; } } \
    SBAR(); \
    PVB(0,0,0,0,C0,0);   PVB(1,1,0,1,C0,2);   PVB(2,2,0,2,C0,4);   PVB(3,3,0,3,C0,6); \
    KRD(GL,0); PVB(4,0,1,0,C0,8);   PVB(5,1,1,1,C0,10); \
    KRD(GL,1); PVB(6,2,1,2,C0,12);  PVB(7,3,1,3,C0,14); \
    KRD(GL,2); PVB(8,0,2,0,C1,0);   PVB(9,1,2,1,C1,2); \
    KRD(GL,3); PVB(10,2,2,2,C1,4);  PVB(11,3,2,3,C1,6); \
    PVB(12,0,3,0,C1,8);  PVB(13,1,3,1,C1,10); PVB(14,2,3,2,C1,12); PVB(15,3,3,3,C1,14); \
    }while(0)
  int t=1;
  #undef CMASK
  #define CMASK(P0,P1,t) do{}while(0)
  for(;t+5<NT;t+=2){
    STEP(pB0,pB1,pA0,pA1,t,true,true,true);     WAIT_BAR(3); RESC(); ROT();
    STEP(pA0,pA1,pB0,pB1,t+1,true,true,true);   WAIT_BAR(3); RESC(); ROT();
  }
  #undef CMASK
  #define CMASK(P0,P1,t) do{ int jb_=(t)-(NT-4); if(jb_>=0)cmask(P0,P1,jb_,qrel,hi); }while(0)
  #define ENDW(tt) do{ if((tt)+3<NT){WAIT_BAR(3);} else if((tt)+2<NT){WAIT_BAR(2);} else {WAIT_BAR(0);} }while(0)
  for(;t+1<NT;t+=2){
    STEP(pB0,pB1,pA0,pA1,t,(t+3<NT),(t+1<NT),(t+1<NT));       ENDW(t);   RESC(); ROT();
    STEP(pA0,pA1,pB0,pB1,t+1,(t+4<NT),(t+2<NT),(t+2<NT));     ENDW(t+1); RESC(); ROT();
  }
  STEP(pB0,pB1,pA0,pA1,NT-1,false,false,false); RESC();
  { float sacc=pB0[0]+pB0[1]; _Pragma("unroll") for(int r=2;r<16;++r)sacc+=pB0[r]; _Pragma("unroll") for(int r=0;r<16;++r)sacc+=pB1[r]; l_reg+=sacc;
    pw0=(u32x4){PKW(pB0,0),PKW(pB0,2),PKW(pB0,4),PKW(pB0,6)};pw1=(u32x4){PKW(pB0,8),PKW(pB0,10),PKW(pB0,12),PKW(pB0,14)};pw2=(u32x4){PKW(pB1,0),PKW(pB1,2),PKW(pB1,4),PKW(pB1,6)};pw3=(u32x4){PKW(pB1,8),PKW(pB1,10),PKW(pB1,12),PKW(pB1,14)};
    SBAR(); pv(o,vb0+2*sl_cur,PAF(0),PAF(1),PAF(2),PAF(3)); pv(o+2,vb0+2*sl_cur+8192,PAF(0),PAF(1),PAF(2),PAF(3)); }
  #undef PKW
  #undef PAF
  #undef VFRB
  #undef PIN
  #undef MX3
  #undef GAPA
  #undef GAPB2
  #undef EX
  #undef VRDB
  #undef PVB
  #undef KRD
  #undef ZZ
  #undef STEP
  #undef ENDW
  {auto rr=__builtin_amdgcn_permlane32_swap(__float_as_uint(l_reg),__float_as_uint(l_reg),false,false);l_reg=__uint_as_float(rr[0])+__uint_as_float(rr[1]);}
  if(hi==0)wsf[32+r32]=l_reg;asm volatile("s_waitcnt lgkmcnt(0)":::"memory");
  float rli[16];
  #pragma unroll
  for(int r=0;r<16;++r)rli[r]=__builtin_amdgcn_rcpf(wsf[32+crow(r,hi)]);
  bf16*Ow=O+(long)(q0+wid*QBLK)*DMO;
  { bf16*stg=(bf16*)(shm+L2_OST)+wid*4096;
    #pragma unroll
    for(int r=0;r<16;++r){const int orow=crow(r,hi);
      #pragma unroll
      for(int d0=0;d0<4;++d0)stg[orow*128+d0*32+r32]=__float2bfloat16(o[d0][r]*rli[r]);}
    asm volatile("s_waitcnt lgkmcnt(0)":::"memory");
    #pragma unroll
    for(int i=0;i<8;++i){const int row=i*4+(lane>>4),ch=lane&15; const u32x4 v=*(const u32x4*)(stg+row*128+ch*8); ATTN_STORE16(Ow+(long)row*DMO+ch*8,v);} }
  asm volatile("s_waitcnt lgkmcnt(0)\n\ts_barrier":::"memory");
  #undef DMA_K
  #undef DMA_V
  #undef CMASK
  #undef RESC
  #undef ROT
}
#undef SBAR
#undef WAIT_BAR
}
#define GAS __attribute__((address_space(1)))
#define LAS __attribute__((address_space(3)))
typedef unsigned short bf16;
typedef unsigned v4u __attribute__((ext_vector_type(4)));
typedef float f32x4 __attribute__((ext_vector_type(4)));
typedef short bf16x8 __attribute__((ext_vector_type(8)));
typedef GAS unsigned gu32;
typedef GAS unsigned long long gu64;
#define RLX_AGENT __ATOMIC_RELAXED, __HIP_MEMORY_SCOPE_AGENT
#define LDS_WAIT() asm volatile("s_waitcnt lgkmcnt(0)" ::: "memory")
#define VM_WAIT() asm volatile("s_waitcnt vmcnt(0)" ::: "memory")
__device__ __forceinline__ unsigned long long rt() { return __builtin_amdgcn_s_memrealtime(); }
__device__ __forceinline__ unsigned f2bf(float f) { unsigned u = __builtin_bit_cast(unsigned, f); return (u + 0x7fffu + ((u >> 16) & 1u)) >> 16; }
__device__ __forceinline__ unsigned pk2(float lo, float hi) { return f2bf(lo) | (f2bf(hi) << 16); }

#define XB_TMO      128
#define XB_XCNT(j)  (256  + 64 * (j))
#define XB_XSUB(j)  (1280 + 64 * (j))
#define XB_XGEN(j)  (2304 + 64 * (j))
#define XB_TOP      3328
#define XB_TOPGEN   3392
#define XCD_BAR_WORDS 3456
#define XB_SPIN_CAP (1u << 18)

__device__ __forceinline__ unsigned xb_ld(unsigned* p)              { return __hip_atomic_load(p, __ATOMIC_RELAXED, __HIP_MEMORY_SCOPE_AGENT); }
__device__ __forceinline__ unsigned xb_add(unsigned* p, unsigned v) { return __hip_atomic_fetch_add(p, v, __ATOMIC_RELAXED, __HIP_MEMORY_SCOPE_AGENT); }
__device__ __forceinline__ unsigned xb_xcc_id() { return (unsigned)__builtin_amdgcn_s_getreg((3 << 11) | 20) & 0xFu; }
#define XB_SPIN(cond, bar) do { unsigned _sp = 0; while (cond) { __builtin_amdgcn_s_sleep(1); \
    if ((++_sp & 255u) == 0u) { if (xb_ld(&(bar)[XB_TMO])) break; if (_sp > XB_SPIN_CAP) { atomicAdd(&(bar)[XB_TMO], 1u); break; } } } } while (0)

struct XcdBarrier {
    unsigned* bar; unsigned x;
    volatile LAS unsigned* st;
};

__device__ __forceinline__ XcdBarrier xcd_barrier_post(unsigned* bar, volatile LAS unsigned* st) {
    XcdBarrier b; b.bar = bar; b.x = xb_xcc_id(); b.st = st;
    if (threadIdx.x == 0) (void)xb_add(&bar[XB_XCNT(b.x)], 1u);
    return b;
}
__device__ __forceinline__ void xcd_barrier_complete(unsigned* bar, unsigned x, unsigned& nloc, unsigned& nx) {
    const unsigned G = gridDim.x * gridDim.y * gridDim.z;
    unsigned sum, cnt, mine, sp = 0u;
    for (;;) {
        sum = 0u; cnt = 0u; mine = 0u;
#pragma unroll
        for (unsigned j = 0; j < 16; ++j) { const unsigned c = xb_ld(&bar[XB_XCNT(j)]); sum += c; cnt += (c > 0u) ? 1u : 0u; mine = (j == x) ? c : mine; }
        if (sum == G) break;
        __builtin_amdgcn_s_sleep(1);
        if ((++sp & 255u) == 0u) { if (xb_ld(&bar[XB_TMO])) break; if (sp > XB_SPIN_CAP) { atomicAdd(&bar[XB_TMO], 1u); break; } }
    }
    nloc = mine > 0u ? mine : 1u; nx = cnt > 0u ? cnt : 1u;
}

__device__ __forceinline__ void xcd_barrier(const XcdBarrier& b) {
    asm volatile("s_waitcnt vmcnt(0)" ::: "memory");
    __syncthreads();
    if (threadIdx.x == 0) {
        unsigned* bar = b.bar;
        __builtin_amdgcn_s_waitcnt(0);
        unsigned nloc = b.st[0], nx = b.st[1];
        if (nloc == 0u) { xcd_barrier_complete(bar, b.x, nloc, nx); b.st[0] = nloc; b.st[1] = nx; }
        const unsigned old = xb_add(&bar[XB_XSUB(b.x)], 1u);
        const unsigned gen = old / nloc;
        if (old + 1u == (gen + 1u) * nloc) {
            __builtin_amdgcn_fence(__ATOMIC_RELEASE, "agent");
            asm volatile("s_waitcnt vmcnt(0)" ::: "memory");
            const unsigned og = xb_add(&bar[XB_TOP], 1u);
            const unsigned tg = og / nx;
            if (og + 1u == (tg + 1u) * nx) xb_add(&bar[XB_TOPGEN], 1u);
            else XB_SPIN(xb_ld(&bar[XB_TOPGEN]) == tg, bar);
            __builtin_amdgcn_fence(__ATOMIC_ACQUIRE, "agent");
            xb_add(&bar[XB_XGEN(b.x)], 1u);
            asm volatile("s_waitcnt vmcnt(0)" ::: "memory");
        } else {
            XB_SPIN(xb_ld(&bar[XB_XGEN(b.x)]) == gen, bar);
            __builtin_amdgcn_fence(__ATOMIC_ACQUIRE, "agent");
            asm volatile("s_waitcnt vmcnt(0)" ::: "memory");
        }
    }
    __syncthreads();
}
constexpr int NWAVES = 8;
constexpr int BATCH = 2, SEQ = 8192, D = 1024, T = BATCH * SEQ, NPROJ = 2304, DFF = 2816, DFE = 3584, NE = 8;
constexpr int NPAD = 2 * T + NE * 256;
constexpr int MAXCH = NPAD / 256;
constexpr float RMS_EPS = 1e-6f, LN_EPS = 1e-5f;
constexpr int NFC = 128, TAIL_KS = 7, TAIL_KSLICE = 512, TAIL_ROWS = 2048;
constexpr int NPH = 17;
constexpr float LOG2E = 1.4426950408889634f;

constexpr size_t MiB = 1u << 20;
constexpr size_t WS_CTL = 0, CTL_ZERO_BYTES = 1 * MiB;
constexpr size_t WS_RT = 1 * MiB;
constexpr size_t RT_SSQ = 1 * MiB;
constexpr size_t RT_SELE = 0, RT_SELL = 128 * 1024, RT_SELW = 256 * 1024, RT_TOKD = 384 * 1024, RT_CNTB = 512 * 1024, RT_CHE = 528 * 1024, RT_NCH = 532 * 1024, RT_CB = 533 * 1024;
constexpr size_t WS_WB = 4 * MiB;
constexpr size_t WB_IN = 0, WB_OUT = WB_IN + (size_t)NPROJ * D, WB_W13 = WB_OUT + (size_t)D * D, WB_W2 = WB_W13 + (size_t)2 * DFF * D, WB_PW1 = WB_W2 + (size_t)D * DFF,
                 WB_PW2 = WB_PW1 + (size_t)2 * D * D, WB_E13 = WB_PW2 + (size_t)D * D, WB_E2 = WB_E13 + (size_t)NE * 2 * DFE * D, WB_END = WB_E2 + (size_t)NE * D * DFE;
static_assert(WB_END * 2 <= 198 * MiB, "weight region");
constexpr size_t WS_X = 202 * MiB;
constexpr size_t WS_XB = 266 * MiB;
constexpr size_t WS_R1 = 298 * MiB;
constexpr size_t R1_PROJ = 0, R1_O16 = 72 * MiB, R1_MIX = 104 * MiB, R1_HB = 0, R1_U = 0, R1_V = 32 * MiB, R1_HN = 0, R1_HMOE = 0;
constexpr size_t WS_R2 = 536 * MiB;
constexpr size_t WS_FAST_END = 604 * MiB;
static_assert((size_t)NPAD * DFE * 2 <= 238 * MiB && (size_t)NPAD * D * 2 <= 68 * MiB, "big regions");
constexpr int CW_BAR = 4096;
constexpr int RING_BYTES = 143360, LDSCTL_OFF = RING_BYTES, MISC_OFF = LDSCTL_OFF + 320, LDS_BYTES = 147456;
static_assert(attn_body::ATTN128_LDS_BYTES <= RING_BYTES && attn_body::ATTN_LDS_BYTES <= RING_BYTES && MISC_OFF + 128 <= LDS_BYTES, "LDS map");

#ifndef FFN_F8_MASK
#define FFN_F8_MASK 2
#endif
#define FFN_F8(pair) (((FFN_F8_MASK) >> (pair)) & 1)
typedef float f32x2 __attribute__((ext_vector_type(2)));
typedef unsigned v2u __attribute__((ext_vector_type(2)));
#define KAS __attribute__((address_space(4)))
static_assert(true, "Args layout: in[26] at 0, out at 208, ws at 216, ph_lo 224, ph_hi 228, li 232, dbg 236");
struct Args { const float* in[26]; float* out; unsigned char* ws; unsigned char* part; int ph_lo, ph_hi, li, dbg; };
constexpr int KA_OUT = 208, KA_WS = 216, KA_PART = 224, KA_LO = 232, KA_HI = 236, KA_LI = 240, KA_DBG = 244;
static_assert(sizeof(Args) == 248, "Args layout");

struct Frame { LAS unsigned char* lds; volatile LAS unsigned* MISC; int tid, lane, wave, vcu, G; };

__device__ __forceinline__ float wave_sum(float v) {
#pragma unroll
    for (int o = 1; o < 64; o <<= 1) v += __shfl_xor(v, o);
    return v;
}
__device__ __forceinline__ unsigned pkbf(float lo, float hi) { return pg8::cvt_pk_bf16(lo, hi); }
__device__ __forceinline__ float bflo(unsigned w) { return __uint_as_float(w << 16); }
__device__ __forceinline__ float bfhi(unsigned w) { return __uint_as_float(w & 0xffff0000u); }

__device__ __forceinline__ unsigned pk4f8(float a, float b, float c, float d) { int w = __builtin_amdgcn_cvt_pk_fp8_f32(a, b, 0, false); w = __builtin_amdgcn_cvt_pk_fp8_f32(c, d, w, true); return (unsigned)w; }
__device__ __forceinline__ void conv_item(const float* W, int ldw, int k0, int n0, bf16* WT, int K, int drow0, LAS float* scr, int lane, const float* gk  , float f8s = 0.f  ) {
    const int kq = lane >> 4, nq = lane & 15;
    f32x4 v[16];
#pragma unroll
    for (int i = 0; i < 16; ++i) v[i] = __builtin_nontemporal_load((const f32x4*)(W + (size_t)(k0 + 4 * i + kq) * ldw + n0 + 4 * nq));
#pragma unroll
    for (int i = 0; i < 16; ++i) { const int k = 4 * i + kq; f32x4 t = v[i]; if (gk) t = t * gk[k0 + k]; *(LAS f32x4*)(scr + k * 64 + 4 * (nq ^ (k >> 3))) = t; }
    LDS_WAIT(); asm volatile("" ::: "memory");
    const int c = lane & 7;
    if (f8s != 0.f) { unsigned char* WT8 = (unsigned char*)WT;
#pragma unroll
        for (int j = 0; j < 8; ++j) { const int nn = (lane >> 3) + 8 * j; const LAS float* s = scr + (8 * c) * 64 + (nn ^ (4 * c));
            v2u o; o.x = pk4f8(s[0] * f8s, s[64] * f8s, s[128] * f8s, s[192] * f8s); o.y = pk4f8(s[256] * f8s, s[320] * f8s, s[384] * f8s, s[448] * f8s);
            *(GAS v2u*)(WT8 + (size_t)(drow0 + nn) * K + k0 + 8 * c) = o; } }
    else {
#pragma unroll
    for (int j = 0; j < 8; ++j) { const int nn = (lane >> 3) + 8 * j; const LAS float* s = scr + (8 * c) * 64 + (nn ^ (4 * c));
        v4u o; o.x = pkbf(s[0], s[64]); o.y = pkbf(s[128], s[192]); o.z = pkbf(s[256], s[320]); o.w = pkbf(s[384], s[448]);
        *(GAS v4u*)(WT + (size_t)(drow0 + nn) * K + k0 + 8 * c) = o; } }
    LDS_WAIT(); asm volatile("" ::: "memory");
}
__device__ __forceinline__ void conv_job(const float* W, int ldw, int K, int N, bf16* WT, int half  , int r, LAS float* scr, int lane, const float* gk = nullptr, float f8s = 0.f) {
    const int nblk = N / 64, kb = r / nblk, nb = r % nblk, n0 = 64 * nb;
    const int drow0 = half < 0 ? n0 : ((n0 >> 7) * 256 + half * 128 + (n0 & 127));
    conv_item(W, ldw, 64 * kb, n0, WT, K, drow0, scr, lane, gk, f8s);
}
__device__ __forceinline__ void rms_row_to_bf16(const float* xrow, const float* g, bf16* orow, int lane) {
    const GAS f32x4* xr = (const GAS f32x4*)xrow + lane; const GAS f32x4* gr = (const GAS f32x4*)g + lane;
    f32x4 v[4]; float s = 0.f;
#pragma unroll
    for (int j = 0; j < 4; ++j) { v[j] = xr[64 * j]; s += (v[j].x * v[j].x + v[j].y * v[j].y) + (v[j].z * v[j].z + v[j].w * v[j].w); }
    const float rstd = 1.f / sqrtf(wave_sum(s) * (1.f / D) + RMS_EPS);
    GAS unsigned long long* o8 = (GAS unsigned long long*)orow + lane;
#pragma unroll
    for (int j = 0; j < 4; ++j) { const f32x4 gg = gr[64 * j]; o8[64 * j] = (unsigned long long)pkbf(v[j].x * rstd * gg.x, v[j].y * rstd * gg.y) | ((unsigned long long)pkbf(v[j].z * rstd * gg.z, v[j].w * rstd * gg.w) << 32); }
}
__device__ __forceinline__ void prep_x(Frame& F, const float* xin, bf16* X, float* ssq4) {
    const int gw = F.vcu * NWAVES + F.wave, NGW = F.G * NWAVES, lane = F.lane;
    for (int m0 = gw; m0 < T; m0 += 4 * NGW) {
        f32x4 v[4][4];
#pragma unroll
        for (int q = 0; q < 4; ++q) { const int m = m0 + q * NGW < T ? m0 + q * NGW : m0; const GAS f32x4* xr = (const GAS f32x4*)(xin + (size_t)m * D) + lane;
#pragma unroll
            for (int j = 0; j < 4; ++j) v[q][j] = xr[64 * j]; }
#pragma unroll
        for (int q = 0; q < 4; ++q) { const int m = m0 + q * NGW; float s = 0.f; unsigned long long w[4];
#pragma unroll
            for (int j = 0; j < 4; ++j) { const unsigned lo = pkbf(v[q][j].x, v[q][j].y), hi = pkbf(v[q][j].z, v[q][j].w); w[j] = (unsigned long long)lo | ((unsigned long long)hi << 32);
                const float r0 = bflo(lo), r1 = bfhi(lo), r2 = bflo(hi), r3 = bfhi(hi); s += (r0 * r0 + r1 * r1) + (r2 * r2 + r3 * r3); }
            s = wave_sum(s);
            if (m < T) { GAS unsigned long long* o8 = (GAS unsigned long long*)(X + (size_t)m * D) + lane;
#pragma unroll
                for (int j = 0; j < 4; ++j) o8[64 * j] = w[j];
                if (lane < 4) ssq4[(size_t)m * 4 + lane] = lane == 0 ? s : 0.f; } }
    }
}
__device__ __forceinline__ void p0_convert(Frame& F, const KAS char* ka, int pair, bf16* WB) {
#define INP(i) (*(const float* const KAS*)(ka + 8 * (i)))
    LAS float* scr = (LAS float*)(F.lds + F.wave * 16384);
    const int gw = F.vcu * NWAVES + F.wave, NGW = F.G * NWAVES;
    constexpr int I_IN = 16 * 36, I_OUT = 256, I_G = 16 * 44, I_DN = 44 * 16, I_PW1H = 256, I_PW2 = 256, I_EG = 16 * 56, I_ED = 56 * 16;
    constexpr int NITEMS = I_IN + I_OUT + 2 * I_G + I_DN + 2 * I_PW1H + I_PW2 + NE * (2 * I_EG + I_ED);
    const float* w_in = INP(2) + (size_t)pair * D * NPROJ; const float* w_out = INP(6) + (size_t)pair * D * D;
    const float* w_fg = INP(8) + (size_t)pair * D * DFF; const float* w_fu = INP(9) + (size_t)pair * D * DFF; const float* w_fd = INP(10) + (size_t)pair * DFF * D;
    const float* w_p1 = INP(12) + (size_t)pair * D * 2 * D; const float* w_p2 = INP(18) + (size_t)pair * D * D;
    const float* g_att = INP(1) + pair * D; const float* g_ffn = INP(7) + pair * D; const float* g_conv = INP(11) + pair * D;
    const bool ffn8 = FFN_F8(pair);
    const float* w_eg = INP(22) + (size_t)pair * NE * D * DFE; const float* w_eu = INP(23) + (size_t)pair * NE * D * DFE; const float* w_ed = INP(24) + (size_t)pair * NE * DFE * D;
    for (int it = gw; it < NITEMS; it += NGW) {
        int r = it;
        if (r < I_IN) { conv_job(w_in, NPROJ, D, NPROJ, WB + WB_IN, -1, r, scr, F.lane, g_att); continue; } r -= I_IN;
        if (r < I_OUT) { conv_job(w_out, D, D, D, WB + WB_OUT, -1, r, scr, F.lane); continue; } r -= I_OUT;
        if (r < I_G) { conv_job(w_fg, DFF, D, DFF, WB + WB_W13, 0, r, scr, F.lane, g_ffn, ffn8 ? (float)(1 << pg8::F8_WSHIFT) : 0.f); continue; } r -= I_G;
        if (r < I_G) { conv_job(w_fu, DFF, D, DFF, WB + WB_W13, 1, r, scr, F.lane, g_ffn, ffn8 ? (float)(1 << pg8::F8_WSHIFT) : 0.f); continue; } r -= I_G;
        if (r < I_DN) { conv_job(w_fd, D, DFF, D, WB + WB_W2, -1, r, scr, F.lane, nullptr, ffn8 ? (float)(1 << pg8::F8_FW2SHIFT) : 0.f); continue; } r -= I_DN;
        if (r < I_PW1H) { conv_job(w_p1, 2 * D, D, D, WB + WB_PW1, 0, r, scr, F.lane, g_conv); continue; } r -= I_PW1H;
        if (r < I_PW1H) { conv_job(w_p1 + D, 2 * D, D, D, WB + WB_PW1, 1, r, scr, F.lane, g_conv); continue; } r -= I_PW1H;
        if (r < I_PW2) { conv_job(w_p2, D, D, D, WB + WB_PW2, -1, r, scr, F.lane); continue; } r -= I_PW2;
        if (r < NE * I_EG) { const int e = r / I_EG; conv_job(w_eg + (size_t)e * D * DFE, DFE, D, DFE, WB + WB_E13 + (size_t)e * DFE * D  , 0, r % I_EG, scr, F.lane, nullptr, (float)(1 << pg8::F8_WSHIFT)); continue; } r -= NE * I_EG;
        if (r < NE * I_EG) { const int e = r / I_EG; conv_job(w_eu + (size_t)e * D * DFE, DFE, D, DFE, WB + WB_E13 + (size_t)e * DFE * D, 1, r % I_EG, scr, F.lane, nullptr, (float)(1 << pg8::F8_WSHIFT)); continue; } r -= NE * I_EG;
        { const int e = r / I_ED; conv_job(w_ed + (size_t)e * DFE * D, D, DFE, D, WB + WB_E2 + (size_t)e * D * DFE / 2  , -1, r % I_ED, scr, F.lane, nullptr, (float)(1 << pg8::F8_W2SHIFT)); }
    }
#undef INP
}
__device__ __forceinline__ void p3_diffcombine(Frame& F, const bf16* O16, bf16* MIX, const float* lamp, const float* subg, float lam_init) {
    const int gw = F.vcu * NWAVES + F.wave, NGW = F.G * NWAVES, lane = F.lane;
    const float pa = wave_sum(lamp[lane] * lamp[64 + lane]), pb = wave_sum(lamp[128 + lane] * lamp[192 + lane]);
    const float lam = expf(pa) - expf(pb) + lam_init;
    const int h = lane >> 4, dvl = (lane & 15) * 8;
    float gsc[8];
#pragma unroll
    for (int i = 0; i < 8; ++i) gsc[i] = subg[dvl + i] * (1.0f - lam_init);
    for (int m0 = gw; m0 < T; m0 += 4 * NGW) {
        v4u a[4], b[4];
#pragma unroll
        for (int q = 0; q < 4; ++q) { const int m = m0 + q * NGW < T ? m0 + q * NGW : m0;
            a[q] = *(const GAS v4u*)(O16 + (size_t)m * D + h * 256 + dvl); b[q] = *(const GAS v4u*)(O16 + (size_t)m * D + h * 256 + 128 + dvl); }
#pragma unroll
        for (int q = 0; q < 4; ++q) { const int m = m0 + q * NGW;
            float v[8];
            v[0] = bflo(a[q].x) - lam * bflo(b[q].x); v[1] = bfhi(a[q].x) - lam * bfhi(b[q].x); v[2] = bflo(a[q].y) - lam * bflo(b[q].y); v[3] = bfhi(a[q].y) - lam * bfhi(b[q].y);
            v[4] = bflo(a[q].z) - lam * bflo(b[q].z); v[5] = bfhi(a[q].z) - lam * bfhi(b[q].z); v[6] = bflo(a[q].w) - lam * bflo(b[q].w); v[7] = bfhi(a[q].w) - lam * bfhi(b[q].w);
            float ss = 0.f;
#pragma unroll
            for (int i = 0; i < 8; ++i) ss += v[i] * v[i];
            ss += __shfl_xor(ss, 1); ss += __shfl_xor(ss, 2); ss += __shfl_xor(ss, 4); ss += __shfl_xor(ss, 8);
            const float r = 1.f / sqrtf(ss * (1.f / 128.f) + RMS_EPS);
            v4u o; o.x = pkbf(v[0] * r * gsc[0], v[1] * r * gsc[1]); o.y = pkbf(v[2] * r * gsc[2], v[3] * r * gsc[3]); o.z = pkbf(v[4] * r * gsc[4], v[5] * r * gsc[5]); o.w = pkbf(v[6] * r * gsc[6], v[7] * r * gsc[7]);
            if (m < T) *(GAS v4u*)(MIX + (size_t)m * D + h * 128 + dvl) = o; }
    }
}
__device__ __forceinline__ void p10_conv(Frame& F, const bf16* U, bf16* V, const float* wdw, const float* bdw, const float* lng, const float* lnb) {
    const int tid = F.tid, lane = F.lane, wave = F.wave;
    LAS unsigned char* tile = F.lds;
    f32x2 w[31];
#pragma unroll
    for (int k = 0; k < 31; ++k) w[k] = *(const GAS f32x2*)(wdw + k * D + 2 * tid);
    const f32x2 bia = *(const GAS f32x2*)(bdw + 2 * tid);
    f32x2 lg_[8], lb_[8];
#pragma unroll
    for (int j = 0; j < 8; ++j) { lg_[j] = *(const GAS f32x2*)(lng + 16 * lane + 2 * j); lb_[j] = *(const GAS f32x2*)(lnb + 16 * lane + 2 * j); }
    for (int u = F.vcu; u < T / 32; u += F.G) {
        const int t0 = u * 32, tp0 = t0 % SEQ;
        { v4u val[16];
#pragma unroll
            for (int i = 0; i < 16; ++i) { const int idx = tid + 512 * i, row = idx >> 7, cc = idx & 127; const bool ok = (tp0 - 30 + row >= 0) && (idx < 62 * 128);
                val[i] = *(const GAS v4u*)(U + (size_t)(ok ? t0 - 30 + row : t0) * D + cc * 8); }
#pragma unroll
            for (int i = 0; i < 16; ++i) { const int idx = tid + 512 * i, row = idx >> 7, cc = idx & 127; const bool ok = (tp0 - 30 + row >= 0);
                if (idx < 62 * 128) *(LAS v4u*)(tile + row * 2048 + cc * 16) = ok ? val[i] : (v4u){0u, 0u, 0u, 0u}; } }
        __syncthreads();
        for (int g = 0; g < 4; ++g) {
            f32x2 acc[8];
#pragma unroll
            for (int o = 0; o < 8; ++o) acc[o] = bia;
            LAS unsigned char* base = tile + (8 * g) * 2048 + 4 * tid;
#pragma unroll
            for (int r = 0; r < 38; ++r) { const unsigned xw = *(LAS unsigned*)(base + r * 2048); const f32x2 xv = (f32x2){bflo(xw), bfhi(xw)};
#pragma unroll
                for (int o = 0; o < 8; ++o) { const int k = r - o; if (k >= 0 && k <= 30) acc[o] += w[k] * xv; } }
#pragma unroll
            for (int o = 0; o < 8; ++o) *(LAS unsigned*)(base + o * 2048) = pkbf(acc[o].x, acc[o].y);
        }
        __syncthreads();
#pragma unroll
        for (int i = 0; i < 4; ++i) { const int tl = 4 * wave + i;
            const v4u a = *(LAS v4u*)(tile + tl * 2048 + lane * 32), b = *(LAS v4u*)(tile + tl * 2048 + lane * 32 + 16);
            float v[16];
            v[0] = bflo(a.x); v[1] = bfhi(a.x); v[2] = bflo(a.y); v[3] = bfhi(a.y); v[4] = bflo(a.z); v[5] = bfhi(a.z); v[6] = bflo(a.w); v[7] = bfhi(a.w);
            v[8] = bflo(b.x); v[9] = bfhi(b.x); v[10] = bflo(b.y); v[11] = bfhi(b.y); v[12] = bflo(b.z); v[13] = bfhi(b.z); v[14] = bflo(b.w); v[15] = bfhi(b.w);
            float s = 0.f;
#pragma unroll
            for (int j = 0; j < 16; ++j) s += v[j];
            const float mu = wave_sum(s) * (1.f / D); float q = 0.f;
#pragma unroll
            for (int j = 0; j < 16; ++j) { v[j] -= mu; q += v[j] * v[j]; }
            const float rstd = 1.f / sqrtf(wave_sum(q) * (1.f / D) + LN_EPS);
            unsigned ow[8];
#pragma unroll
            for (int j = 0; j < 8; ++j) { const f32x2 gg = lg_[j], bb = lb_[j];
                const float y0 = v[2 * j] * rstd * gg.x + bb.x, y1 = v[2 * j + 1] * rstd * gg.y + bb.y;
                ow[j] = pkbf(y0 * pg8::sigmoid_fast(y0), y1 * pg8::sigmoid_fast(y1)); }
            bf16* vp = V + (size_t)(t0 + tl) * D + 16 * lane;
            *(GAS v4u*)vp = (v4u){ow[0], ow[1], ow[2], ow[3]}; *(GAS v4u*)(vp + 8) = (v4u){ow[4], ow[5], ow[6], ow[7]}; }
        __syncthreads();
    }
}
__device__ __forceinline__ void p12_route1(Frame& F, const bf16* X, const float* g, const float* wr, bf16* HN, unsigned char* rt) {
    const int lane = F.lane, wave = F.wave, tid = F.tid;
    LAS int* tok_e = (LAS int*)F.lds; LAS int* loc = tok_e + 64;
    int2* SELE = (int2*)(rt + RT_SELE); int2* SELL = (int2*)(rt + RT_SELL); float2* SELW = (float2*)(rt + RT_SELW); int* CNTB = (int*)(rt + RT_CNTB);
    f32x4 wa[16], wb[16];
#pragma unroll
    for (int j = 0; j < 4; ++j)
#pragma unroll
        for (int i = 0; i < 4; ++i) { const int k = 4 * lane + 256 * j + i; wa[4 * j + i] = *(const GAS f32x4*)(wr + k * 8); wb[4 * j + i] = *(const GAS f32x4*)(wr + k * 8 + 4); }
    f32x4 gg[4];
#pragma unroll
    for (int j = 0; j < 4; ++j) gg[j] = ((const GAS f32x4*)g)[lane + 64 * j];
    for (int blk = F.vcu; blk < T / 64; blk += F.G) {
        for (int i0 = 0; i0 < 8; i0 += 2) {
            f32x4 vv[2][4];
            { unsigned long long xw[2][4];
#pragma unroll
            for (int q = 0; q < 2; ++q) { const GAS unsigned long long* xr = (const GAS unsigned long long*)(X + (size_t)(blk * 64 + 8 * wave + i0 + q) * D) + lane;
#pragma unroll
                for (int j = 0; j < 4; ++j) xw[q][j] = xr[64 * j]; }
#pragma unroll
            for (int q = 0; q < 2; ++q)
#pragma unroll
                for (int j = 0; j < 4; ++j) { const unsigned lo = (unsigned)xw[q][j], hi = (unsigned)(xw[q][j] >> 32); vv[q][j] = (f32x4){bflo(lo), bfhi(lo), bflo(hi), bfhi(hi)}; } }
#pragma unroll
            for (int q = 0; q < 2; ++q) { const int tl = 8 * wave + i0 + q, t = blk * 64 + tl;
            f32x4 v[4]; float s = 0.f;
#pragma unroll
            for (int j = 0; j < 4; ++j) { v[j] = vv[q][j]; s += (v[j].x * v[j].x + v[j].y * v[j].y) + (v[j].z * v[j].z + v[j].w * v[j].w); }
            const float rstd = 1.f / sqrtf(wave_sum(s) * (1.f / D) + RMS_EPS);
            f32x4 la = (f32x4){0.f, 0.f, 0.f, 0.f}, lb = la;
            GAS unsigned long long* o8 = (GAS unsigned long long*)(HN + (size_t)t * D) + lane;
#pragma unroll
            for (int j = 0; j < 4; ++j) { v[j] = v[j] * rstd * gg[j];
                la += wa[4 * j] * v[j].x + wa[4 * j + 1] * v[j].y + wa[4 * j + 2] * v[j].z + wa[4 * j + 3] * v[j].w;
                lb += wb[4 * j] * v[j].x + wb[4 * j + 1] * v[j].y + wb[4 * j + 2] * v[j].z + wb[4 * j + 3] * v[j].w;
                o8[64 * j] = (unsigned long long)pkbf(v[j].x, v[j].y) | ((unsigned long long)pkbf(v[j].z, v[j].w) << 32); }
            float lg[8] = {la.x, la.y, la.z, la.w, lb.x, lb.y, lb.z, lb.w};
#pragma unroll
            for (int e = 0; e < 8; ++e) lg[e] = wave_sum(lg[e]);
            int e0 = 0; float b0 = lg[0];
#pragma unroll
            for (int e = 1; e < 8; ++e) if (lg[e] > b0) { b0 = lg[e]; e0 = e; }
            int e1 = -1; float b1 = -INFINITY;
#pragma unroll
            for (int e = 0; e < 8; ++e) if (e != e0 && lg[e] > b1) { b1 = lg[e]; e1 = e; }
            const float w0 = 1.0f / (1.0f + expf(b1 - b0));
            if (lane == 0) { SELE[t] = make_int2(e0, e1); SELW[t] = make_float2(w0, 1.0f - w0); tok_e[tl] = e0 | (e1 << 8); }
            } }
        __syncthreads();
        if (tid < 8) { int c = 0;
            for (int tl = 0; tl < 64; ++tl) { const int ee = tok_e[tl]; if ((ee & 255) == tid) loc[2 * tl] = c++; if ((ee >> 8) == tid) loc[2 * tl + 1] = c++; }
            CNTB[blk * 8 + tid] = c; }
        __syncthreads();
        if (tid < 64) SELL[blk * 64 + tid] = make_int2(loc[2 * tid], loc[2 * tid + 1]);
        __syncthreads();
    }
}
__device__ __forceinline__ void p13_route2(Frame& F, const bf16* HN, bf16* XS, unsigned char* rt) {
    const int lane = F.lane, wave = F.wave, tid = F.tid;
    LAS int* tot = (LAS int*)F.lds; LAS int* bas = tot + 8; LAS int* pst = tot + 16;
    const int2* SELE = (const int2*)(rt + RT_SELE); const int2* SELL = (const int2*)(rt + RT_SELL); int2* TOKD = (int2*)(rt + RT_TOKD); const int* CNTB = (const int*)(rt + RT_CNTB);
    int* CHE = (int*)(rt + RT_CHE); int* NCH = (int*)(rt + RT_NCH);
    const int c0 = CNTB[(4 * lane + 0) * 8 + wave], c1 = CNTB[(4 * lane + 1) * 8 + wave], c2 = CNTB[(4 * lane + 2) * 8 + wave], c3 = CNTB[(4 * lane + 3) * 8 + wave];
    const int sl = c0 + c1 + c2 + c3; int inc = sl;
#pragma unroll
    for (int o = 1; o < 64; o <<= 1) { const int t = __shfl_up(inc, o); if (lane >= o) inc += t; }
    const int ex = inc - sl, total = __shfl(inc, 63);
    for (int blk = F.vcu; blk < T / 64; blk += F.G) {
        const int j = blk & 3; const int pj = ex + (j > 0 ? c0 : 0) + (j > 1 ? c1 : 0) + (j > 2 ? c2 : 0);
        const int mybase = __shfl(pj, blk >> 2);
        __syncthreads();
        if (lane == 0) { tot[wave] = total; bas[wave] = mybase; }
        __syncthreads();
        if (tid == 0) { int ps = 0;
            for (int e = 0; e < 8; ++e) { pst[e] = ps; const int nc = (tot[e] + 255) >> 8;
                if (blockIdx.x == 0 && blk == F.vcu) for (int c = 0; c < nc; ++c) CHE[(ps >> 8) + c] = e;
                ps += nc << 8; if (blockIdx.x == 0 && blk == F.vcu) ((int*)(rt + RT_CB))[e] = ps >> 8; }
            if (blockIdx.x == 0 && blk == F.vcu) NCH[0] = ps >> 8; }
        __syncthreads();
        for (int i0 = 0; i0 < 8; i0 += 4) {
            v4u ra[4], rb[4]; int d0[4], d1[4];
#pragma unroll
            for (int q = 0; q < 4; ++q) { const int t = blk * 64 + 8 * wave + i0 + q; const int2 ee = SELE[t], ll = SELL[t];
                d0[q] = pst[ee.x] + bas[ee.x] + ll.x; d1[q] = pst[ee.y] + bas[ee.y] + ll.y;
                const GAS v4u* src = (const GAS v4u*)(HN + (size_t)t * D); ra[q] = src[lane]; rb[q] = src[lane + 64]; }
#pragma unroll
            for (int q = 0; q < 4; ++q) { const int t = blk * 64 + 8 * wave + i0 + q;
                if (lane == 0) TOKD[t] = make_int2(d0[q], d1[q]);
                v2u fa, fb; fa.x = pk4f8(bflo(ra[q].x), bfhi(ra[q].x), bflo(ra[q].y), bfhi(ra[q].y)); fa.y = pk4f8(bflo(ra[q].z), bfhi(ra[q].z), bflo(ra[q].w), bfhi(ra[q].w));
                fb.x = pk4f8(bflo(rb[q].x), bfhi(rb[q].x), bflo(rb[q].y), bfhi(rb[q].y)); fb.y = pk4f8(bflo(rb[q].z), bfhi(rb[q].z), bflo(rb[q].w), bfhi(rb[q].w));
                GAS v2u* q0 = (GAS v2u*)((unsigned char*)XS + (size_t)d0[q] * D); GAS v2u* q1 = (GAS v2u*)((unsigned char*)XS + (size_t)d1[q] * D);
                q0[lane] = fa; q0[lane + 64] = fb; q1[lane] = fa; q1[lane + 64] = fb; } }
    }
}
__device__ __forceinline__ void p16_combine(Frame& F, bf16* X, const bf16* YS, const bf16* PART, const unsigned char* rt, const float* g, float* ssq4, float* out, bool last, bool poison) {
    const int gw = F.vcu * NWAVES + F.wave, NGW = F.G * NWAVES, lane = F.lane;
    const int2* TOKD = (const int2*)(rt + RT_TOKD); const float2* SELW = (const float2*)(rt + RT_SELW);
    f32x4 gg[4];
#pragma unroll
    for (int j = 0; j < 4; ++j) gg[j] = ((const GAS f32x4*)g)[lane + 64 * j];
    for (int m0 = gw; m0 < T; m0 += 4 * NGW) {
        int2 dd[4]; float2 ww[4];
#pragma unroll
        for (int q = 0; q < 4; ++q) { const int m = m0 + q * NGW < T ? m0 + q * NGW : m0; dd[q] = TOKD[m]; ww[q] = SELW[m]; }
        f32x4 v[4][4]; unsigned long long xa[4][4], ya[4][4], yb[4][4];
#pragma unroll
        for (int q = 0; q < 4; ++q) { const int m = m0 + q * NGW < T ? m0 + q * NGW : m0;
            const int d0 = dd[q].x < NFC * 256 ? dd[q].x : 0, d1 = dd[q].y < NFC * 256 ? dd[q].y : 0;
            const GAS unsigned long long* xr = (const GAS unsigned long long*)(X + (size_t)m * D) + lane;
            const GAS unsigned long long* y0 = (const GAS unsigned long long*)(YS + (size_t)d0 * D) + lane; const GAS unsigned long long* y1 = (const GAS unsigned long long*)(YS + (size_t)d1 * D) + lane;
#pragma unroll
            for (int j = 0; j < 4; ++j) { xa[q][j] = xr[64 * j]; ya[q][j] = y0[64 * j]; yb[q][j] = y1[64 * j]; } }
#pragma unroll
        for (int q = 0; q < 4; ++q)
#pragma unroll
            for (int j = 0; j < 4; ++j) { const unsigned lo = (unsigned)xa[q][j], hi = (unsigned)(xa[q][j] >> 32); v[q][j] = (f32x4){bflo(lo), bfhi(lo), bflo(hi), bfhi(hi)}; }
#pragma unroll
        for (int q = 0; q < 4; ++q) { const int m = m0 + q * NGW;
#pragma unroll
            for (int e = 0; e < 2; ++e) { const int d = e ? dd[q].y : dd[q].x; const float w = e ? ww[q].y : ww[q].x;
                if (d < NFC * 256) {
#pragma unroll
                    for (int j = 0; j < 4; ++j) { const unsigned long long a = e ? yb[q][j] : ya[q][j]; const unsigned al = (unsigned)a, ah = (unsigned)(a >> 32);
                        v[q][j].x += w * bflo(al); v[q][j].y += w * bfhi(al); v[q][j].z += w * bflo(ah); v[q][j].w += w * bfhi(ah); } }
                else { f32x4 t[4];
#pragma unroll
                    for (int j = 0; j < 4; ++j) t[j] = (f32x4){0.f, 0.f, 0.f, 0.f};
                    for (int ks = 0; ks < TAIL_KS; ++ks) { const GAS unsigned long long* y = (const GAS unsigned long long*)(PART + ((size_t)ks * TAIL_ROWS + (d - NFC * 256)) * D) + lane;
#pragma unroll
                        for (int j = 0; j < 4; ++j) { const unsigned long long a = y[64 * j]; const unsigned al = (unsigned)a, ah = (unsigned)(a >> 32);
                            t[j].x += bflo(al); t[j].y += bfhi(al); t[j].z += bflo(ah); t[j].w += bfhi(ah); } }
#pragma unroll
                    for (int j = 0; j < 4; ++j) v[q][j] += t[j] * w; } }
            if (last) {
                float s = 0.f;
#pragma unroll
                for (int j = 0; j < 4; ++j) s += (v[q][j].x * v[q][j].x + v[q][j].y * v[q][j].y) + (v[q][j].z * v[q][j].z + v[q][j].w * v[q][j].w);
                const float rstd = 1.f / sqrtf(wave_sum(s) * (1.f / D) + RMS_EPS);
                if (m < T) { GAS f32x4* orow = (GAS f32x4*)(out + (size_t)m * D) + lane; const float qn = __builtin_nanf("");
#pragma unroll
                    for (int j = 0; j < 4; ++j) { f32x4 o = v[q][j] * rstd * gg[j]; if (poison) o = (f32x4){qn, qn, qn, qn}; orow[64 * j] = o; } } }
            else {
                float s = 0.f; unsigned long long w[4];
#pragma unroll
                for (int j = 0; j < 4; ++j) { const unsigned lo = pkbf(v[q][j].x, v[q][j].y), hi = pkbf(v[q][j].z, v[q][j].w); w[j] = (unsigned long long)lo | ((unsigned long long)hi << 32);
                    const float r0 = bflo(lo), r1 = bfhi(lo), r2 = bflo(hi), r3 = bfhi(hi); s += (r0 * r0 + r1 * r1) + (r2 * r2 + r3 * r3); }
                s = wave_sum(s);
                if (m < T) { GAS unsigned long long* o8 = (GAS unsigned long long*)(X + (size_t)m * D) + lane;
#pragma unroll
                    for (int j = 0; j < 4; ++j) o8[64 * j] = w[j];
                    if (lane < 4) ssq4[(size_t)m * 4 + lane] = lane == 0 ? s : 0.f; } }
        }
    }
}
template <int pair> __device__ __forceinline__ void layer_pair(Frame& F) {
    const KAS char* const ka0 = (const KAS char*)__builtin_amdgcn_kernarg_segment_ptr();
    extern __shared__ __attribute__((aligned(16))) unsigned char lds[];
        const int pb = pair * NPH;
#define PLO() (*(const int KAS*)(ka0 + KA_LO))
#define PHI() (*(const int KAS*)(ka0 + KA_HI))
#define IN(k) (PLO() <= pb + (k) && pb + (k) < PHI())
#define SEAM(k) do { if (pb + (k) + 1 < PHI()) { XcdBarrier b_; b_.bar = (unsigned*)((gu32*)(ws + WS_CTL) + CW_BAR) + (size_t)(*(const int KAS*)(ka + KA_LI)) * XCD_BAR_WORDS; b_.x = xb_xcc_id(); b_.st = F.MISC + 8; xcd_barrier(b_); } } while (0)
#define REFRESH() int l_ = (int)__builtin_amdgcn_mbcnt_hi(~0u, __builtin_amdgcn_mbcnt_lo(~0u, 0u)); asm volatile("" : "+v"(l_)); F.lane = l_; F.tid = F.wave * 64 + l_; \
        const KAS char* ka = (const KAS char*)__builtin_amdgcn_kernarg_segment_ptr(); asm volatile("" : "+s"(ka)); unsigned char* const ws = *(unsigned char* const KAS*)(ka + KA_WS); (void)ws
#define INP(i) (*(const float* const KAS*)(ka + 8 * (i)))
#define WSP(T_, off) ((T_*)(ws + (off)))
        const float lam_init = pair == 0 ? 0.2f : 0.47071302f;

        if (IN(0)) { REFRESH();
            if (pair == 0 || *(const int KAS*)(ka + KA_DBG) != 0) p0_convert(F, ka, pair, WSP(bf16, WS_WB));
            if (pair == 0 && *(const int KAS*)(ka + KA_DBG) == 0) prep_x(F, INP(0), WSP(bf16, WS_X), WSP(float, WS_RT + RT_SSQ));
            if (pair == 0 || *(const int KAS*)(ka + KA_DBG) != 0) SEAM(0);
        }
        if (IN(1)) { REFRESH();
            pg8::Gemm g{WSP(bf16, WS_X), WSP(bf16, WS_WB) + WB_IN, T, NPROJ, D, D, 0, 0}; pg8::StaticOrder S; S.init(T, NPROJ, F.G, (int)blockIdx.x);
            pg8::EpiProj E{WSP(bf16, WS_R1 + R1_PROJ), NPROJ, 0xC3u, attn_body::C2, WSP(const float, WS_RT + RT_SSQ), 1.0f / D, RMS_EPS};
            pg8::gemm_phase<pg8::EpiProj, pg8::StaticOrder, true, true>(F.lds, g, S, E, F.wave);
            SEAM(1);
        }
        if (IN(2)) { REFRESH();
            const attn_body::bf16* PJ = WSP(const attn_body::bf16, WS_R1 + R1_PROJ); attn_body::bf16* O16 = WSP(attn_body::bf16, WS_R1 + R1_O16); attn_body::bf16* MIX = WSP(attn_body::bf16, WS_R1 + R1_MIX); const float* sinks = INP(5) + pair * 8;
#if defined(PROBE_SKIP_DIFF)
            if (F.vcu < 256 && *(const int KAS*)(ka + KA_LI) == 0) { const int k = F.vcu;
#else
            if (F.vcu < 256) { const int k = F.vcu;
#endif
                const int bhc = k >> 4, s = k & 15, b = bhc >> 3, h = (bhc >> 1) & 3, c = bhc & 1;
                const attn_body::bf16* base = PJ + (size_t)b * SEQ * NPROJ;
                for (int i = 0; i < 2; ++i) { const int qb = (i == 0) ? s : 31 - s;
                    attn_body::attn_unit128<8>(qb, base + h * 128 + c * 64, base + 512 + h * 128 + c * 64, base + 1024 + h * 128,
                                               O16 + (size_t)b * SEQ * D + (h * 2 + c) * 128, (char*)lds, F.wave); }
            }
#if defined(PROBE_SKIP_SWA)
            if (F.vcu < 256 && *(const int KAS*)(ka + KA_LI) == 0)
#else
            if (F.vcu < 256)
#endif
                for (int i = 0; i < 2; ++i) { const int su = F.vcu * 2 + i, b = su >> 8, hq = (su >> 5) & 7, qb = su & 31, kvh = hq >> 2;
                    const attn_body::bf16* base = PJ + (size_t)b * SEQ * NPROJ;
                    const float sink2 = sinks[hq] * LOG2E;
                    attn_body::attn_unit<8, true>(qb, base + 1536 + hq * 64, base + 2048 + kvh * 64, base + 2176 + kvh * 64,
                                                  MIX + (size_t)b * SEQ * D + 512 + hq * 64, sink2, (char*)lds, F.wave); }
            SEAM(2);
        }
        if (IN(3)) { REFRESH(); p3_diffcombine(F, WSP(bf16, WS_R1 + R1_O16), WSP(bf16, WS_R1 + R1_MIX), INP(3) + pair * 256, INP(4) + pair * 128, lam_init); SEAM(3); }
        if (IN(4)) { REFRESH();
            pg8::Gemm g{WSP(bf16, WS_R1 + R1_MIX), WSP(bf16, WS_WB) + WB_OUT, T, D, D, D, 0, 0}; pg8::StaticOrder S; S.init(T, D, F.G, (int)blockIdx.x);
            pg8::EpiResX E{WSP(const bf16, WS_X), nullptr, WSP(bf16, WS_X), D, nullptr, WSP(float, WS_RT + RT_SSQ), FFN_F8(pair) ? ws + WS_XB : nullptr, (float)(1 << pg8::F8_XSHIFT)};
            pg8::gemm_phase<pg8::EpiResX, pg8::StaticOrder, false, true>(F.lds, g, S, E, F.wave);
            SEAM(4);
        }
        if (IN(6)) { REFRESH();
            pg8::Gemm g{FFN_F8(pair) ? WSP(bf16, WS_XB) : WSP(bf16, WS_X), WSP(bf16, WS_WB) + WB_W13, T, 2 * DFF, FFN_F8(pair) ? D / 2 : D, FFN_F8(pair) ? D / 2 : D, pg8::f8_scale(pg8::F8_WSHIFT), pg8::f8_scale(pg8::F8_XSHIFT)}; pg8::StaticOrder S; S.init(T, 2 * DFF, F.G, (int)blockIdx.x);
            pg8::EpiSwiglu E{WSP(bf16, WS_R1 + R1_HB), DFF, WSP(const float, WS_RT + RT_SSQ), 1.0f / D, RMS_EPS, FFN_F8(pair) ? (float)(1 << pg8::F8_HSHIFT) : 0.f};
            pg8::gemm_phase<pg8::EpiSwiglu, pg8::StaticOrder, true, true, FFN_F8(pair) != 0>(F.lds, g, S, E, F.wave);
            SEAM(6);
        }
        if (IN(7)) { REFRESH();
            pg8::Gemm g{WSP(bf16, WS_R1 + R1_HB), WSP(bf16, WS_WB) + WB_W2, T, D, FFN_F8(pair) ? DFF / 2 : DFF, FFN_F8(pair) ? DFF / 2 : DFF, pg8::f8_scale(pg8::F8_FW2SHIFT), pg8::f8_scale(pg8::F8_HSHIFT)}; pg8::StaticOrder S; S.init(T, D, F.G, (int)blockIdx.x);
            pg8::EpiResX E{WSP(const bf16, WS_X), nullptr, WSP(bf16, WS_X), D, nullptr, WSP(float, WS_RT + RT_SSQ), nullptr, 0.f};
            pg8::gemm_phase<pg8::EpiResX, pg8::StaticOrder, false, true, FFN_F8(pair) != 0>(F.lds, g, S, E, F.wave);
            SEAM(7);
        }
        if (IN(9)) { REFRESH();
            pg8::Gemm g{WSP(bf16, WS_X), WSP(bf16, WS_WB) + WB_PW1, T, 2 * D, D, D, 0, 0}; pg8::StaticOrder S; S.init(T, 2 * D, F.G, (int)blockIdx.x);
            pg8::EpiGlu E{WSP(bf16, WS_R1 + R1_U), D, INP(13) + pair * 2 * D, D, WSP(const float, WS_RT + RT_SSQ), 1.0f / D, RMS_EPS};
            pg8::gemm_phase<pg8::EpiGlu, pg8::StaticOrder, true, true>(F.lds, g, S, E, F.wave);
            SEAM(9);
        }
        if (IN(10)) { REFRESH(); p10_conv(F, WSP(bf16, WS_R1 + R1_U), WSP(bf16, WS_R1 + R1_V), INP(14) + pair * 31 * D, INP(15) + pair * D, INP(16) + pair * D, INP(17) + pair * D); SEAM(10); }
        if (IN(11)) { REFRESH();
            pg8::Gemm g{WSP(bf16, WS_R1 + R1_V), WSP(bf16, WS_WB) + WB_PW2, T, D, D, D, 0, 0}; pg8::StaticOrder S; S.init(T, D, F.G, (int)blockIdx.x);
            pg8::EpiResX E{WSP(const bf16, WS_X), nullptr, WSP(bf16, WS_X), D, INP(19) + pair * D, WSP(float, WS_RT + RT_SSQ), nullptr, 0.f};
            pg8::gemm_phase<pg8::EpiResX, pg8::StaticOrder, false, true>(F.lds, g, S, E, F.wave);
            SEAM(11);
        }
        if (IN(12)) { REFRESH(); p12_route1(F, WSP(bf16, WS_X), INP(20) + pair * D, INP(21) + (size_t)pair * D * NE, WSP(bf16, WS_R1 + R1_HN), ws + WS_RT); SEAM(12); }
        if (IN(13)) { REFRESH(); p13_route2(F, WSP(bf16, WS_R1 + R1_HN), WSP(bf16, WS_R2), ws + WS_RT); SEAM(13); }
        if (IN(14)) { REFRESH();
            const unsigned char* rt = ws + WS_RT; const int nch = __builtin_amdgcn_readfirstlane(*(const int*)(rt + RT_NCH));
            pg8::Gemm g{WSP(bf16, WS_R2), WSP(bf16, WS_WB) + WB_E13, nch * 256, 2 * DFE, D / 2, D / 2, pg8::f8_scale(pg8::F8_WSHIFT), pg8::f8_scale(0)};     pg8::MoeOrder S; S.so.init(nch * 256, 2 * DFE, F.G, (int)blockIdx.x); S.load_cb((const int*)(rt + RT_CB)); S.estride = (size_t)2 * DFE * D;
            pg8::EpiSwiglu E{WSP(bf16, WS_R1 + R1_HMOE), DFE, nullptr, 0.f, 0.f, (float)(1 << pg8::F8_HSHIFT)};
            pg8::gemm_phase<pg8::EpiSwiglu, pg8::MoeOrder, true, true, true>(F.lds, g, S, E, F.wave);
            SEAM(14);
        }
        if (IN(15)) { REFRESH();
            const unsigned char* rt = ws + WS_RT; const int nch = __builtin_amdgcn_readfirstlane(*(const int*)(rt + RT_NCH)); const int nfc = nch < NFC ? nch : NFC;
            { pg8::Gemm g{WSP(bf16, WS_R1 + R1_HMOE), WSP(bf16, WS_WB) + WB_E2, nfc * 256, D, DFE / 2, DFE / 2, pg8::f8_scale(pg8::F8_W2SHIFT), pg8::f8_scale(pg8::F8_HSHIFT)};     pg8::MoeOrder S; S.so.init(nfc * 256, D, F.G, (int)blockIdx.x); S.load_cb((const int*)(rt + RT_CB)); S.estride = (size_t)D * DFE;
              pg8::EpiProj E{WSP(bf16, WS_R2), D, 0u, 1.f, nullptr, 0.f, 0.f};
              pg8::gemm_phase<pg8::EpiProj, pg8::MoeOrder, true, true, true>(F.lds, g, S, E, F.wave); }
            if (nch > NFC) {
              pg8::Gemm g{WSP(bf16, WS_R1 + R1_HMOE), WSP(bf16, WS_WB) + WB_E2, 0, D, TAIL_KSLICE / 2, DFE / 2, pg8::f8_scale(pg8::F8_W2SHIFT), pg8::f8_scale(pg8::F8_HSHIFT)}; pg8::TailOrder S; S.nsu = (nch - NFC) * 4 * TAIL_KS; S.G = F.G; S.c = (int)blockIdx.x; S.nfc = NFC; S.KS = TAIL_KS; S.kslice = TAIL_KSLICE / 2; { const int* CB = (const int*)(rt + RT_CB);
#pragma unroll
                for (int e = 0; e < 7; ++e) S.cb[e] = __builtin_amdgcn_readfirstlane(CB[e]); } S.estride = (size_t)D * DFE;
              pg8::EpiProj E{(bf16*)(*(unsigned char* const KAS*)(ka + KA_PART)), D, 0u, 1.f, nullptr, 0.f, 0.f};
              pg8::gemm_phase<pg8::EpiProj, pg8::TailOrder, true, true, true>(F.lds, g, S, E, F.wave); }
            SEAM(15);
        }
        if (IN(16)) { REFRESH();
            const bool last = (pair == 1);
            const bool poison = last && (__hip_atomic_load((gu32*)(ws + WS_CTL) + CW_BAR + (size_t)(*(const int KAS*)(ka + KA_LI)) * XCD_BAR_WORDS + XB_TMO, RLX_AGENT) != 0u);
            p16_combine(F, WSP(bf16, WS_X), WSP(bf16, WS_R2), (const bf16*)(*(unsigned char* const KAS*)(ka + KA_PART)), ws + WS_RT, INP(25), WSP(float, WS_RT + RT_SSQ), *(float* const KAS*)(ka + KA_OUT), last, poison);
            if (pair == 0 && *(const int KAS*)(ka + KA_DBG) == 0 && pb + 17 < PHI()) p0_convert(F, ka, 1, WSP(bf16, WS_WB));
            SEAM(16);
        }
#undef IN
#undef PLO
#undef PHI
#undef SEAM
#undef REFRESH
#undef INP
#undef WSP
}
__global__ void __launch_bounds__(NWAVES * 64, 2) mk_fwd(Args args) {
    extern __shared__ __attribute__((aligned(16))) unsigned char lds[];
    Frame F;
    F.lds = (LAS unsigned char*)lds;
    F.MISC = (volatile LAS unsigned*)(F.lds + MISC_OFF);
    F.tid = threadIdx.x; F.lane = F.tid & 63; F.wave = __builtin_amdgcn_readfirstlane(F.tid >> 6);
    F.G = gridDim.x; { const int bx = blockIdx.x; F.vcu = (F.G % 8 == 0) ? (bx % 8) * (F.G / 8) + bx / 8 : bx; }
    for (int u = F.tid; u < (LDS_BYTES - LDSCTL_OFF) / 4; u += NWAVES * 64) ((LAS unsigned*)(F.lds + LDSCTL_OFF))[u] = 0u;
    __syncthreads();
    unsigned* barw = (unsigned*)((gu32*)(args.ws + WS_CTL) + CW_BAR) + (size_t)args.li * XCD_BAR_WORDS;
    (void)xcd_barrier_post(barw, F.MISC + 8);

    layer_pair<0>(F);
    layer_pair<1>(F);
}
#ifndef MK_DEBUG
#define MK_DEBUG 0
#endif
#ifndef MK_REPORT
#define MK_REPORT -1
#endif
static int mk_grid(size_t ws_need, size_t ws_size, int n_in) {
    static int grid = 0;
    if (grid == 0) {
        if (n_in != 26 || ws_size < ws_need) { fprintf(stderr, "kernel_launch: built for 26 inputs and >= %zu bytes of workspace; got n_in %d, ws %zu; nothing launched\n", ws_need, n_in, ws_size); grid = -1; return grid; }
        int dev = 0, cus = 0, per_cu = 0;
        if (hipGetDevice(&dev) != hipSuccess || hipDeviceGetAttribute(&cus, hipDeviceAttributeMultiprocessorCount, dev) != hipSuccess) { grid = -1; return grid; }
        if (hipFuncSetAttribute((const void*)mk_fwd, hipFuncAttributeMaxDynamicSharedMemorySize, LDS_BYTES) != hipSuccess) { fprintf(stderr, "kernel_launch: hipFuncSetAttribute failed\n"); grid = -1; return grid; }
        if (hipOccupancyMaxActiveBlocksPerMultiprocessor(&per_cu, (const void*)mk_fwd, NWAVES * 64, LDS_BYTES) != hipSuccess || per_cu < 1) { fprintf(stderr, "kernel_launch: occupancy query reports %d\n", per_cu); }
        (void)hipGetLastError();
        grid = cus;
    }
    return grid;
}
#if MK_DEBUG
namespace dbg {
__global__ void __launch_bounds__(256) k_cmp(const void* a, int a_bf16, int lda, float sa, const float* b, int ldb, int rows, int cols, float* acc) {
    const size_t n = (size_t)rows * cols; float d2 = 0.f, b2 = 0.f;
    for (size_t i = (size_t)blockIdx.x * 256 + threadIdx.x; i < n; i += (size_t)gridDim.x * 256) { const size_t r = i / cols, c = i % cols;
        const float av = (a_bf16 ? __uint_as_float((unsigned)((const unsigned short*)a)[r * lda + c] << 16) : ((const float*)a)[r * lda + c]) * sa; const float bv = b[r * ldb + c];
        const float d = av - bv; d2 += d * d; b2 += bv * bv; }
    d2 = orc::wsum(d2); b2 = orc::wsum(b2);
    if ((threadIdx.x & 63) == 0) { atomicAdd(acc, d2); atomicAdd(acc + 1, b2); }
}
__global__ void k_report(float* out, const float* acc, int n, float tol, int which) {
    if (threadIdx.x != 0 || blockIdx.x != 0) return;
    float pert = 0.f;
    if (which < 0) { for (int i = 0; i < n; ++i) { const float e = sqrtf(acc[2 * i] / acc[2 * i + 1]); if (!(e <= tol)) { pert = exp2f((float)(i + 1)); break; } } }
    else { const float e = sqrtf(acc[2 * which] / acc[2 * which + 1]); pert = (e == e) ? e * 1024.f : 3e4f; }
    out[0] += pert;
}
__global__ void __launch_bounds__(256) k_prep(const float* xo, unsigned short* X, float* ssq4) {
    const int row = blockIdx.x * 4 + (threadIdx.x >> 6), lane = threadIdx.x & 63; float s = 0.f;
    for (int j = 0; j < 16; ++j) { const int c = lane + 64 * j; const float v = xo[(size_t)row * 1024 + c]; unsigned u = __float_as_uint(v); u = (u + 0x7fffu + ((u >> 16) & 1u)) >> 16; X[(size_t)row * 1024 + c] = (unsigned short)u; const float r = __uint_as_float(u << 16); s += r * r; }
    s = orc::wsum(s); if (lane < 4) ssq4[(size_t)row * 4 + lane] = lane == 0 ? s : 0.f;
}
static void cmp(hipStream_t st, const void* a, int a_bf16, int lda, float sa, const float* b, int ldb, int rows, int cols, float* acc) {
    hipLaunchKernelGGL(k_cmp, dim3(2048), dim3(256), 0, st, a, a_bf16, lda, sa, b, ldb, rows, cols, acc);
}
}
#endif

extern "C" void kernel_launch(void* const* d_in, const int* in_sizes, int n_in, void* d_out, int out_size, void* d_ws, size_t ws_size, hipStream_t stream) {
#if !MK_DEBUG
    const int grid = mk_grid(WS_FAST_END + (size_t)TAIL_KS * TAIL_ROWS * D * 2, ws_size, n_in); if (grid < 0) return;
    (void)hipMemsetAsync((char*)d_ws + WS_CTL, 0, 65536, stream);
    Args a{};
    for (int i = 0; i < 26; ++i) a.in[i] = (const float*)d_in[i];
    a.out = (float*)d_out; a.ws = (unsigned char*)d_ws; a.part = (unsigned char*)d_ws + WS_FAST_END; a.ph_lo = 0; a.ph_hi = 2 * NPH; a.li = 0; a.dbg = 0;
    hipLaunchKernelGGL(mk_fwd, dim3(grid), dim3(NWAVES * 64), LDS_BYTES, stream, a);
#if defined(PROBE_LO)
    a.ph_lo = PROBE_LO; a.ph_hi = PROBE_HI; a.li = 1; a.out = (float*)((unsigned char*)d_ws + WS_R1);
    hipLaunchKernelGGL(mk_fwd, dim3(grid), dim3(NWAVES * 64), LDS_BYTES, stream, a);
#endif
#else
    const int grid = mk_grid(WS_FAST_END + orc::O_END, ws_size, n_in); if (grid < 0) return;
    (void)hipMemsetAsync((char*)d_ws + WS_CTL, 0, CTL_ZERO_BYTES, stream);
    unsigned char* ws = (unsigned char*)d_ws; unsigned char* ob = ws + WS_FAST_END;
    const orc::In I = orc::make_in(d_in);
    float* Xo = (float*)(ob + orc::O_X); float* Ho = (float*)(ob + orc::O_H); float* BIGo = (float*)(ob + orc::O_BIG);
    unsigned short* Xf = (unsigned short*)(ws + WS_X);
    float* acc = (float*)(ws + WS_CTL + 512 * 1024);
    float* fout = (float*)(ws + WS_R1);
    hipLaunchKernelGGL(orc::k_copy, dim3(T * D / 4 / 256), dim3(256), 0, stream, (const float4*)I.x, (float4*)Xo, (size_t)T * D / 4);
    Args a{};
    for (int i = 0; i < 26; ++i) a.in[i] = (const float*)d_in[i];
    a.out = fout; a.ws = ws; a.part = (unsigned char*)d_out; a.dbg = 1;
    const int plo[4] = {0, 5, 8, 12}, phi[4] = {5, 8, 12, 17};
    for (int sub = 0; sub < 8; ++sub) {
        const int pair = sub >> 2, s4 = sub & 3; float* ac = acc + 2 * 10 * pair;
        hipLaunchKernelGGL(dbg::k_prep, dim3(T / 4), dim3(256), 0, stream, (const float*)Xo, Xf, (float*)(ws + WS_RT + RT_SSQ));
        a.ph_lo = pair * NPH + plo[s4]; a.ph_hi = pair * NPH + phi[s4]; a.li = sub;
        hipLaunchKernelGGL(mk_fwd, dim3(grid), dim3(NWAVES * 64), LDS_BYTES, stream, a);
        orc::sublayer(stream, I, ob, sub);
        if (s4 == 0) {
            const unsigned short* PROJ = (const unsigned short*)(ws + WS_R1 + R1_PROJ); const unsigned short* MIX = (const unsigned short*)(ws + WS_R1 + R1_MIX);
            dbg::cmp(stream, PROJ + 512, 1, NPROJ, 1.f, BIGo + 512, NPROJ, T, 1024, ac + 0);
            dbg::cmp(stream, PROJ, 1, NPROJ, 1.f / attn_body::C2, BIGo, NPROJ, T, 512, ac + 2);
            dbg::cmp(stream, MIX + 512, 1, D, 1.f, Ho + 512, D, T, 512, ac + 4);
            dbg::cmp(stream, MIX, 1, D, 1.f, Ho, D, T, 512, ac + 6);
            dbg::cmp(stream, Xf, 1, D, 1.f, Xo, D, T, D, ac + 8);
        } else if (s4 == 1) {
            const unsigned short* HB = (const unsigned short*)(ws + WS_R1 + R1_HB);
            dbg::cmp(stream, HB + (size_t)8192 * DFF, 1, DFF, 1.f, BIGo, DFF, 8192, DFF, ac + 10);
            dbg::cmp(stream, Xf, 1, D, 1.f, Xo, D, T, D, ac + 12);
        } else if (s4 == 2) {
            const unsigned short* V = (const unsigned short*)(ws + WS_R1 + R1_V);
            dbg::cmp(stream, V, 1, D, 1.f, Ho, D, T, D, ac + 14);
            dbg::cmp(stream, Xf, 1, D, 1.f, Xo, D, T, D, ac + 16);
        } else if (pair == 0) {
            dbg::cmp(stream, Xf, 1, D, 1.f, Xo, D, T, D, ac + 18);
        }
    }
    hipLaunchKernelGGL(orc::k_rmsnorm, dim3(T / 4), dim3(256), 0, stream, (const float*)Xo, I.final_norm_g, (float*)d_out, T);
    dbg::cmp(stream, fout, 0, D, 1.f, (const float*)d_out, D, T, D, acc + 2 * 19);
    hipLaunchKernelGGL(dbg::k_report, dim3(1), dim3(64), 0, stream, (float*)d_out, (const float*)acc, 20, 0.03f, (int)MK_REPORT);
#endif
}
```

```cpp
#include <hip/hip_runtime.h>
#include <cstdio>
#include <cstdint>
#include <cmath>
namespace pg8 {
#define PG8_LAS __attribute__((address_space(3)))
typedef unsigned short bf16_t;
typedef short bf16x8 __attribute__((ext_vector_type(8)));
typedef float f32x4 __attribute__((ext_vector_type(4)));
typedef unsigned u32x4 __attribute__((ext_vector_type(4)));
typedef int i32x4 __attribute__((ext_vector_type(4)));
typedef int i32x8 __attribute__((ext_vector_type(8)));
typedef float f32x8 __attribute__((ext_vector_type(8)));
constexpr int F8_WSHIFT = 5, F8_W2SHIFT = 6, F8_HSHIFT = 4, F8_XSHIFT = 2, F8_FW2SHIFT = 5;
__host__ __device__ constexpr int f8_scale(int shift) { return (127 - shift) * 0x01010101; }
#ifndef PG8_TOUCH
#define PG8_TOUCH 0
#endif
constexpr int BM = 256, BK = 64, HALF = 128, HTB = HALF * BK * 2  , STAGE_BYTES = 8 * HTB, NXCD = 8, WGM = 8;

__host__ __device__ __forceinline__ int lds_byte(int r, int c) { const int st = (r >> 4) * 2 + (c >> 5), rr = r & 15, cc = c & 31, ob = rr * 64 + cc * 2; return st * 1024 + (ob ^ (((ob >> 9) & 1) << 5)); }
__host__ __device__ __forceinline__ void stage_rc(int b, int& R, int& C) { const int st = b / 1024, sb = b % 1024, swz = sb ^ (((sb >> 9) & 1) << 5); R = (st >> 1) * 16 + swz / 64; C = (st & 1) * 32 + (swz % 64) / 2; }
__host__ __device__ __forceinline__ int perm32(int rho) { const int n = rho >> 4, i = rho & 15; return 8 * (i >> 2) + 4 * n + (i & 3); }

struct Unit { int pm, pn, am; size_t ea, eb; };
struct Gemm { const bf16_t* A; const bf16_t* Bt; int M, N, K, ldk; int f8sw, f8sa; };

struct StaticOrder {
    int nM, nN, nwg, G, c;
    __host__ __device__ void init(int M, int N, int G_, int c_) { nM = M / BM; nN = N / BM; nwg = nM * nN; G = G_; c = c_; }
    __host__ __device__ bool next(int i, Unit& u) const {
        const long L = (long)i * G + c; if (L >= nwg) return false;
        int wgid = (int)L; { const int q = nwg / NXCD, r = nwg % NXCD, xcd = wgid % NXCD, off = wgid / NXCD; wgid = (xcd < r ? xcd * (q + 1) : r * (q + 1) + (xcd - r) * q) + off; }
        const int nig = WGM * nN, gid = wgid / nig, fm = gid * WGM, gsz = (nM - fm) < WGM ? (nM - fm) : WGM;
        u.pm = fm + ((wgid % nig) % gsz); u.pn = (wgid % nig) / gsz; u.am = u.pm; u.ea = 0; u.eb = 0; return true;
    }
    __device__ __forceinline__ void a_ready(const Unit&) const {}
    __device__ __forceinline__ void done(const Unit&) const {}
};

__device__ __forceinline__ unsigned cvt_pk_bf16(float lo, float hi) { unsigned r; asm volatile("v_cvt_pk_bf16_f32 %0, %1, %2" : "=v"(r) : "v"(lo), "v"(hi)); return r; }
__device__ __forceinline__ float sigmoid_fast(float x) { return __builtin_amdgcn_rcpf(1.0f + __builtin_amdgcn_exp2f(-1.4426950408889634f * x)); }

struct MoeOrder {
    StaticOrder so; int cb[7]; size_t estride;
    __device__ __forceinline__ void load_cb(const int* CB) {
#pragma unroll
        for (int e = 0; e < 7; ++e) cb[e] = __builtin_amdgcn_readfirstlane(CB[e]); }
    __device__ __forceinline__ int expert_of(int pm) const { int e = 0;
#pragma unroll
        for (int j = 0; j < 7; ++j) e += (pm >= cb[j]) ? 1 : 0;
        return e; }
    __device__ bool next(int i, Unit& u) const { if (!so.next(i, u)) return false; u.eb = (size_t)expert_of(u.pm) * estride; return true; }
    __device__ __forceinline__ void a_ready(const Unit&) const {}
    __device__ __forceinline__ void done(const Unit&) const {}
};

struct TailOrder {
    int nsu, G, c, nfc, KS, kslice; int cb[7]; size_t estride;
    __device__ bool next(int i, Unit& u) const {
        const int L = i * G + c; if (L >= nsu) return false;
        const int ks = L % KS, r = L / KS, pn = r & 3, tc = r >> 2;
        u.pm = ks * 8 + tc; u.pn = pn; u.am = nfc + tc; u.ea = (size_t)ks * kslice * 2; int e = 0;
#pragma unroll
        for (int j = 0; j < 7; ++j) e += (nfc + tc >= cb[j]) ? 1 : 0;
        u.eb = (size_t)e * estride + (size_t)ks * kslice * 2; return true;
    }
    __device__ __forceinline__ void a_ready(const Unit&) const {}
    __device__ __forceinline__ void done(const Unit&) const {}
};

__device__ __forceinline__ float row_rstd(const float* ssq4, int row, float inv_n, float eps) {
    const f32x4 a = *(const f32x4*)(ssq4 + (size_t)row * 4);
    return 1.0f / sqrtf(((a[0] + a[1]) + (a[2] + a[3])) * inv_n + eps);
}
__device__ __forceinline__ void load_rstd8(float (&rs)[2][4], const float* ssq4, int row0, float inv_n, float eps, float mul) {
    f32x4 q[2][4];
#pragma unroll
    for (int ai = 0; ai < 2; ++ai)
#pragma unroll
        for (int m = 0; m < 4; ++m) q[ai][m] = *(const f32x4*)(ssq4 + (size_t)(row0 + ai * HALF + m * 16) * 4);
#pragma unroll
    for (int ai = 0; ai < 2; ++ai)
#pragma unroll
        for (int m = 0; m < 4; ++m) rs[ai][m] = mul / sqrtf(((q[ai][m][0] + q[ai][m][1]) + (q[ai][m][2] + q[ai][m][3])) * inv_n + eps);
}
struct EpiProj {
    static constexpr bool PERM = true, AFTER_DRAIN = false;
    bf16_t* O; int ldc; unsigned smask; float sc; const float* ssq4; float inv_n, eps;
    __device__ __forceinline__ void operator()(const f32x4 (&acc)[2][2][4][2], const Unit& u, int wr, int wc, int fr, int fq) const {
        const int row0 = u.pm * BM + wr * 64 + fr, col0 = u.pn * BM + wc * 32 + 8 * fq; const float s = ((smask >> u.pn) & 1u) ? sc : 1.f;
        float rsv[2][4];
        if (ssq4) load_rstd8(rsv, ssq4, row0, inv_n, eps, s); else {
#pragma unroll
            for (int ai = 0; ai < 2; ++ai)
#pragma unroll
                for (int m = 0; m < 4; ++m) rsv[ai][m] = s; }
#pragma unroll
        for (int ai = 0; ai < 2; ++ai)
#pragma unroll
            for (int m = 0; m < 4; ++m) { const int row = row0 + ai * HALF + m * 16; bf16_t* rowp = O + (size_t)row * ldc + col0; const float rs = rsv[ai][m];
#pragma unroll
                for (int bj = 0; bj < 2; ++bj) { const f32x4 v0 = acc[ai][bj][m][0] * rs, v1 = acc[ai][bj][m][1] * rs;
                    u32x4 w; w.x = cvt_pk_bf16(v0[0], v0[1]); w.y = cvt_pk_bf16(v0[2], v0[3]); w.z = cvt_pk_bf16(v1[0], v1[1]); w.w = cvt_pk_bf16(v1[2], v1[3]);
                    *(u32x4*)(rowp + bj * HALF) = w; } }
    }
};
struct EpiSwiglu {
    static constexpr bool PERM = true, AFTER_DRAIN = false;
    bf16_t* O; int ldc; const float* ssq4; float inv_n, eps; float f8s;
    __device__ __forceinline__ void operator()(const f32x4 (&acc)[2][2][4][2], const Unit& u, int wr, int wc, int fr, int fq) const {
        const int row0 = u.pm * BM + wr * 64 + fr, col0 = u.pn * HALF + wc * 32 + 8 * fq;
        float rsv[2][4];
        if (ssq4) load_rstd8(rsv, ssq4, row0, inv_n, eps, 1.0f); else {
#pragma unroll
            for (int ai = 0; ai < 2; ++ai)
#pragma unroll
                for (int m = 0; m < 4; ++m) rsv[ai][m] = 1.0f; }
#pragma unroll
        for (int ai = 0; ai < 2; ++ai)
#pragma unroll
            for (int m = 0; m < 4; ++m) { const int row = row0 + ai * HALF + m * 16; bf16_t* rowp = O + (size_t)row * ldc + col0; const float rs = rsv[ai][m];
                const float c1 = -1.4426950408889634f * rs, c2 = rs * rs * (f8s != 0.f ? f8s : 1.0f);
                float h[8];
#pragma unroll
                for (int n = 0; n < 2; ++n)
#pragma unroll
                    for (int i = 0; i < 4; ++i) { const float g = acc[ai][0][m][n][i], up = acc[ai][1][m][n][i]; h[4 * n + i] = (g * up) * c2 * __builtin_amdgcn_rcpf(1.0f + __builtin_amdgcn_exp2f(g * c1)); }
                if (f8s != 0.f) { typedef unsigned u32x2 __attribute__((ext_vector_type(2)));
#pragma unroll
                    for (int i = 0; i < 8; ++i) h[i] = __builtin_amdgcn_fmed3f(h[i], -400.f, 400.f);
                    int w0 = __builtin_amdgcn_cvt_pk_fp8_f32(h[0], h[1], 0, false); w0 = __builtin_amdgcn_cvt_pk_fp8_f32(h[2], h[3], w0, true);
                    int w1 = __builtin_amdgcn_cvt_pk_fp8_f32(h[4], h[5], 0, false); w1 = __builtin_amdgcn_cvt_pk_fp8_f32(h[6], h[7], w1, true);
                    *(u32x2*)((unsigned char*)O + (size_t)row * ldc + col0) = (u32x2){(unsigned)w0, (unsigned)w1}; }
                else {
                u32x4 w; w.x = cvt_pk_bf16(h[0], h[1]); w.y = cvt_pk_bf16(h[2], h[3]); w.z = cvt_pk_bf16(h[4], h[5]); w.w = cvt_pk_bf16(h[6], h[7]);
                *(u32x4*)rowp = w; } }
    }
};
struct EpiGlu {
    static constexpr bool PERM = true, AFTER_DRAIN = false;
    bf16_t* O; int ldc; const float* bias; int nh; const float* ssq4; float inv_n, eps;
    __device__ __forceinline__ void operator()(const f32x4 (&acc)[2][2][4][2], const Unit& u, int wr, int wc, int fr, int fq) const {
        const int row0 = u.pm * BM + wr * 64 + fr, col0 = u.pn * HALF + wc * 32 + 8 * fq;
        const f32x4 ba0 = *(const f32x4*)(bias + col0), ba1 = *(const f32x4*)(bias + col0 + 4), bg0 = *(const f32x4*)(bias + nh + col0), bg1 = *(const f32x4*)(bias + nh + col0 + 4);
        float rsv[2][4];
        if (ssq4) load_rstd8(rsv, ssq4, row0, inv_n, eps, 1.0f); else {
#pragma unroll
            for (int ai = 0; ai < 2; ++ai)
#pragma unroll
                for (int m = 0; m < 4; ++m) rsv[ai][m] = 1.0f; }
#pragma unroll
        for (int ai = 0; ai < 2; ++ai)
#pragma unroll
            for (int m = 0; m < 4; ++m) { const int row = row0 + ai * HALF + m * 16; bf16_t* rowp = O + (size_t)row * ldc + col0; const float rs = rsv[ai][m];
                const f32x4 a0 = acc[ai][0][m][0] * rs + ba0, a1 = acc[ai][0][m][1] * rs + ba1, g0 = acc[ai][1][m][0] * rs + bg0, g1 = acc[ai][1][m][1] * rs + bg1;
                float h[8];
#pragma unroll
                for (int i = 0; i < 4; ++i) { h[i] = a0[i] * sigmoid_fast(g0[i]); h[4 + i] = a1[i] * sigmoid_fast(g1[i]); }
                u32x4 w; w.x = cvt_pk_bf16(h[0], h[1]); w.y = cvt_pk_bf16(h[2], h[3]); w.z = cvt_pk_bf16(h[4], h[5]); w.w = cvt_pk_bf16(h[6], h[7]);
                *(u32x4*)rowp = w; }
    }
};
struct EpiResX {
    static constexpr bool PERM = false, AFTER_DRAIN = true;
    const bf16_t* baseb; const float* basef; bf16_t* out; int ldc; const float* bias; float* ssq4; unsigned char* x8; float x8s;
    __device__ __forceinline__ const char* res_row(const Unit& u, int r) const { return (const char*)(baseb + (size_t)(u.pm * BM + r) * ldc + u.pn * BM); }
    __device__ __forceinline__ void fused(f32x4 (&acc)[2][2][4][2], const Unit& u, int wr, int wc, int fr, int fq, PG8_LAS unsigned char* lds, int wid, int lane) const {
        typedef unsigned u32x2 __attribute__((ext_vector_type(2)));
        typedef unsigned u32x4 __attribute__((ext_vector_type(4)));
        constexpr int PAIR = 1056;
        PG8_LAS float* P = (PG8_LAS float*)(lds + 128 * PAIR);
        { const char* gs = res_row(u, wid * 32 + (lane >> 5)) + (lane & 31) * 16; const size_t rp = (size_t)ldc * 4;
#pragma unroll
          for (int j = 0; j < 16; ++j) __builtin_amdgcn_global_load_lds((const unsigned*)(gs + j * rp), (PG8_LAS unsigned*)(lds + (wid * 16 + j) * PAIR), 16, 0, 0); }
        const int col0 = u.pn * BM + wc * 32 + 4 * fq;
        f32x4 bv[2][2];
#pragma unroll
        for (int bj = 0; bj < 2; ++bj)
#pragma unroll
            for (int n = 0; n < 2; ++n) bv[bj][n] = bias ? *(const f32x4*)(bias + col0 + bj * HALF + n * 16) : (f32x4){0.f, 0.f, 0.f, 0.f};
        asm volatile("s_waitcnt vmcnt(0)" ::: "memory"); __builtin_amdgcn_s_barrier(); asm volatile("" ::: "memory");
#if defined(MK_STAT)
        const unsigned long long se_a = __builtin_amdgcn_s_memrealtime();
#endif
#pragma unroll
        for (int ai = 0; ai < 2; ++ai) {
#pragma unroll
            for (int m = 0; m < 4; ++m) { const int rl = ai * HALF + wr * 64 + m * 16 + fr; PG8_LAS unsigned char* rowp = lds + (rl >> 1) * PAIR + (rl & 1) * 512 + (wc * 32 + 4 * fq) * 2; float ss = 0.f;
#pragma unroll
                for (int bj = 0; bj < 2; ++bj)
#pragma unroll
                    for (int n = 0; n < 2; ++n) { PG8_LAS u32x2* q = (PG8_LAS u32x2*)(rowp + (bj * HALF + n * 16) * 2); const u32x2 rw = *q;
                        const f32x4 rs = (f32x4){__uint_as_float(rw.x << 16), __uint_as_float(rw.x & 0xffff0000u), __uint_as_float(rw.y << 16), __uint_as_float(rw.y & 0xffff0000u)};
                        const f32x4 o = rs + acc[ai][bj][m][n] + bv[bj][n]; u32x2 w; w.x = cvt_pk_bf16(o[0], o[1]); w.y = cvt_pk_bf16(o[2], o[3]); *q = w;
                        const float r0 = __uint_as_float(w.x << 16), r1 = __uint_as_float(w.x & 0xffff0000u), r2 = __uint_as_float(w.y << 16), r3 = __uint_as_float(w.y & 0xffff0000u); ss += (r0 * r0 + r1 * r1) + (r2 * r2 + r3 * r3); }
                ss += __shfl_xor(ss, 16); ss += __shfl_xor(ss, 32);
                if (fq == 0) P[rl * 4 + wc] = ss; }
            asm volatile("" ::: "memory"); }
#if defined(MK_STAT)
        const unsigned long long se_b = __builtin_amdgcn_s_memrealtime();
        if (wid == 0 && lane == 0) { PG8_LAS unsigned* sw = (PG8_LAS unsigned*)(lds + 143360 + 1024); if (sw[8] == (unsigned)MK_STAT_PARAM) { sw[15] += (unsigned)(se_b - se_a); sw[16] = (unsigned)se_a; } }
#endif
        asm volatile("s_waitcnt lgkmcnt(0)" ::: "memory"); __builtin_amdgcn_s_barrier(); asm volatile("" ::: "memory");
        { char* gd = (char*)(out + (size_t)(u.pm * BM + wid * 32 + (lane >> 5)) * ldc + u.pn * BM) + (lane & 31) * 16; const size_t rp = (size_t)ldc * 4;
          unsigned char* g8 = x8 ? x8 + (size_t)(u.pm * BM + wid * 32 + (lane >> 5)) * ldc + u.pn * BM + (lane & 31) * 8 : nullptr;
#pragma unroll
          for (int j = 0; j < 16; ++j) { const u32x4 w = *(const PG8_LAS u32x4*)(lds + (wid * 16 + j) * PAIR + lane * 16); *(u32x4*)(gd + j * rp) = w;
              if (x8) { u32x2 o8;
#pragma unroll
                  for (int h = 0; h < 2; ++h) { const unsigned w0 = h ? w.z : w.x, w1 = h ? w.w : w.y;
                      int q8 = __builtin_amdgcn_cvt_pk_fp8_f32(__builtin_amdgcn_fmed3f(__uint_as_float(w0 << 16) * x8s, -440.f, 440.f), __builtin_amdgcn_fmed3f(__uint_as_float(w0 & 0xffff0000u) * x8s, -440.f, 440.f), 0, false);
                      q8 = __builtin_amdgcn_cvt_pk_fp8_f32(__builtin_amdgcn_fmed3f(__uint_as_float(w1 << 16) * x8s, -440.f, 440.f), __builtin_amdgcn_fmed3f(__uint_as_float(w1 & 0xffff0000u) * x8s, -440.f, 440.f), q8, true);
                      if (h) o8.y = (unsigned)q8; else o8.x = (unsigned)q8; }
                  *(u32x2*)(g8 + j * (rp >> 1)) = o8; } } }
        const int tid = wid * 64 + lane;
        if (tid < 256) { const f32x4 q = *(const PG8_LAS f32x4*)(P + tid * 4); ssq4[(size_t)(u.pm * BM + tid) * 4 + u.pn] = (q[0] + q[1]) + (q[2] + q[3]); }
    }
};

template <class Epi, class Sched, bool ALIGN_EPI = false, bool SP2 = false, bool F8 = false>
__device__ __forceinline__ void gemm_phase(PG8_LAS unsigned char* lds, const Gemm g, const Sched& S, const Epi& E, const int wid_in  ) {
    int lane_ = (int)__builtin_amdgcn_mbcnt_hi(~0u, __builtin_amdgcn_mbcnt_lo(~0u, 0u)); asm volatile("" : "+v"(lane_));
    const int wid = wid_in, lane = lane_, tid = wid * 64 + lane, wr = wid >> 2, wc = wid & 3, fr = lane & 15, fq = lane >> 4;
    const int K = g.ldk, nt = g.K / BK;
    unsigned voffA[2], voffB[2];
#pragma unroll
    for (int i = 0; i < 2; ++i) { int R, C; stage_rc(tid * 16 + i * 8192, R, C); const int Rb = Epi::PERM ? ((R & ~31) + perm32(R & 31)) : R;
        voffA[i] = (unsigned)(R * K + C) * 2u; voffB[i] = (unsigned)(Rb * K + C) * 2u; }
    const size_t kstep = (size_t)(BK * 2);
    const size_t hstep = (size_t)HALF * K * 2;
    const size_t tstep = 2 * hstep;
    const unsigned ldsw = (unsigned)wid * 1024u;
    const int fcol = fq * 8;
    const int aoff = lds_byte(wr * 64 + fr, fcol), boff = lds_byte(wc * 32 + fr, fcol);
#define PG8_SA(b, h) (((b) * 2 + (h)) * HTB)
#define PG8_SB(b, h) ((4 + (b) * 2 + (h)) * HTB)
#define PG8_STAGE(bufoff, gbase, voff) do { _Pragma("unroll") for (int _i = 0; _i < 2; ++_i) \
        __builtin_amdgcn_global_load_lds((const unsigned*)((const char*)(gbase) + (voff)[_i]), (PG8_LAS unsigned*)(lds + (bufoff) + ldsw + _i * 8192), 16, 0, 0); } while (0)
#define PG8_LD32(base_) __builtin_shufflevector(__builtin_bit_cast(i32x4, *(const PG8_LAS bf16x8*)(base_)), __builtin_bit_cast(i32x4, *(const PG8_LAS bf16x8*)((base_) + 1024)), 0, 1, 2, 3, 4, 5, 6, 7)
#define PG8_LDA(dst, b, h) do { if constexpr (F8) { _Pragma("unroll") for (int m = 0; m < 4; ++m) dst##_8[m] = PG8_LD32(lds + PG8_SA(b, h) + aoff + m * 2048); } \
        else { _Pragma("unroll") for (int m = 0; m < 4; ++m) _Pragma("unroll") for (int k = 0; k < 2; ++k) dst[m][k] = *(const PG8_LAS bf16x8*)(lds + PG8_SA(b, h) + aoff + m * 2048 + k * 1024); } } while (0)
#define PG8_LDB(dst, b, h) do { if constexpr (F8) { _Pragma("unroll") for (int n = 0; n < 2; ++n) dst##_8[n] = PG8_LD32(lds + PG8_SB(b, h) + boff + n * 2048); } \
        else { _Pragma("unroll") for (int n = 0; n < 2; ++n) _Pragma("unroll") for (int k = 0; k < 2; ++k) dst[n][k] = *(const PG8_LAS bf16x8*)(lds + PG8_SB(b, h) + boff + n * 2048 + k * 1024); } } while (0)
#define PG8_MMA(ai, bj, At, Bt) do { __builtin_amdgcn_s_setprio(1); \
        if constexpr (F8) { _Pragma("unroll") for (int m = 0; m < 4; ++m) _Pragma("unroll") for (int n = 0; n < 2; ++n) \
            asm volatile("v_mfma_scale_f32_16x16x128_f8f6f4 %0, %1, %2, %0, %3, %4 op_sel_hi:[0,0,0]" : "+v"(acc[ai][bj][m][n]) : "v"(Bt##_8[n]), "v"(At##_8[m]), "v"(f8sw), "v"(f8sa)); } \
        else { _Pragma("unroll") for (int m = 0; m < 4; ++m) _Pragma("unroll") for (int n = 0; n < 2; ++n) _Pragma("unroll") for (int k = 0; k < 2; ++k) \
            acc[ai][bj][m][n] = __builtin_amdgcn_mfma_f32_16x16x32_bf16(Bt[n][k], At[m][k], acc[ai][bj][m][n], 0, 0, 0); } \
        __builtin_amdgcn_s_setprio(0); } while (0)
#define PG8_WAIT_V(n) asm volatile("s_waitcnt vmcnt(" #n ")" ::: "memory")
#define PG8_WAIT_L(n) asm volatile("s_waitcnt lgkmcnt(" #n ")" ::: "memory")
#define PG8_BAR __builtin_amdgcn_s_barrier()
#define PG8_SCHED __builtin_amdgcn_sched_barrier(0)
#if defined(MK_STAT)
    const unsigned long long st_in = __builtin_amdgcn_s_memrealtime(); bool st_first = true;
#endif
    Unit cur, nxt; int ui = 0;
    if (!S.next(0, cur)) return;
    f32x4 acc[2][2][4][2];
#pragma unroll
    for (int a = 0; a < 2; ++a)
#pragma unroll
        for (int b = 0; b < 2; ++b)
#pragma unroll
            for (int m = 0; m < 4; ++m)
#pragma unroll
                for (int n = 0; n < 2; ++n) acc[a][b][m][n] = (f32x4){0.f, 0.f, 0.f, 0.f};
    int f8sw = g.f8sw, f8sa = g.f8sa; (void)f8sw; (void)f8sa;
    bf16x8 At[4][2], B0[2][2], B1[2][2]; i32x8 At_8[4], B0_8[2], B1_8[2];
    const char* cA = (const char*)g.A + (size_t)cur.am * tstep + cur.ea; const char* cB = (const char*)g.Bt + (size_t)cur.pn * tstep + cur.eb;
    S.a_ready(cur);
#if PG8_TOUCH
    if constexpr (Epi::AFTER_DRAIN) {
        const char* tr = E.res_row(cur, tid >> 1) + (tid & 1) * 256;
        __builtin_amdgcn_global_load_lds((const unsigned*)tr, (PG8_LAS unsigned*)(lds + STAGE_BYTES + wid * 256), 4, 0, 0);
        __builtin_amdgcn_global_load_lds((const unsigned*)(tr + 128), (PG8_LAS unsigned*)(lds + STAGE_BYTES + wid * 256), 4, 0, 0);
    }
#endif
    if constexpr (SP2) {
        PG8_STAGE(PG8_SB(0, 0), cB, voffB); PG8_STAGE(PG8_SB(0, 1), cB + hstep, voffB); PG8_STAGE(PG8_SA(0, 0), cA, voffA); PG8_STAGE(PG8_SA(0, 1), cA + hstep, voffA);
        if (wr == 1) PG8_BAR;
        PG8_WAIT_V(2); PG8_BAR;
        PG8_STAGE(PG8_SB(1, 0), cB + kstep, voffB); PG8_STAGE(PG8_SA(1, 0), cA + kstep, voffA); PG8_STAGE(PG8_SB(1, 1), cB + hstep + kstep, voffB);
        PG8_WAIT_V(6); PG8_BAR;
    } else {
        PG8_STAGE(PG8_SB(0, 0), cB, voffB); PG8_STAGE(PG8_SA(0, 0), cA, voffA); PG8_STAGE(PG8_SB(0, 1), cB + hstep, voffB); PG8_STAGE(PG8_SA(0, 1), cA + hstep, voffA);
        if (wr == 1) PG8_BAR;
        PG8_WAIT_V(4); PG8_BAR;
        PG8_STAGE(PG8_SB(1, 0), cB + kstep, voffB); PG8_STAGE(PG8_SA(1, 0), cA + kstep, voffA); PG8_STAGE(PG8_SB(1, 1), cB + hstep + kstep, voffB);
        PG8_WAIT_V(6); PG8_BAR;
    }
    for (;;) {
        const bool has_next = S.next(ui + 1, nxt);
        const char* nA = has_next ? (const char*)g.A + (size_t)nxt.am * tstep + nxt.ea : cA; const char* nB = has_next ? (const char*)g.Bt + (size_t)nxt.pn * tstep + nxt.eb : cB;
#if defined(MK_STAT)
        const unsigned long long st_t0 = __builtin_amdgcn_s_memrealtime();
#endif
        for (int t = 0; t < nt; t += 2) {
            const bool last = (t == nt - 2);
            const char* a1 = cA + (size_t)(t + 1) * kstep;
            const char* a2 = last ? nA : cA + (size_t)(t + 2) * kstep; const char* b2 = last ? nB : cB + (size_t)(t + 2) * kstep;
            const char* a3 = a2 + kstep; const char* b3 = b2 + kstep;
            if (last && has_next) S.a_ready(nxt);
            if constexpr (SP2) {
            PG8_LDB(B0, 0, 0); PG8_LDB(B1, 0, 1); PG8_SCHED; PG8_LDA(At, 0, 0); PG8_STAGE(PG8_SA(1, 1), a1 + hstep, voffA);
            PG8_WAIT_V(8); PG8_WAIT_L(0); PG8_BAR; PG8_MMA(0, 0, At, B0); PG8_MMA(0, 1, At, B1); PG8_BAR; PG8_SCHED;
            PG8_LDA(At, 0, 1); PG8_STAGE(PG8_SB(0, 0), b2, voffB); PG8_STAGE(PG8_SB(0, 1), b2 + hstep, voffB); PG8_STAGE(PG8_SA(0, 0), a2, voffA);
            PG8_WAIT_V(8); PG8_WAIT_L(0); PG8_BAR; PG8_MMA(1, 0, At, B0); PG8_MMA(1, 1, At, B1); PG8_BAR; PG8_SCHED;
            PG8_LDB(B0, 1, 0); PG8_LDB(B1, 1, 1); PG8_SCHED; PG8_LDA(At, 1, 0); PG8_STAGE(PG8_SA(0, 1), a2 + hstep, voffA);
            PG8_WAIT_V(8); PG8_WAIT_L(0); PG8_BAR; PG8_MMA(0, 0, At, B0); PG8_MMA(0, 1, At, B1); PG8_BAR; PG8_SCHED;
            PG8_LDA(At, 1, 1); PG8_STAGE(PG8_SB(1, 0), b3, voffB); PG8_STAGE(PG8_SB(1, 1), b3 + hstep, voffB); PG8_STAGE(PG8_SA(1, 0), a3, voffA);
            PG8_WAIT_V(8); PG8_WAIT_L(0); PG8_BAR; PG8_MMA(1, 0, At, B0); PG8_MMA(1, 1, At, B1); PG8_BAR; PG8_SCHED;
            } else {
            PG8_LDB(B0, 0, 0); PG8_SCHED; PG8_LDA(At, 0, 0); PG8_STAGE(PG8_SA(1, 1), a1 + hstep, voffA);
            PG8_WAIT_L(8); PG8_BAR; PG8_WAIT_L(0); PG8_MMA(0, 0, At, B0); PG8_BAR; PG8_SCHED;
            PG8_LDB(B1, 0, 1); PG8_STAGE(PG8_SB(0, 0), b2, voffB);
            PG8_BAR; PG8_WAIT_L(0); PG8_MMA(0, 1, At, B1); PG8_BAR;
            PG8_LDA(At, 0, 1); PG8_STAGE(PG8_SA(0, 0), a2, voffA);
            PG8_BAR; PG8_WAIT_L(0); PG8_MMA(1, 0, At, B0); PG8_BAR; PG8_SCHED;
            PG8_STAGE(PG8_SB(0, 1), b2 + hstep, voffB);
            PG8_WAIT_V(6); PG8_BAR; PG8_MMA(1, 1, At, B1); PG8_BAR;
            PG8_LDB(B0, 1, 0); PG8_SCHED; PG8_LDA(At, 1, 0); PG8_STAGE(PG8_SA(0, 1), a2 + hstep, voffA);
            PG8_WAIT_L(8); PG8_BAR; PG8_WAIT_L(0); PG8_MMA(0, 0, At, B0); PG8_BAR; PG8_SCHED;
            PG8_LDB(B1, 1, 1); PG8_STAGE(PG8_SB(1, 0), b3, voffB);
            PG8_BAR; PG8_WAIT_L(0); PG8_MMA(0, 1, At, B1); PG8_BAR;
            PG8_LDA(At, 1, 1); PG8_STAGE(PG8_SA(1, 0), a3, voffA);
            PG8_BAR; PG8_WAIT_L(0); PG8_MMA(1, 0, At, B0); PG8_BAR; PG8_SCHED;
            PG8_STAGE(PG8_SB(1, 1), b3 + hstep, voffB);
            PG8_WAIT_V(6); PG8_BAR; PG8_MMA(1, 1, At, B1); PG8_BAR;
            }
        }
#if defined(MK_STAT)
        const unsigned long long st_t1 = __builtin_amdgcn_s_memrealtime();
#endif
        if constexpr (F8) asm volatile("s_nop 15\n\ts_nop 7" ::: "memory");
        if constexpr (ALIGN_EPI) { if (wr == 0) PG8_BAR; }
        if constexpr (!Epi::AFTER_DRAIN) { E(acc, cur, wr, wc, fr, fq); S.done(cur); }
#if defined(MK_STAT)
        if (wid == 0 && lane == 0) { PG8_LAS unsigned* sw = (PG8_LAS unsigned*)(lds + 143360 + 1024); if (sw[8] == (unsigned)MK_STAT_PARAM) { sw[9] += (unsigned)(st_t1 - st_t0); if (st_first) sw[10] += (unsigned)(st_t0 - st_in); } st_first = false; sw[0] += (unsigned)(st_t1 - st_t0); sw[1] += (unsigned)(__builtin_amdgcn_s_memrealtime() - st_t1); sw[2] += 1u; if (F8) { sw[3] += (unsigned)(st_t1 - st_t0); sw[5] += (unsigned)nt; } else sw[4] += (unsigned)nt; }
#endif
        if (!has_next) break;
#pragma unroll
        for (int a = 0; a < 2; ++a)
#pragma unroll
            for (int b = 0; b < 2; ++b)
#pragma unroll
                for (int m = 0; m < 4; ++m)
#pragma unroll
                    for (int n = 0; n < 2; ++n) acc[a][b][m][n] = (f32x4){0.f, 0.f, 0.f, 0.f};
        cur = nxt; cA = nA; cB = nB; ++ui;
        if constexpr (ALIGN_EPI) { if (wr == 1) PG8_BAR; }
    }
#if defined(MK_STAT)
    const unsigned long long st_out = __builtin_amdgcn_s_memrealtime();
#endif
    PG8_WAIT_V(0);
    if constexpr (!ALIGN_EPI) { if (wr == 0) PG8_BAR; }
    PG8_BAR;
#if defined(MK_STAT)
    const unsigned long long st_d1 = __builtin_amdgcn_s_memrealtime();
#endif
    if constexpr (Epi::AFTER_DRAIN) { E.fused(acc, cur, wr, wc, fr, fq, lds, wid, lane); S.done(cur); }
#if defined(MK_STAT)
    const unsigned long long st_d2 = __builtin_amdgcn_s_memrealtime();
#endif
#if defined(MK_STAT)
    if (wid == 0 && lane == 0) { asm volatile("s_waitcnt vmcnt(0)" ::: "memory"); PG8_LAS unsigned* sw = (PG8_LAS unsigned*)(lds + 143360 + 1024); if (sw[8] == (unsigned)MK_STAT_PARAM) { const unsigned long long st_d3 = __builtin_amdgcn_s_memrealtime(); sw[11] += (unsigned)(st_d3 - st_out); sw[12] += (unsigned)(st_d1 - st_out); sw[13] += (unsigned)(st_d2 - st_d1); sw[14] += (unsigned)(st_d3 - st_d2); sw[17] += sw[16] - (unsigned)st_d1; } }
#endif
#undef PG8_SA
#undef PG8_SB
#undef PG8_STAGE
#undef PG8_LDA
#undef PG8_LDB
#undef PG8_MMA
#undef PG8_LD32
#undef PG8_WAIT_V
#undef PG8_WAIT_L
#undef PG8_BAR
#undef PG8_SCHED
}
}
#include <hip/hip_bf16.h>
#include <cmath>
namespace attn_body {
using bf16=__hip_bfloat16;
using bf16x8=__attribute__((ext_vector_type(8)))short;
using s16x4=__attribute__((ext_vector_type(4)))short;
using f32x16=__attribute__((ext_vector_type(16)))float;
using u32x4=__attribute__((ext_vector_type(4)))unsigned;
constexpr int BATCH=2,SEQ=8192,D=64,DM=2304,DMO=1024;
constexpr int NW=8,QBLK=32,QB=QBLK*NW,KVBLK=64,NQB=SEQ/QB;
constexpr int ATTN_UNIT_ROWS=QB;
__device__ __forceinline__ int crow(int r,int hi){return (r&3)+8*(r>>2)+4*hi;}
#define SBAR() __builtin_amdgcn_sched_barrier(0)
__device__ __forceinline__ void cmask(f32x16&p0,f32x16&p1,int jb,int qrel,int hi){
  const float NEG=-INFINITY; int kb=64*jb+4*hi;
  #pragma unroll
  for(int r=0;r<16;++r){int kv=kb+(r&3)+8*(r>>2); if(kv>qrel)p0[r]=NEG; if(kv+32>qrel)p1[r]=NEG;}
}

constexpr int NSLOT=3, SLOTB=8192;
constexpr int LDS_K=0, LDS_V=NSLOT*SLOTB, LDS_WS=2*NSLOT*SLOTB, LDS_OST=LDS_WS+NW*64*4, LDS_BYTES=LDS_OST+NW*4096;
constexpr float C2=0.125f*1.4426950408889634f;
__device__ __forceinline__ void glds16(const void*sbase,unsigned voff,unsigned lds_dst){unsigned keep;
  asm volatile("s_mov_b32 %0, m0\n\ts_mov_b32 m0, %2\n\ts_nop 0\n\tglobal_load_lds_dwordx4 %1, %3\n\ts_mov_b32 m0, %0":"=&s"(keep):"v"(voff),"s"(lds_dst),"s"(sbase):"memory");}
__device__ __forceinline__ float max3f(float a,float b,float c){float r;asm("v_max3_f32 %0, %1, %2, %3":"=v"(r):"v"(a),"v"(b),"v"(c));return r;}
__device__ __forceinline__ float max2f(float a,float b){float r;asm("v_max_f32_e32 %0, %1, %2":"=v"(r):"v"(a),"v"(b));return r;}
__device__ __forceinline__ float fadd_s(float a,float b){float r;asm("v_add_f32_e32 %0, %1, %2":"=v"(r):"v"(a),"v"(b));return r;}
__device__ __forceinline__ float fsub_s(float a,float b){float r;asm("v_sub_f32_e32 %0, %1, %2":"=v"(r):"v"(a),"v"(b));return r;}
typedef float f32x2_t __attribute__((ext_vector_type(2))); typedef __bf16 bf16x2_t __attribute__((ext_vector_type(2)));
__device__ __forceinline__ unsigned cvtpk_s(float lo,float hi){f32x2_t v={lo,hi};bf16x2_t b=__builtin_convertvector(v,bf16x2_t);return __builtin_bit_cast(unsigned,b);}
#define WAIT_BAR(N) asm volatile("s_waitcnt vmcnt(" #N ") lgkmcnt(0)\n\ts_barrier":::"memory")

__device__ __forceinline__ void swmask(f32x16&p0,f32x16&p1,int tl,int ql,int hi){
  const float NEG=-INFINITY; int kb=64*tl+4*hi;
  #pragma unroll
  for(int r=0;r<16;++r){int kv=kb+(r&3)+8*(r>>2); if(kv>ql||kv+128<=ql)p0[r]=NEG; if(kv+32>ql||kv+160<=ql)p1[r]=NEG;}
}
__device__ __forceinline__ void qkt(f32x16&p0,f32x16&p1,const char*Kslot,const bf16x8*qr,const f32x16&negm,int r32,int hi){
  const char*kb=Kslot+hi*1024+r32*16;
  #pragma unroll
  for(int d0=0;d0<4;++d0){
    const bf16x8 b0=*reinterpret_cast<const bf16x8*>(kb+d0*2048);
    const bf16x8 b1=*reinterpret_cast<const bf16x8*>(kb+d0*2048+512);
    if(d0==0){p0=__builtin_amdgcn_mfma_f32_32x32x16_bf16(b0,qr[0],negm,0,0,0);p1=__builtin_amdgcn_mfma_f32_32x32x16_bf16(b1,qr[0],negm,0,0,0);}
    else{p0=__builtin_amdgcn_mfma_f32_32x32x16_bf16(b0,qr[d0],p0,0,0,0);p1=__builtin_amdgcn_mfma_f32_32x32x16_bf16(b1,qr[d0],p1,0,0,0);}}
}
typedef __attribute__((address_space(3))) const char* lds_cptr;
typedef short v4i16_t __attribute__((ext_vector_type(4)));
__device__ __forceinline__ void kload8(bf16x8*kf,lds_cptr kp){
  kf[0]=*(const __attribute__((address_space(3))) bf16x8*)(kp);      kf[1]=*(const __attribute__((address_space(3))) bf16x8*)(kp+512);
  kf[2]=*(const __attribute__((address_space(3))) bf16x8*)(kp+2048); kf[3]=*(const __attribute__((address_space(3))) bf16x8*)(kp+2560);
  kf[4]=*(const __attribute__((address_space(3))) bf16x8*)(kp+4096); kf[5]=*(const __attribute__((address_space(3))) bf16x8*)(kp+4608);
  kf[6]=*(const __attribute__((address_space(3))) bf16x8*)(kp+6144); kf[7]=*(const __attribute__((address_space(3))) bf16x8*)(kp+6656);
}
__device__ __forceinline__ void kload2(bf16x8*kf,lds_cptr kp,int j){ kf[2*j]=*(const __attribute__((address_space(3))) bf16x8*)(kp+j*2048); kf[2*j+1]=*(const __attribute__((address_space(3))) bf16x8*)(kp+j*2048+512); }
__device__ __forceinline__ s16x4 vtr(lds_cptr p){ return __builtin_bit_cast(s16x4,__builtin_amdgcn_ds_read_tr16_b64_v4i16((__attribute__((address_space(3))) v4i16_t*)p)); }
__device__ __forceinline__ float rowmax(const f32x16&p0,const f32x16&p1){
  float a=max3f(p0[0],p0[1],p1[0]),b=max3f(p0[2],p0[3],p1[1]);a=max3f(a,p1[2],p1[3]);
  #pragma unroll
  for(int r=4;r<16;r+=4){a=max3f(a,p0[r],p0[r+1]);b=max3f(b,p0[r+2],p0[r+3]);a=max3f(a,p1[r],p1[r+1]);b=max3f(b,p1[r+2],p1[r+3]);}
  const float m=max2f(a,b);
  auto rr=__builtin_amdgcn_permlane32_swap(__float_as_uint(m),__float_as_uint(m),false,false);
  return max2f(__uint_as_float(rr[0]),__uint_as_float(rr[1]));
}
__device__ __forceinline__ void pv(f32x16*o,int vb,bf16x8 pa0,bf16x8 pa1,bf16x8 pa2,bf16x8 pa3){
  #pragma unroll
  for(int d0=0;d0<2;++d0){s16x4 lo[4],hi[4];
    #pragma unroll
    for(int ks=0;ks<4;++ks){
      asm volatile("ds_read_b64_tr_b16 %0,%1 offset:%c2":"=&v"(lo[ks]):"v"(vb),"i"(d0*4096+ks*1024):"memory");
      asm volatile("ds_read_b64_tr_b16 %0,%1 offset:%c2":"=&v"(hi[ks]):"v"(vb),"i"(d0*4096+ks*1024+512):"memory");}
    asm volatile("s_waitcnt lgkmcnt(0)":::"memory");SBAR();
    #define PK(k) (bf16x8){lo[k][0],lo[k][1],lo[k][2],lo[k][3],hi[k][0],hi[k][1],hi[k][2],hi[k][3]}
    o[d0]=__builtin_amdgcn_mfma_f32_32x32x16_bf16(pa0,PK(0),o[d0],0,0,0);
    o[d0]=__builtin_amdgcn_mfma_f32_32x32x16_bf16(pa1,PK(1),o[d0],0,0,0);
    o[d0]=__builtin_amdgcn_mfma_f32_32x32x16_bf16(pa2,PK(2),o[d0],0,0,0);
    o[d0]=__builtin_amdgcn_mfma_f32_32x32x16_bf16(pa3,PK(3),o[d0],0,0,0);
    #undef PK
  }
}

#ifndef ATTN_STORE16
#define ATTN_STORE16(p,v) (*(u32x4*)(p)=(v))
#endif
template<int THRL,bool SWA> __device__ __forceinline__ void attn_unit(int qb,const bf16*Q,const bf16*__restrict__ K,const bf16*__restrict__ V,bf16*O,float sink2,char*shm,const int wid_in){
  int lane_=(int)__builtin_amdgcn_mbcnt_hi(~0u,__builtin_amdgcn_mbcnt_lo(~0u,0u)); asm volatile("":"+v"(lane_));
  const int wid=wid_in,lane=lane_,tid=wid*64+lane,r32=lane&31,hi=lane>>5; (void)tid;
  const int q0=qb*QB; const int t_lo=SWA?((q0>=128)?(q0/KVBLK-2):0):0;
  const bf16*Qw=Q+(long)(q0+wid*QBLK)*DM;
  const bf16*Kh=K+(long)t_lo*KVBLK*DM,*Vh=V+(long)t_lo*KVBLK*DM;
  const unsigned lds0=(unsigned)(uintptr_t)shm;
  float*wsf=(float*)(shm+LDS_WS)+wid*64;
  const unsigned koff=(unsigned)(lane*DM+wid*8)*2u;
  const unsigned voff=(unsigned)((16*(wid&3)+(lane>>2))*DM+(wid>>2)*32+(lane&3)*8)*2u;
  const unsigned kdst=lds0+LDS_K+wid*1024, vdst=lds0+LDS_V+wid*1024;
  #define DMA_K(t,slot) glds16(Kh+(long)(t)*KVBLK*DM,koff,(unsigned)__builtin_amdgcn_readfirstlane(kdst+(slot)))
  #define DMA_V(t,slot) glds16(Vh+(long)(t)*KVBLK*DM,voff,(unsigned)__builtin_amdgcn_readfirstlane(vdst+(slot)))
  const int vb0=(int)(lds0+LDS_V)+((lane>>4)&1)*32+(lane&3)*8+(4*hi+((lane&15)>>2))*64;
  const char*Kbase=shm+LDS_K; bf16x8 kf[8];
  const lds_cptr shm3=(lds_cptr)shm; const lds_cptr kp0=shm3+LDS_K+hi*1024+r32*16; const lds_cptr vp0=shm3+LDS_V+((lane>>4)&1)*32+(lane&3)*8+(4*hi+((lane&15)>>2))*64;
  const int NT=(q0+QB)/KVBLK-t_lo;
  DMA_K(0,0);DMA_V(0,0);DMA_K(1,SLOTB);
  bf16x8 qr[4];
  #pragma unroll
  for(int d0=0;d0<4;++d0)qr[d0]=*reinterpret_cast<const bf16x8*>(&Qw[(long)r32*DM+d0*16+hi*8]);
  float z_=0.f; asm volatile("":"+v"(z_));
  float mhat=z_,l_reg=z_;f32x16 o[2],negm;
  _Pragma("unroll") for(int r=0;r<16;++r){o[0][r]=z_;o[1][r]=z_;negm[r]=z_;} asm volatile("":"+v"(negm));
  const int qrel=wid*QBLK+r32; const int ql=q0-t_lo*KVBLK+qrel;
  #define CMASK(P0,P1,t) do{ if(SWA){swmask(P0,P1,(t),ql,hi);} else {int jb_=(t)-(NT-4); if(jb_>=0)cmask(P0,P1,jb_,qrel,hi);} }while(0)
  bool resc=false;
  #define START(P0,P1) do{ const float rm=rowmax(P0,P1); resc=false; \
    { const float dl=SWA?max2f(rm,sink2):rm; if(SWA){l_reg=(hi==0)?__builtin_amdgcn_exp2f(sink2-dl):0.f;} mhat=fadd_s(mhat,dl); \
      _Pragma("unroll") for(int r=0;r<16;++r){P0[r]=fsub_s(P0[r],dl);P1[r]=fsub_s(P1[r],dl);} \
      _Pragma("unroll") for(int r=0;r<16;++r)negm[r]=-mhat; asm volatile("":"+v"(negm)); } \
    _Pragma("unroll") for(int r=0;r<16;++r)P0[r]=__builtin_amdgcn_exp2f(P0[r]); }while(0)
  #define RESC() do{ if(resc){ asm volatile("s_waitcnt lgkmcnt(0)":::"memory"); \
      _Pragma("unroll") for(int d_=0;d_<2;++d_) _Pragma("unroll") for(int r=0;r<16;++r)o[d_][r]*=wsf[crow(r,hi)]; } }while(0)
  f32x16 pA0,pA1,pB0,pB1;
  int sl_prev=0,sl_cur=0,sl_next=SLOTB;
  #define ROT() do{sl_prev=sl_cur;sl_cur=sl_next;sl_next=(sl_next==(NSLOT-1)*SLOTB)?0:sl_next+SLOTB;}while(0)
  DMA_K(2,2*SLOTB);
  WAIT_BAR(3);
  qkt(pA0,pA1,Kbase,qr,negm,r32,hi);asm volatile("s_nop 15\n\ts_nop 7":"+v"(pA0),"+v"(pA1));CMASK(pA0,pA1,0);
  START(pA0,pA1);
  _Pragma("unroll") for(int r=0;r<16;++r)pA1[r]=__builtin_amdgcn_exp2f(pA1[r]);
  WAIT_BAR(0);
  DMA_K(3,0);DMA_V(1,SLOTB);
  ROT();
  kload8(kf,kp0+sl_cur);
  WAIT_BAR(2);
  s16x4 vlo[8],vhi[8]; u32x4 pw0,pw1,pw2,pw3;
  #define PKW(P,B) cvtpk_s(P[B],P[B+1])
  #define PAF(k) __builtin_bit_cast(bf16x8,pw##k)
  #define VFR(i) (bf16x8){vlo[i][0],vlo[i][1],vlo[i][2],vlo[i][3],vhi[i][0],vhi[i][1],vhi[i][2],vhi[i][3]}
  #define PIN(x) asm volatile("":"+v"(x))
  #define MX3(a,b,c) __builtin_fmaxf(__builtin_fmaxf((a),(b)),(c))
  #define GAPA(MF,A0,A1,A2,A3,W0,W1,PW) do{ MF; sacc+=A0; sacc+=A1; sacc+=A2; sacc+=A3; PIN(sacc); W0; W1; PIN(PW); SBAR(); }while(0)
  #define EX(v) __builtin_amdgcn_exp2f(v)
  #define GAPB(MF,X,B) do{ MF; X[B]=EX(X[B]); X[B+1]=EX(X[B+1]); X[B+2]=EX(X[B+2]); X[B+3]=EX(X[B+3]); PIN(X); SBAR(); }while(0)
  #define VRD(i) do{ vlo[i]=vtr(vp_+(((i)>>2)*4096+((i)&3)*1024)); vhi[i]=vtr(vp_+(((i)>>2)*4096+((i)&3)*1024+512)); }while(0)
  #define KRD(G,j) do{ if(G){ kload2(kf,kp0+sl_next,j); SBAR(); } }while(0)
  #define STEP(C0,C1,P0,P1,t,GK,GV,GL) do{ SBAR(); \
    const lds_cptr vp_=vp0+sl_prev; \
    VRD(0); SBAR(); float sacc=(P0[0]+P0[1]); \
    GAPA(C0=__builtin_amdgcn_mfma_f32_32x32x16_bf16(kf[0],qr[0],negm,0,0,0), P0[2],P0[3],P0[4],P0[5],     pw0[0]=PKW(P0,0), pw0[1]=PKW(P0,2), pw0); \
    VRD(4); SBAR(); GAPA(C1=__builtin_amdgcn_mfma_f32_32x32x16_bf16(kf[1],qr[0],negm,0,0,0), P0[6],P0[7],P0[8],P0[9],     pw0[2]=PKW(P0,4), pw0[3]=PKW(P0,6), pw0); \
    VRD(1); SBAR(); GAPA(C0=__builtin_amdgcn_mfma_f32_32x32x16_bf16(kf[2],qr[1],C0,0,0,0),   P0[10],P0[11],P0[12],P0[13], pw1[0]=PKW(P0,8), pw1[1]=PKW(P0,10), pw1); \
    VRD(5); SBAR(); GAPA(C1=__builtin_amdgcn_mfma_f32_32x32x16_bf16(kf[3],qr[1],C1,0,0,0),   P0[14],P0[15],P1[0],P1[1],   pw1[2]=PKW(P0,12),pw1[3]=PKW(P0,14), pw1); \
    VRD(2); SBAR(); GAPA(C0=__builtin_amdgcn_mfma_f32_32x32x16_bf16(kf[4],qr[2],C0,0,0,0),   P1[2],P1[3],P1[4],P1[5],     pw2[0]=PKW(P1,0), pw2[1]=PKW(P1,2), pw2); \
    VRD(6); SBAR(); GAPA(C1=__builtin_amdgcn_mfma_f32_32x32x16_bf16(kf[5],qr[2],C1,0,0,0),   P1[6],P1[7],P1[8],P1[9],     pw2[2]=PKW(P1,4), pw2[3]=PKW(P1,6), pw2); \
    VRD(3); SBAR(); GAPA(C0=__builtin_amdgcn_mfma_f32_32x32x16_bf16(kf[6],qr[3],C0,0,0,0),   P1[10],P1[11],P1[12],P1[13], pw3[0]=PKW(P1,8), pw3[1]=PKW(P1,10), pw3); \
    VRD(7); SBAR(); GAPA(C1=__builtin_amdgcn_mfma_f32_32x32x16_bf16(kf[7],qr[3],C1,0,0,0),   P1[14],P1[15],0.f,0.f,       pw3[2]=PKW(P1,12),pw3[3]=PKW(P1,14), pw3); \
    l_reg+=sacc; \
    if(GK){DMA_K((t)+3,sl_cur);} if(GV){DMA_V((t)+1,sl_next);} \
    CMASK(C0,C1,t); \
    { float a=MX3(C0[0],C0[1],C1[0]),b=MX3(C0[2],C0[3],C1[1]); a=MX3(a,C1[2],C1[3]); \
      _Pragma("unroll") for(int r=4;r<16;r+=4){a=MX3(a,C0[r],C0[r+1]);b=MX3(b,C0[r+2],C0[r+3]);a=MX3(a,C1[r],C1[r+1]);b=MX3(b,C1[r+2],C1[r+3]);} \
      float rm=__builtin_fmaxf(a,b); { auto rr=__builtin_amdgcn_permlane32_swap(__float_as_uint(rm),__float_as_uint(rm),false,false); rm=__builtin_fmaxf(__uint_as_float(rr[0]),__uint_as_float(rr[1])); } \
      resc=false; \
      if(__builtin_expect(__any(rm>(float)THRL),0)){ const float dl=__builtin_fmaxf(rm,0.f); mhat+=dl; \
        _Pragma("unroll") for(int r=0;r<16;++r){C0[r]-=dl;C1[r]-=dl;} \
        _Pragma("unroll") for(int r=0;r<16;++r)negm[r]=-mhat; asm volatile("":"+v"(negm)); \
        const float f=__builtin_amdgcn_exp2f(-dl); l_reg*=f; if(hi==0)wsf[r32]=f; resc=true; } } \
    SBAR(); \
    GAPB(o[0]=__builtin_amdgcn_mfma_f32_32x32x16_bf16(PAF(0),VFR(0),o[0],0,0,0), C0,0); \
    GAPB(o[1]=__builtin_amdgcn_mfma_f32_32x32x16_bf16(PAF(0),VFR(4),o[1],0,0,0), C0,4); \
    KRD(GL,0); GAPB(o[0]=__builtin_amdgcn_mfma_f32_32x32x16_bf16(PAF(1),VFR(1),o[0],0,0,0), C0,8); \
    KRD(GL,1); GAPB(o[1]=__builtin_amdgcn_mfma_f32_32x32x16_bf16(PAF(1),VFR(5),o[1],0,0,0), C0,12); \
    KRD(GL,2); GAPB(o[0]=__builtin_amdgcn_mfma_f32_32x32x16_bf16(PAF(2),VFR(2),o[0],0,0,0), C1,0); \
    KRD(GL,3); GAPB(o[1]=__builtin_amdgcn_mfma_f32_32x32x16_bf16(PAF(2),VFR(6),o[1],0,0,0), C1,4); \
    GAPB(o[0]=__builtin_amdgcn_mfma_f32_32x32x16_bf16(PAF(3),VFR(3),o[0],0,0,0), C1,8); \
    GAPB(o[1]=__builtin_amdgcn_mfma_f32_32x32x16_bf16(PAF(3),VFR(7),o[1],0,0,0), C1,12); \
    }while(0)
  int t=1;
  #undef CMASK
  #define CMASK(P0,P1,t) do{}while(0)
  for(;t+5<NT;t+=2){
    STEP(pB0,pB1,pA0,pA1,t,true,true,true);     WAIT_BAR(2); RESC(); ROT();
    STEP(pA0,pA1,pB0,pB1,t+1,true,true,true);   WAIT_BAR(2); RESC(); ROT();
  }
  #undef CMASK
  #define CMASK(P0,P1,t) do{ if(SWA){swmask(P0,P1,(t),ql,hi);} else {int jb_=(t)-(NT-4); if(jb_>=0)cmask(P0,P1,jb_,qrel,hi);} }while(0)
  #define ENDW(tt) do{ if((tt)+3<NT){WAIT_BAR(2);} else if((tt)+2<NT){WAIT_BAR(1);} else {WAIT_BAR(0);} }while(0)
  for(;t+1<NT;t+=2){
    STEP(pB0,pB1,pA0,pA1,t,(t+3<NT),(t+1<NT),(t+1<NT));       ENDW(t);   RESC(); ROT();
    STEP(pA0,pA1,pB0,pB1,t+1,(t+4<NT),(t+2<NT),(t+2<NT));     ENDW(t+1); RESC(); ROT();
  }
  STEP(pB0,pB1,pA0,pA1,NT-1,false,false,false); RESC();
  { float sacc=pB0[0]+pB0[1]; _Pragma("unroll") for(int r=2;r<16;++r)sacc+=pB0[r]; _Pragma("unroll") for(int r=0;r<16;++r)sacc+=pB1[r]; l_reg+=sacc;
    pw0=(u32x4){PKW(pB0,0),PKW(pB0,2),PKW(pB0,4),PKW(pB0,6)};pw1=(u32x4){PKW(pB0,8),PKW(pB0,10),PKW(pB0,12),PKW(pB0,14)};pw2=(u32x4){PKW(pB1,0),PKW(pB1,2),PKW(pB1,4),PKW(pB1,6)};pw3=(u32x4){PKW(pB1,8),PKW(pB1,10),PKW(pB1,12),PKW(pB1,14)};
    SBAR(); pv(o,vb0+sl_cur,PAF(0),PAF(1),PAF(2),PAF(3)); }
  #undef PKW
  #undef PAF
  #undef VFR
  #undef PIN
  #undef MX3
  #undef GAPA
  #undef GAPB
  #undef EX
  #undef VRD
  #undef KRD
  #undef STEP
  #undef ENDW
  {auto rr=__builtin_amdgcn_permlane32_swap(__float_as_uint(l_reg),__float_as_uint(l_reg),false,false);l_reg=__uint_as_float(rr[0])+__uint_as_float(rr[1]);}
  if(hi==0)wsf[32+r32]=l_reg;asm volatile("s_waitcnt lgkmcnt(0)":::"memory");
  float rli[16];
  #pragma unroll
  for(int r=0;r<16;++r)rli[r]=__builtin_amdgcn_rcpf(wsf[32+crow(r,hi)]);
  bf16*Ow=O+(long)(q0+wid*QBLK)*DMO;
  { bf16*stg=(bf16*)(shm+LDS_OST)+wid*2048;
    #pragma unroll
    for(int r=0;r<16;++r){const int orow=crow(r,hi);
      #pragma unroll
      for(int d0=0;d0<2;++d0)stg[orow*64+d0*32+r32]=__float2bfloat16(o[d0][r]*rli[r]);}
    asm volatile("s_waitcnt lgkmcnt(0)":::"memory");
    #pragma unroll
    for(int i=0;i<4;++i){const int row=i*8+(lane>>3),ch=lane&7; const u32x4 v=*(const u32x4*)(stg+row*64+ch*8); ATTN_STORE16(Ow+(long)row*DMO+ch*8,v);} }
  asm volatile("s_waitcnt lgkmcnt(0)\n\ts_barrier":::"memory");
  #undef DMA_K
  #undef DMA_V
  #undef CMASK
  #undef START
  #undef RESC
  #undef ROT
}
constexpr int ATTN_LDS_BYTES=LDS_BYTES;

constexpr int V2_SLOTB=16384, L2_K=0, L2_V=NSLOT*SLOTB, L2_WS=L2_V+NSLOT*V2_SLOTB, L2_OST=L2_WS+NW*64*4, ATTN128_LDS_BYTES=L2_OST+NW*8192;
template<int THRL> __device__ __forceinline__ void attn_unit128(int qb,const bf16*Q,const bf16*__restrict__ K,const bf16*__restrict__ V,bf16*O,char*shm,const int wid_in){
  int lane_=(int)__builtin_amdgcn_mbcnt_hi(~0u,__builtin_amdgcn_mbcnt_lo(~0u,0u)); asm volatile("":"+v"(lane_));
  int wid_=wid_in; asm volatile("":"+s"(wid_));
  const int wid=wid_,lane=lane_,r32=lane&31,hi=lane>>5;
  const int q0=qb*QB;
  const bf16*Qw=Q+(long)(q0+wid*QBLK)*DM;
  unsigned lds0_=(unsigned)(uintptr_t)shm; asm volatile("":"+s"(lds0_)); const unsigned lds0=lds0_;
  float*wsf=(float*)(shm+L2_WS)+wid*64;
  const unsigned koff=(unsigned)(lane*DM+wid*8)*2u;
  const unsigned voff=(unsigned)((16*(wid&3)+(lane>>2))*DM+(wid>>2)*32+(lane&3)*8)*2u;
  const unsigned kdst=lds0+L2_K+wid*1024, vdst=lds0+L2_V+wid*1024;
  #define DMA_K(t,slot) glds16(K+(long)(t)*KVBLK*DM,koff,(unsigned)__builtin_amdgcn_readfirstlane(kdst+(slot)))
  #define DMA_V(t,slot) do{ glds16(V+(long)(t)*KVBLK*DM,voff,(unsigned)__builtin_amdgcn_readfirstlane(vdst+2*(slot))); glds16(V+(long)(t)*KVBLK*DM+64,voff,(unsigned)__builtin_amdgcn_readfirstlane(vdst+2*(slot)+8192)); }while(0)
  const int vb0=(int)(lds0+L2_V)+((lane>>4)&1)*32+(lane&3)*8+(4*hi+((lane&15)>>2))*64;
  const char*Kbase=shm+L2_K; bf16x8 kf[8];
  const lds_cptr shm3=(lds_cptr)shm; const lds_cptr kp0=shm3+L2_K+hi*1024+r32*16; const lds_cptr vp0=shm3+L2_V+((lane>>4)&1)*32+(lane&3)*8+(4*hi+((lane&15)>>2))*64;
  const int NT=(q0+QB)/KVBLK;
  DMA_K(0,0);DMA_V(0,0);DMA_K(1,SLOTB);
  bf16x8 qr[4];
  #pragma unroll
  for(int d0=0;d0<4;++d0)qr[d0]=*reinterpret_cast<const bf16x8*>(&Qw[(long)r32*DM+d0*16+hi*8]);
  float z_=0.f; asm volatile("":"+v"(z_));
  float mhat=z_,l_reg=z_;f32x16 o[4];
  _Pragma("unroll") for(int r=0;r<16;++r){o[0][r]=z_;o[1][r]=z_;o[2][r]=z_;o[3][r]=z_;}
  const int qrel=wid*QBLK+r32;
  #define CMASK(P0,P1,t) do{ int jb_=(t)-(NT-4); if(jb_>=0)cmask(P0,P1,jb_,qrel,hi); }while(0)
  bool resc=false;
  #define RESC() do{ if(resc){ asm volatile("s_waitcnt lgkmcnt(0)":::"memory"); \
      _Pragma("unroll") for(int d_=0;d_<4;++d_) _Pragma("unroll") for(int r=0;r<16;++r)o[d_][r]*=wsf[crow(r,hi)]; } }while(0)
  f32x16 pA0,pA1,pB0,pB1;
  int sl_prev=0,sl_cur=0,sl_next=SLOTB;
  #define ROT() do{sl_prev=sl_cur;sl_cur=sl_next;sl_next=(sl_next==(NSLOT-1)*SLOTB)?0:sl_next+SLOTB;}while(0)
  DMA_K(2,2*SLOTB);
  WAIT_BAR(3);
  { const f32x16 zz={};
    const char*kb=Kbase+hi*1024+r32*16;
    #pragma unroll
    for(int d0=0;d0<4;++d0){
      const bf16x8 b0=*reinterpret_cast<const bf16x8*>(kb+d0*2048);
      const bf16x8 b1=*reinterpret_cast<const bf16x8*>(kb+d0*2048+512);
      if(d0==0){pA0=__builtin_amdgcn_mfma_f32_32x32x16_bf16(b0,qr[0],zz,0,0,0);pA1=__builtin_amdgcn_mfma_f32_32x32x16_bf16(b1,qr[0],zz,0,0,0);}
      else{pA0=__builtin_amdgcn_mfma_f32_32x32x16_bf16(b0,qr[d0],pA0,0,0,0);pA1=__builtin_amdgcn_mfma_f32_32x32x16_bf16(b1,qr[d0],pA1,0,0,0);}} }
  asm volatile("s_nop 15\n\ts_nop 7":"+v"(pA0),"+v"(pA1));CMASK(pA0,pA1,0);
  { const float rm=rowmax(pA0,pA1); mhat=fadd_s(mhat,rm);
    _Pragma("unroll") for(int r=0;r<16;++r){pA0[r]=__builtin_amdgcn_exp2f(fsub_s(pA0[r],mhat));pA1[r]=__builtin_amdgcn_exp2f(fsub_s(pA1[r],mhat));} }
  WAIT_BAR(0);
  DMA_K(3,0);DMA_V(1,SLOTB);
  ROT();
  kload8(kf,kp0+sl_cur);
  WAIT_BAR(3);
  s16x4 vl0,vh0,vl1,vh1,vl2,vh2,vl3,vh3; u32x4 pw0,pw1,pw2,pw3;
  #define PKW(P,B) cvtpk_s(P[B],P[B+1])
  #define PAF(k) __builtin_bit_cast(bf16x8,pw##k)
  #define VFRB(b) (bf16x8){vl##b[0],vl##b[1],vl##b[2],vl##b[3],vh##b[0],vh##b[1],vh##b[2],vh##b[3]}
  #define PIN(x) asm volatile("":"+v"(x))
  #define MX3(a,b,c) __builtin_fmaxf(__builtin_fmaxf((a),(b)),(c))
  #define GAPA(MF,A0,A1,A2,A3,W0,W1,PW) do{ MF; sacc+=A0; sacc+=A1; sacc+=A2; sacc+=A3; PIN(sacc); W0; W1; PIN(PW); SBAR(); }while(0)
  #define EX(v) __builtin_amdgcn_exp2f((v)-mhat)
  #define GAPB2(MF,X,B) do{ MF; X[B]=EX(X[B]); X[B+1]=EX(X[B+1]); PIN(X); SBAR(); }while(0)
  #define VRDB(b,n) do{ vl##b=vtr(vp_+((((n)&3))*4096+((n)>>2)*1024)); vh##b=vtr(vp_+((((n)&3))*4096+((n)>>2)*1024+512)); SBAR(); }while(0)
  #define KRD(G,j) do{ if(G){ kload2(kf,kp0+sl_next,j); SBAR(); } }while(0)
  #define ZZ (f32x16){0.f,0.f,0.f,0.f,0.f,0.f,0.f,0.f,0.f,0.f,0.f,0.f,0.f,0.f,0.f,0.f}
  #define PVB(n,b,k,d,X,B) do{ GAPB2(o[d]=__builtin_amdgcn_mfma_f32_32x32x16_bf16(PAF(k),VFRB(b),o[d],0,0,0), X,B); if((n)+4<16){ VRDB(b,(n)+4); } }while(0)
  #define STEP(C0,C1,P0,P1,t,GK,GV,GL) do{ SBAR(); \
    const lds_cptr vp_=vp0+2*sl_prev; \
    float sacc=(P0[0]+P0[1]); \
    GAPA(C0=__builtin_amdgcn_mfma_f32_32x32x16_bf16(kf[0],qr[0],ZZ,0,0,0), P0[2],P0[3],P0[4],P0[5],     pw0[0]=PKW(P0,0), pw0[1]=PKW(P0,2), pw0); \
    GAPA(C1=__builtin_amdgcn_mfma_f32_32x32x16_bf16(kf[1],qr[0],ZZ,0,0,0), P0[6],P0[7],P0[8],P0[9],     pw0[2]=PKW(P0,4), pw0[3]=PKW(P0,6), pw0); \
    GAPA(C0=__builtin_amdgcn_mfma_f32_32x32x16_bf16(kf[2],qr[1],C0,0,0,0),   P0[10],P0[11],P0[12],P0[13], pw1[0]=PKW(P0,8), pw1[1]=PKW(P0,10), pw1); \
    GAPA(C1=__builtin_amdgcn_mfma_f32_32x32x16_bf16(kf[3],qr[1],C1,0,0,0),   P0[14],P0[15],P1[0],P1[1],   pw1[2]=PKW(P0,12),pw1[3]=PKW(P0,14), pw1); \
    VRDB(0,0); GAPA(C0=__builtin_amdgcn_mfma_f32_32x32x16_bf16(kf[4],qr[2],C0,0,0,0),   P1[2],P1[3],P1[4],P1[5],     pw2[0]=PKW(P1,0), pw2[1]=PKW(P1,2), pw2); \
    VRDB(1,1); GAPA(C1=__builtin_amdgcn_mfma_f32_32x32x16_bf16(kf[5],qr[2],C1,0,0,0),   P1[6],P1[7],P1[8],P1[9],     pw2[2]=PKW(P1,4), pw2[3]=PKW(P1,6), pw2); \
    VRDB(2,2); GAPA(C0=__builtin_amdgcn_mfma_f32_32x32x16_bf16(kf[6],qr[3],C0,0,0,0),   P1[10],P1[11],P1[12],P1[13], pw3[0]=PKW(P1,8), pw3[1]=PKW(P1,10), pw3); \
    VRDB(3,3); GAPA(C1=__builtin_amdgcn_mfma_f32_32x32x16_bf16(kf[7],qr[3],C1,0,0,0),   P1[14],P1[15],0.f,0.f,       pw3[2]=PKW(P1,12),pw3[3]=PKW(P1,14), pw3); \
    l_reg+=sacc; \
    if(GK){DMA_K((t)+3,sl_cur);} if(GV){DMA_V((t)+1,sl_next);} \
    CMASK(C0,C1,t); \
    { float a=MX3(C0[0],C0[1],C1[0]),b=MX3(C0[2],C0[3],C1[1]); a=MX3(a,C1[2],C1[3]); \
      _Pragma("unroll") for(int r=4;r<16;r+=4){a=MX3(a,C0[r],C0[r+1]);b=MX3(b,C0[r+2],C0[r+3]);a=MX3(a,C1[r],C1[r+1]);b=MX3(b,C1[r+2],C1[r+3]);} \
      float rm=__builtin_fmaxf(a,b); { auto rr=__builtin_amdgcn_permlane32_swap(__float_as_uint(rm),__float_as_uint(rm),false,false); rm=__builtin_fmaxf(__uint_as_float(rr[0]),__uint_as_float(rr[1])); } \
      rm-=mhat; resc=false; \
      if(__builtin_expect(__any(rm>(float)THRL),0)){ const float dl=__builtin_fmaxf(rm,0.f); mhat+=dl; \
        const float f=__builtin_amdgcn_exp2f(-dl); l_reg*=f; if(hi==0)wsf[r32]=f; resc=true; } } \
    SBAR(); \
    PVB(0,0,0,0,C0,0);   PVB(1,1,0,1,C0,2);   PVB(2,2,0,2,C0,4);   PVB(3,3,0,3,C0,6); \
    KRD(GL,0); PVB(4,0,1,0,C0,8);   PVB(5,1,1,1,C0,10); \
    KRD(GL,1); PVB(6,2,1,2,C0,12);  PVB(7,3,1,3,C0,14); \
    KRD(GL,2); PVB(8,0,2,0,C1,0);   PVB(9,1,2,1,C1,2); \
    KRD(GL,3); PVB(10,2,2,2,C1,4);  PVB(11,3,2,3,C1,6); \
    PVB(12,0,3,0,C1,8);  PVB(13,1,3,1,C1,10); PVB(14,2,3,2,C1,12); PVB(15,3,3,3,C1,14); \
    }while(0)
  int t=1;
  #undef CMASK
  #define CMASK(P0,P1,t) do{}while(0)
  for(;t+5<NT;t+=2){
    STEP(pB0,pB1,pA0,pA1,t,true,true,true);     WAIT_BAR(3); RESC(); ROT();
    STEP(pA0,pA1,pB0,pB1,t+1,true,true,true);   WAIT_BAR(3); RESC(); ROT();
  }
  #undef CMASK
  #define CMASK(P0,P1,t) do{ int jb_=(t)-(NT-4); if(jb_>=0)cmask(P0,P1,jb_,qrel,hi); }while(0)
  #define ENDW(tt) do{ if((tt)+3<NT){WAIT_BAR(3);} else if((tt)+2<NT){WAIT_BAR(2);} else {WAIT_BAR(0);} }while(0)
  for(;t+1<NT;t+=2){
    STEP(pB0,pB1,pA0,pA1,t,(t+3<NT),(t+1<NT),(t+1<NT));       ENDW(t);   RESC(); ROT();
    STEP(pA0,pA1,pB0,pB1,t+1,(t+4<NT),(t+2<NT),(t+2<NT));     ENDW(t+1); RESC(); ROT();
  }
  STEP(pB0,pB1,pA0,pA1,NT-1,false,false,false); RESC();
  { float sacc=pB0[0]+pB0[1]; _Pragma("unroll") for(int r=2;r<16;++r)sacc+=pB0[r]; _Pragma("unroll") for(int r=0;r<16;++r)sacc+=pB1[r]; l_reg+=sacc;
    pw0=(u32x4){PKW(pB0,0),PKW(pB0,2),PKW(pB0,4),PKW(pB0,6)};pw1=(u32x4){PKW(pB0,8),PKW(pB0,10),PKW(pB0,12),PKW(pB0,14)};pw2=(u32x4){PKW(pB1,0),PKW(pB1,2),PKW(pB1,4),PKW(pB1,6)};pw3=(u32x4){PKW(pB1,8),PKW(pB1,10),PKW(pB1,12),PKW(pB1,14)};
    SBAR(); pv(o,vb0+2*sl_cur,PAF(0),PAF(1),PAF(2),PAF(3)); pv(o+2,vb0+2*sl_cur+8192,PAF(0),PAF(1),PAF(2),PAF(3)); }
  #undef PKW
  #undef PAF
  #undef VFRB
  #undef PIN
  #undef MX3
  #undef GAPA
  #undef GAPB2
  #undef EX
  #undef VRDB
  #undef PVB
  #undef KRD
  #undef ZZ
  #undef STEP
  #undef ENDW
  {auto rr=__builtin_amdgcn_permlane32_swap(__float_as_uint(l_reg),__float_as_uint(l_reg),false,false);l_reg=__uint_as_float(rr[0])+__uint_as_float(rr[1]);}
  if(hi==0)wsf[32+r32]=l_reg;asm volatile("s_waitcnt lgkmcnt(0)":::"memory");
  float rli[16];
  #pragma unroll
  for(int r=0;r<16;++r)rli[r]=__builtin_amdgcn_rcpf(wsf[32+crow(r,hi)]);
  bf16*Ow=O+(long)(q0+wid*QBLK)*DMO;
  { bf16*stg=(bf16*)(shm+L2_OST)+wid*4096;
    #pragma unroll
    for(int r=0;r<16;++r){const int orow=crow(r,hi);
      #pragma unroll
      for(int d0=0;d0<4;++d0)stg[orow*128+d0*32+r32]=__float2bfloat16(o[d0][r]*rli[r]);}
    asm volatile("s_waitcnt lgkmcnt(0)":::"memory");
    #pragma unroll
    for(int i=0;i<8;++i){const int row=i*4+(lane>>4),ch=lane&15; const u32x4 v=*(const u32x4*)(stg+row*128+ch*8); ATTN_STORE16(Ow+(long)row*DMO+ch*8,v);} }
  asm volatile("s_waitcnt lgkmcnt(0)\n\ts_barrier":::"memory");
  #undef DMA_K
  #undef DMA_V
  #undef CMASK
  #undef RESC
  #undef ROT
}
#undef SBAR
#undef WAIT_BAR
}
#define GAS __attribute__((address_space(1)))
#define LAS __attribute__((address_space(3)))
typedef unsigned short bf16;
typedef unsigned v4u __attribute__((ext_vector_type(4)));
typedef float f32x4 __attribute__((ext_vector_type(4)));
typedef short bf16x8 __attribute__((ext_vector_type(8)));
typedef GAS unsigned gu32;
typedef GAS unsigned long long gu64;
#define RLX_AGENT __ATOMIC_RELAXED, __HIP_MEMORY_SCOPE_AGENT
#define LDS_WAIT() asm volatile("s_waitcnt lgkmcnt(0)" ::: "memory")
#define VM_WAIT() asm volatile("s_waitcnt vmcnt(0)" ::: "memory")
__device__ __forceinline__ unsigned long long rt() { return __builtin_amdgcn_s_memrealtime(); }
__device__ __forceinline__ unsigned f2bf(float f) { unsigned u = __builtin_bit_cast(unsigned, f); return (u + 0x7fffu + ((u >> 16) & 1u)) >> 16; }
__device__ __forceinline__ unsigned pk2(float lo, float hi) { return f2bf(lo) | (f2bf(hi) << 16); }

#define XB_TMO      128
#define XB_XCNT(j)  (256  + 64 * (j))
#define XB_XSUB(j)  (1280 + 64 * (j))
#define XB_XGEN(j)  (2304 + 64 * (j))
#define XB_TOP      3328
#define XB_TOPGEN   3392
#define XCD_BAR_WORDS 3456
#define XB_SPIN_CAP (1u << 18)

__device__ __forceinline__ unsigned xb_ld(unsigned* p)              { return __hip_atomic_load(p, __ATOMIC_RELAXED, __HIP_MEMORY_SCOPE_AGENT); }
__device__ __forceinline__ unsigned xb_add(unsigned* p, unsigned v) { return __hip_atomic_fetch_add(p, v, __ATOMIC_RELAXED, __HIP_MEMORY_SCOPE_AGENT); }
__device__ __forceinline__ unsigned xb_xcc_id() { return (unsigned)__builtin_amdgcn_s_getreg((3 << 11) | 20) & 0xFu; }
#define XB_SPIN(cond, bar) do { unsigned _sp = 0; while (cond) { __builtin_amdgcn_s_sleep(1); \
    if ((++_sp & 255u) == 0u) { if (xb_ld(&(bar)[XB_TMO])) break; if (_sp > XB_SPIN_CAP) { atomicAdd(&(bar)[XB_TMO], 1u); break; } } } } while (0)

struct XcdBarrier {
    unsigned* bar; unsigned x;
    volatile LAS unsigned* st;
};

__device__ __forceinline__ XcdBarrier xcd_barrier_post(unsigned* bar, volatile LAS unsigned* st) {
    XcdBarrier b; b.bar = bar; b.x = xb_xcc_id(); b.st = st;
    if (threadIdx.x == 0) (void)xb_add(&bar[XB_XCNT(b.x)], 1u);
    return b;
}
__device__ __forceinline__ void xcd_barrier_complete(unsigned* bar, unsigned x, unsigned& nloc, unsigned& nx) {
    const unsigned G = gridDim.x * gridDim.y * gridDim.z;
    unsigned sum, cnt, mine, sp = 0u;
    for (;;) {
        sum = 0u; cnt = 0u; mine = 0u;
#pragma unroll
        for (unsigned j = 0; j < 16; ++j) { const unsigned c = xb_ld(&bar[XB_XCNT(j)]); sum += c; cnt += (c > 0u) ? 1u : 0u; mine = (j == x) ? c : mine; }
        if (sum == G) break;
        __builtin_amdgcn_s_sleep(1);
        if ((++sp & 255u) == 0u) { if (xb_ld(&bar[XB_TMO])) break; if (sp > XB_SPIN_CAP) { atomicAdd(&bar[XB_TMO], 1u); break; } }
    }
    nloc = mine > 0u ? mine : 1u; nx = cnt > 0u ? cnt : 1u;
}

__device__ __forceinline__ void xcd_barrier(const XcdBarrier& b) {
    asm volatile("s_waitcnt vmcnt(0)" ::: "memory");
    __syncthreads();
    if (threadIdx.x == 0) {
        unsigned* bar = b.bar;
        __builtin_amdgcn_s_waitcnt(0);
        unsigned nloc = b.st[0], nx = b.st[1];
        if (nloc == 0u) { xcd_barrier_complete(bar, b.x, nloc, nx); b.st[0] = nloc; b.st[1] = nx; }
        const unsigned old = xb_add(&bar[XB_XSUB(b.x)], 1u);
        const unsigned gen = old / nloc;
        if (old + 1u == (gen + 1u) * nloc) {
            __builtin_amdgcn_fence(__ATOMIC_RELEASE, "agent");
            asm volatile("s_waitcnt vmcnt(0)" ::: "memory");
            const unsigned og = xb_add(&bar[XB_TOP], 1u);
            const unsigned tg = og / nx;
            if (og + 1u == (tg + 1u) * nx) xb_add(&bar[XB_TOPGEN], 1u);
            else XB_SPIN(xb_ld(&bar[XB_TOPGEN]) == tg, bar);
            __builtin_amdgcn_fence(__ATOMIC_ACQUIRE, "agent");
            xb_add(&bar[XB_XGEN(b.x)], 1u);
            asm volatile("s_waitcnt vmcnt(0)" ::: "memory");
        } else {
            XB_SPIN(xb_ld(&bar[XB_XGEN(b.x)]) == gen, bar);
            __builtin_amdgcn_fence(__ATOMIC_ACQUIRE, "agent");
            asm volatile("s_waitcnt vmcnt(0)" ::: "memory");
        }
    }
    __syncthreads();
}
constexpr int NWAVES = 8;
constexpr int BATCH = 2, SEQ = 8192, D = 1024, T = BATCH * SEQ, NPROJ = 2304, DFF = 2816, DFE = 3584, NE = 8;
constexpr int NPAD = 2 * T + NE * 256;
constexpr int MAXCH = NPAD / 256;
constexpr float RMS_EPS = 1e-6f, LN_EPS = 1e-5f;
constexpr int NFC = 128, TAIL_KS = 7, TAIL_KSLICE = 512, TAIL_ROWS = 2048;
constexpr int NPH = 17;
constexpr float LOG2E = 1.4426950408889634f;

constexpr size_t MiB = 1u << 20;
constexpr size_t WS_CTL = 0, CTL_ZERO_BYTES = 1 * MiB;
constexpr size_t WS_RT = 1 * MiB;
constexpr size_t RT_SSQ = 1 * MiB;
constexpr size_t RT_SELE = 0, RT_SELL = 128 * 1024, RT_SELW = 256 * 1024, RT_TOKD = 384 * 1024, RT_CNTB = 512 * 1024, RT_CHE = 528 * 1024, RT_NCH = 532 * 1024, RT_CB = 533 * 1024;
constexpr size_t WS_WB = 4 * MiB;
constexpr size_t WB_IN = 0, WB_OUT = WB_IN + (size_t)NPROJ * D, WB_W13 = WB_OUT + (size_t)D * D, WB_W2 = WB_W13 + (size_t)2 * DFF * D, WB_PW1 = WB_W2 + (size_t)D * DFF,
                 WB_PW2 = WB_PW1 + (size_t)2 * D * D, WB_E13 = WB_PW2 + (size_t)D * D, WB_E2 = WB_E13 + (size_t)NE * 2 * DFE * D, WB_END = WB_E2 + (size_t)NE * D * DFE;
static_assert(WB_END * 2 <= 198 * MiB, "weight region");
constexpr size_t WS_X = 202 * MiB;
constexpr size_t WS_XB = 266 * MiB;
constexpr size_t WS_R1 = 298 * MiB;
constexpr size_t R1_PROJ = 0, R1_O16 = 72 * MiB, R1_MIX = 104 * MiB, R1_HB = 0, R1_U = 0, R1_V = 32 * MiB, R1_HN = 0, R1_HMOE = 0;
constexpr size_t WS_R2 = 536 * MiB;
constexpr size_t WS_FAST_END = 604 * MiB;
static_assert((size_t)NPAD * DFE * 2 <= 238 * MiB && (size_t)NPAD * D * 2 <= 68 * MiB, "big regions");
constexpr int CW_BAR = 4096;
constexpr int RING_BYTES = 143360, LDSCTL_OFF = RING_BYTES, MISC_OFF = LDSCTL_OFF + 320, LDS_BYTES = 147456;
static_assert(attn_body::ATTN128_LDS_BYTES <= RING_BYTES && attn_body::ATTN_LDS_BYTES <= RING_BYTES && MISC_OFF + 128 <= LDS_BYTES, "LDS map");

#ifndef FFN_F8_MASK
#define FFN_F8_MASK 2
#endif
#define FFN_F8(pair) (((FFN_F8_MASK) >> (pair)) & 1)
#ifndef CONV_F8_MASK
#define CONV_F8_MASK 2
#endif
#define CONV_F8(pair) (((CONV_F8_MASK) >> (pair)) & 1)
#ifndef PROJ_F8_MASK
#define PROJ_F8_MASK 2
#endif
#define PROJ_F8(pair) (((PROJ_F8_MASK) >> (pair)) & 1)
#ifndef OUT_F8_MASK
#define OUT_F8_MASK 2
#endif
#define OUT_F8(pair) (((OUT_F8_MASK) >> (pair)) & 1)
constexpr size_t R1_MIX8 = 136 * MiB;
static_assert(((PROJ_F8_MASK) & 1) == 0, "PROJ_F8_MASK bit 0");
typedef float f32x2 __attribute__((ext_vector_type(2)));
typedef unsigned v2u __attribute__((ext_vector_type(2)));
#define KAS __attribute__((address_space(4)))
static_assert(true, "Args layout: in[26] at 0, out at 208, ws at 216, ph_lo 224, ph_hi 228, li 232, dbg 236");
struct Args { const float* in[26]; float* out; unsigned char* ws; unsigned char* part; int ph_lo, ph_hi, li, dbg; };
constexpr int KA_OUT = 208, KA_WS = 216, KA_PART = 224, KA_LO = 232, KA_HI = 236, KA_LI = 240, KA_DBG = 244;
static_assert(sizeof(Args) == 248, "Args layout");

struct Frame { LAS unsigned char* lds; volatile LAS unsigned* MISC; int tid, lane, wave, vcu, G; };

__device__ __forceinline__ float wave_sum(float v) {
#pragma unroll
    for (int o = 1; o < 64; o <<= 1) v += __shfl_xor(v, o);
    return v;
}
__device__ __forceinline__ unsigned pkbf(float lo, float hi) { return pg8::cvt_pk_bf16(lo, hi); }
__device__ __forceinline__ float bflo(unsigned w) { return __uint_as_float(w << 16); }
__device__ __forceinline__ float bfhi(unsigned w) { return __uint_as_float(w & 0xffff0000u); }

__device__ __forceinline__ unsigned pk4f8(float a, float b, float c, float d) { int w = __builtin_amdgcn_cvt_pk_fp8_f32(a, b, 0, false); w = __builtin_amdgcn_cvt_pk_fp8_f32(c, d, w, true); return (unsigned)w; }
__device__ __forceinline__ void conv_item(const float* W, int ldw, int k0, int n0, bf16* WT, int K, int drow0, LAS float* scr, int lane, const float* gk  , float f8s = 0.f  ) {
    const int kq = lane >> 4, nq = lane & 15;
    f32x4 v[16];
#pragma unroll
    for (int i = 0; i < 16; ++i) v[i] = __builtin_nontemporal_load((const f32x4*)(W + (size_t)(k0 + 4 * i + kq) * ldw + n0 + 4 * nq));
#pragma unroll
    for (int i = 0; i < 16; ++i) { const int k = 4 * i + kq; f32x4 t = v[i]; if (gk) t = t * gk[k0 + k]; *(LAS f32x4*)(scr + k * 64 + 4 * (nq ^ (k >> 3))) = t; }
    LDS_WAIT(); asm volatile("" ::: "memory");
    const int c = lane & 7;
    if (f8s != 0.f) { unsigned char* WT8 = (unsigned char*)WT;
#pragma unroll
        for (int j = 0; j < 8; ++j) { const int nn = (lane >> 3) + 8 * j; const LAS float* s = scr + (8 * c) * 64 + (nn ^ (4 * c));
            v2u o; o.x = pk4f8(s[0] * f8s, s[64] * f8s, s[128] * f8s, s[192] * f8s); o.y = pk4f8(s[256] * f8s, s[320] * f8s, s[384] * f8s, s[448] * f8s);
            *(GAS v2u*)(WT8 + (size_t)(drow0 + nn) * K + k0 + 8 * c) = o; } }
    else {
#pragma unroll
    for (int j = 0; j < 8; ++j) { const int nn = (lane >> 3) + 8 * j; const LAS float* s = scr + (8 * c) * 64 + (nn ^ (4 * c));
        v4u o; o.x = pkbf(s[0], s[64]); o.y = pkbf(s[128], s[192]); o.z = pkbf(s[256], s[320]); o.w = pkbf(s[384], s[448]);
        *(GAS v4u*)(WT + (size_t)(drow0 + nn) * K + k0 + 8 * c) = o; } }
    LDS_WAIT(); asm volatile("" ::: "memory");
}
__device__ __forceinline__ void conv_job(const float* W, int ldw, int K, int N, bf16* WT, int half  , int r, LAS float* scr, int lane, const float* gk = nullptr, float f8s = 0.f) {
    const int nblk = N / 64, kb = r / nblk, nb = r % nblk, n0 = 64 * nb;
    const int drow0 = half < 0 ? n0 : ((n0 >> 7) * 256 + half * 128 + (n0 & 127));
    conv_item(W, ldw, 64 * kb, n0, WT, K, drow0, scr, lane, gk, f8s);
}
__device__ __forceinline__ void rms_row_to_bf16(const float* xrow, const float* g, bf16* orow, int lane) {
    const GAS f32x4* xr = (const GAS f32x4*)xrow + lane; const GAS f32x4* gr = (const GAS f32x4*)g + lane;
    f32x4 v[4]; float s = 0.f;
#pragma unroll
    for (int j = 0; j < 4; ++j) { v[j] = xr[64 * j]; s += (v[j].x * v[j].x + v[j].y * v[j].y) + (v[j].z * v[j].z + v[j].w * v[j].w); }
    const float rstd = 1.f / sqrtf(wave_sum(s) * (1.f / D) + RMS_EPS);
    GAS unsigned long long* o8 = (GAS unsigned long long*)orow + lane;
#pragma unroll
    for (int j = 0; j < 4; ++j) { const f32x4 gg = gr[64 * j]; o8[64 * j] = (unsigned long long)pkbf(v[j].x * rstd * gg.x, v[j].y * rstd * gg.y) | ((unsigned long long)pkbf(v[j].z * rstd * gg.z, v[j].w * rstd * gg.w) << 32); }
}
__device__ __forceinline__ void prep_x(Frame& F, const float* xin, bf16* X, float* ssq4) {
    const int gw = F.vcu * NWAVES + F.wave, NGW = F.G * NWAVES, lane = F.lane;
    for (int m0 = gw; m0 < T; m0 += 4 * NGW) {
        f32x4 v[4][4];
#pragma unroll
        for (int q = 0; q < 4; ++q) { const int m = m0 + q * NGW < T ? m0 + q * NGW : m0; const GAS f32x4* xr = (const GAS f32x4*)(xin + (size_t)m * D) + lane;
#pragma unroll
            for (int j = 0; j < 4; ++j) v[q][j] = __builtin_nontemporal_load(&xr[64 * j]); }
#pragma unroll
        for (int q = 0; q < 4; ++q) { const int m = m0 + q * NGW; float s = 0.f; unsigned long long w[4];
#pragma unroll
            for (int j = 0; j < 4; ++j) { const unsigned lo = pkbf(v[q][j].x, v[q][j].y), hi = pkbf(v[q][j].z, v[q][j].w); w[j] = (unsigned long long)lo | ((unsigned long long)hi << 32);
                const float r0 = bflo(lo), r1 = bfhi(lo), r2 = bflo(hi), r3 = bfhi(hi); s += (r0 * r0 + r1 * r1) + (r2 * r2 + r3 * r3); }
            s = wave_sum(s);
            if (m < T) { GAS unsigned long long* o8 = (GAS unsigned long long*)(X + (size_t)m * D) + lane;
#pragma unroll
                for (int j = 0; j < 4; ++j) o8[64 * j] = w[j];
                if (lane < 4) ssq4[(size_t)m * 4 + lane] = lane == 0 ? s : 0.f; } }
    }
}
__device__ __forceinline__ void p0_convert(Frame& F, const KAS char* ka, int pair, bf16* WB) {
#define INP(i) (*(const float* const KAS*)(ka + 8 * (i)))
    LAS float* scr = (LAS float*)(F.lds + F.wave * 16384);
    const int gw = F.vcu * NWAVES + F.wave, NGW = F.G * NWAVES;
    constexpr int I_IN = 16 * 36, I_OUT = 256, I_G = 16 * 44, I_DN = 44 * 16, I_PW1H = 256, I_PW2 = 256, I_EG = 16 * 56, I_ED = 56 * 16;
    constexpr int NITEMS = I_IN + I_OUT + 2 * I_G + I_DN + 2 * I_PW1H + I_PW2 + NE * (2 * I_EG + I_ED);
    const float* w_in = INP(2) + (size_t)pair * D * NPROJ; const float* w_out = INP(6) + (size_t)pair * D * D;
    const float* w_fg = INP(8) + (size_t)pair * D * DFF; const float* w_fu = INP(9) + (size_t)pair * D * DFF; const float* w_fd = INP(10) + (size_t)pair * DFF * D;
    const float* w_p1 = INP(12) + (size_t)pair * D * 2 * D; const float* w_p2 = INP(18) + (size_t)pair * D * D;
    const float* g_att = INP(1) + pair * D; const float* g_ffn = INP(7) + pair * D; const float* g_conv = INP(11) + pair * D;
    const bool ffn8 = FFN_F8(pair);
    const bool conv8 = CONV_F8(pair);
    const float* w_eg = INP(22) + (size_t)pair * NE * D * DFE; const float* w_eu = INP(23) + (size_t)pair * NE * D * DFE; const float* w_ed = INP(24) + (size_t)pair * NE * DFE * D;
    for (int it = gw; it < NITEMS; it += NGW) {
        int r = it;
        if (r < I_IN) { conv_job(w_in, NPROJ, D, NPROJ, WB + WB_IN, -1, r, scr, F.lane, g_att, PROJ_F8(pair) ? (float)(1 << pg8::F8_WSHIFT) : 0.f); continue; } r -= I_IN;
        if (r < I_OUT) { conv_job(w_out, D, D, D, WB + WB_OUT, -1, r, scr, F.lane, nullptr, OUT_F8(pair) ? (float)(1 << pg8::F8_WSHIFT) : 0.f); continue; } r -= I_OUT;
        if (r < I_G) { conv_job(w_fg, DFF, D, DFF, WB + WB_W13, 0, r, scr, F.lane, g_ffn, ffn8 ? (float)(1 << pg8::F8_WSHIFT) : 0.f); continue; } r -= I_G;
        if (r < I_G) { conv_job(w_fu, DFF, D, DFF, WB + WB_W13, 1, r, scr, F.lane, g_ffn, ffn8 ? (float)(1 << pg8::F8_WSHIFT) : 0.f); continue; } r -= I_G;
        if (r < I_DN) { conv_job(w_fd, D, DFF, D, WB + WB_W2, -1, r, scr, F.lane, nullptr, ffn8 ? (float)(1 << pg8::F8_FW2SHIFT) : 0.f); continue; } r -= I_DN;
        if (r < I_PW1H) { conv_job(w_p1, 2 * D, D, D, WB + WB_PW1, 0, r, scr, F.lane, g_conv, conv8 ? (float)(1 << pg8::F8_WSHIFT) : 0.f); continue; } r -= I_PW1H;
        if (r < I_PW1H) { conv_job(w_p1 + D, 2 * D, D, D, WB + WB_PW1, 1, r, scr, F.lane, g_conv, conv8 ? (float)(1 << pg8::F8_WSHIFT) : 0.f); continue; } r -= I_PW1H;
        if (r < I_PW2) { conv_job(w_p2, D, D, D, WB + WB_PW2, -1, r, scr, F.lane, nullptr, conv8 ? (float)(1 << pg8::F8_WSHIFT) : 0.f); continue; } r -= I_PW2;
        if (r < NE * I_EG) { const int e = r / I_EG; conv_job(w_eg + (size_t)e * D * DFE, DFE, D, DFE, WB + WB_E13 + (size_t)e * DFE * D  , 0, r % I_EG, scr, F.lane, nullptr, (float)(1 << pg8::F8_WSHIFT)); continue; } r -= NE * I_EG;
        if (r < NE * I_EG) { const int e = r / I_EG; conv_job(w_eu + (size_t)e * D * DFE, DFE, D, DFE, WB + WB_E13 + (size_t)e * DFE * D, 1, r % I_EG, scr, F.lane, nullptr, (float)(1 << pg8::F8_WSHIFT)); continue; } r -= NE * I_EG;
        { const int e = r / I_ED; conv_job(w_ed + (size_t)e * DFE * D, D, DFE, D, WB + WB_E2 + (size_t)e * D * DFE / 2  , -1, r % I_ED, scr, F.lane, nullptr, (float)(1 << pg8::F8_W2SHIFT)); }
    }
#undef INP
}
__device__ __forceinline__ void p3_diffcombine(Frame& F, const bf16* O16, bf16* MIX, const float* lamp, const float* subg, float lam_init, unsigned char* mix8  ) {
    const int gw = F.vcu * NWAVES + F.wave, NGW = F.G * NWAVES, lane = F.lane;
    const float pa = wave_sum(lamp[lane] * lamp[64 + lane]), pb = wave_sum(lamp[128 + lane] * lamp[192 + lane]);
    const float lam = expf(pa) - expf(pb) + lam_init;
    const int h = lane >> 4, dvl = (lane & 15) * 8;
    float gsc[8];
#pragma unroll
    for (int i = 0; i < 8; ++i) gsc[i] = subg[dvl + i] * (1.0f - lam_init);
    for (int m0 = gw; m0 < T; m0 += 4 * NGW) {
        v4u a[4], b[4], sw[4];
#pragma unroll
        for (int q = 0; q < 4; ++q) { const int m = m0 + q * NGW < T ? m0 + q * NGW : m0;
            a[q] = *(const GAS v4u*)(O16 + (size_t)m * D + h * 256 + dvl); b[q] = *(const GAS v4u*)(O16 + (size_t)m * D + h * 256 + 128 + dvl);
            if (mix8) sw[q] = *(const GAS v4u*)(MIX + (size_t)m * D + 512 + 8 * lane); }
#pragma unroll
        for (int q = 0; q < 4; ++q) { const int m = m0 + q * NGW;
            float v[8];
            v[0] = bflo(a[q].x) - lam * bflo(b[q].x); v[1] = bfhi(a[q].x) - lam * bfhi(b[q].x); v[2] = bflo(a[q].y) - lam * bflo(b[q].y); v[3] = bfhi(a[q].y) - lam * bfhi(b[q].y);
            v[4] = bflo(a[q].z) - lam * bflo(b[q].z); v[5] = bfhi(a[q].z) - lam * bfhi(b[q].z); v[6] = bflo(a[q].w) - lam * bflo(b[q].w); v[7] = bfhi(a[q].w) - lam * bfhi(b[q].w);
            float ss = 0.f;
#pragma unroll
            for (int i = 0; i < 8; ++i) ss += v[i] * v[i];
            ss += __shfl_xor(ss, 1); ss += __shfl_xor(ss, 2); ss += __shfl_xor(ss, 4); ss += __shfl_xor(ss, 8);
            const float r = 1.f / sqrtf(ss * (1.f / 128.f) + RMS_EPS);
            v4u o; o.x = pkbf(v[0] * r * gsc[0], v[1] * r * gsc[1]); o.y = pkbf(v[2] * r * gsc[2], v[3] * r * gsc[3]); o.z = pkbf(v[4] * r * gsc[4], v[5] * r * gsc[5]); o.w = pkbf(v[6] * r * gsc[6], v[7] * r * gsc[7]);
            if (m < T) { if (!mix8) *(GAS v4u*)(MIX + (size_t)m * D + h * 128 + dvl) = o;
                if (mix8) { const float ms = (float)(1 << pg8::F8_HSHIFT);
#define P3_F8(w_) __builtin_amdgcn_fmed3f(bflo(w_) * ms, -440.f, 440.f), __builtin_amdgcn_fmed3f(bfhi(w_) * ms, -440.f, 440.f)
                    v2u f0, f1; f0.x = pk4f8(P3_F8(o.x), P3_F8(o.y)); f0.y = pk4f8(P3_F8(o.z), P3_F8(o.w)); f1.x = pk4f8(P3_F8(sw[q].x), P3_F8(sw[q].y)); f1.y = pk4f8(P3_F8(sw[q].z), P3_F8(sw[q].w));
#undef P3_F8
                    *(GAS v2u*)(mix8 + (size_t)m * D + h * 128 + dvl) = f0; *(GAS v2u*)(mix8 + (size_t)m * D + 512 + 8 * lane) = f1; } } }
    }
}
__device__ __forceinline__ void p10_conv(Frame& F, const bf16* U, bf16* V, const float* wdw, const float* bdw, const float* lng, const float* lnb, float f8s  ) {
    const int tid = F.tid, lane = F.lane, wave = F.wave;
    LAS unsigned char* tile = F.lds;
    f32x2 w[31];
#pragma unroll
    for (int k = 0; k < 31; ++k) w[k] = *(const GAS f32x2*)(wdw + k * D + 2 * tid);
    const f32x2 bia = *(const GAS f32x2*)(bdw + 2 * tid);
    f32x2 lg_[8], lb_[8];
#pragma unroll
    for (int j = 0; j < 8; ++j) { lg_[j] = *(const GAS f32x2*)(lng + 16 * lane + 2 * j); lb_[j] = *(const GAS f32x2*)(lnb + 16 * lane + 2 * j); }
    for (int u = F.vcu; u < T / 32; u += F.G) {
        const int t0 = u * 32, tp0 = t0 % SEQ;
        { v4u val[16];
#pragma unroll
            for (int i = 0; i < 16; ++i) { const int idx = tid + 512 * i, row = idx >> 7, cc = idx & 127; const bool ok = (tp0 - 30 + row >= 0) && (idx < 62 * 128);
                val[i] = *(const GAS v4u*)(U + (size_t)(ok ? t0 - 30 + row : t0) * D + cc * 8); }
#pragma unroll
            for (int i = 0; i < 16; ++i) { const int idx = tid + 512 * i, row = idx >> 7, cc = idx & 127; const bool ok = (tp0 - 30 + row >= 0);
                if (idx < 62 * 128) *(LAS v4u*)(tile + row * 2048 + cc * 16) = ok ? val[i] : (v4u){0u, 0u, 0u, 0u}; } }
        __syncthreads();
        for (int g = 0; g < 4; ++g) {
            f32x2 acc[8];
#pragma unroll
            for (int o = 0; o < 8; ++o) acc[o] = bia;
            LAS unsigned char* base = tile + (8 * g) * 2048 + 4 * tid;
#pragma unroll
            for (int r = 0; r < 38; ++r) { const unsigned xw = *(LAS unsigned*)(base + r * 2048); const f32x2 xv = (f32x2){bflo(xw), bfhi(xw)};
#pragma unroll
                for (int o = 0; o < 8; ++o) { const int k = r - o; if (k >= 0 && k <= 30) acc[o] += w[k] * xv; } }
#pragma unroll
            for (int o = 0; o < 8; ++o) *(LAS unsigned*)(base + o * 2048) = pkbf(acc[o].x, acc[o].y);
        }
        __syncthreads();
#pragma unroll
        for (int i = 0; i < 4; ++i) { const int tl = 4 * wave + i;
            const v4u a = *(LAS v4u*)(tile + tl * 2048 + lane * 32), b = *(LAS v4u*)(tile + tl * 2048 + lane * 32 + 16);
            float v[16];
            v[0] = bflo(a.x); v[1] = bfhi(a.x); v[2] = bflo(a.y); v[3] = bfhi(a.y); v[4] = bflo(a.z); v[5] = bfhi(a.z); v[6] = bflo(a.w); v[7] = bfhi(a.w);
            v[8] = bflo(b.x); v[9] = bfhi(b.x); v[10] = bflo(b.y); v[11] = bfhi(b.y); v[12] = bflo(b.z); v[13] = bfhi(b.z); v[14] = bflo(b.w); v[15] = bfhi(b.w);
            float s = 0.f;
#pragma unroll
            for (int j = 0; j < 16; ++j) s += v[j];
            const float mu = wave_sum(s) * (1.f / D); float q = 0.f;
#pragma unroll
            for (int j = 0; j < 16; ++j) { v[j] -= mu; q += v[j] * v[j]; }
            const float rstd = 1.f / sqrtf(wave_sum(q) * (1.f / D) + LN_EPS);
            unsigned ow[8];
#pragma unroll
            for (int j = 0; j < 8; ++j) { const f32x2 gg = lg_[j], bb = lb_[j];
                const float y0 = v[2 * j] * rstd * gg.x + bb.x, y1 = v[2 * j + 1] * rstd * gg.y + bb.y;
                const float z0 = y0 * pg8::sigmoid_fast(y0), z1 = y1 * pg8::sigmoid_fast(y1); ow[j] = pkbf(z0, z1); v[2 * j] = z0; v[2 * j + 1] = z1; }
            if (f8s != 0.f) {
#pragma unroll
                for (int j = 0; j < 16; ++j) v[j] = __builtin_amdgcn_fmed3f(v[j] * f8s, -440.f, 440.f);
                v4u o8; o8.x = pk4f8(v[0], v[1], v[2], v[3]); o8.y = pk4f8(v[4], v[5], v[6], v[7]); o8.z = pk4f8(v[8], v[9], v[10], v[11]); o8.w = pk4f8(v[12], v[13], v[14], v[15]);
                *(GAS v4u*)((unsigned char*)V + (size_t)(t0 + tl) * D + 16 * lane) = o8; }
            else { bf16* vp = V + (size_t)(t0 + tl) * D + 16 * lane;
            *(GAS v4u*)vp = (v4u){ow[0], ow[1], ow[2], ow[3]}; *(GAS v4u*)(vp + 8) = (v4u){ow[4], ow[5], ow[6], ow[7]}; } }
        __syncthreads();
    }
}
__device__ __forceinline__ void p12_route1(Frame& F, const bf16* X, const float* g, const float* wr, const float* ssq4, unsigned char* rt) {
    const int lane = F.lane, wave = F.wave, tid = F.tid;
    LAS int* tok_e = (LAS int*)F.lds; LAS int* loc = tok_e + 64;
    int2* SELE = (int2*)(rt + RT_SELE); int2* SELL = (int2*)(rt + RT_SELL); float2* SELW = (float2*)(rt + RT_SELW); int* CNTB = (int*)(rt + RT_CNTB);
    f32x4 wa[16], wb[16];
    { LAS unsigned char* wl = F.lds + 1024;
#pragma unroll
      for (int r = 0; r < 4; ++r) { const int idx = tid + 512 * r, k = idx >> 1, half = idx & 1; const f32x4 wv = *(const GAS f32x4*)(wr + k * 8 + half * 4);
          *(LAS f32x4*)(wl + ((((k >> 8) * 4 + (k & 3)) * 2 + half) * 64 + ((k & 255) >> 2)) * 16) = wv; }
      __syncthreads();
#pragma unroll
      for (int j = 0; j < 4; ++j)
#pragma unroll
          for (int i = 0; i < 4; ++i) { wa[4 * j + i] = *(const LAS f32x4*)(wl + (((j * 4 + i) * 2 + 0) * 64 + lane) * 16); wb[4 * j + i] = *(const LAS f32x4*)(wl + (((j * 4 + i) * 2 + 1) * 64 + lane) * 16); }
      __syncthreads(); }
    f32x4 gg[4];
#pragma unroll
    for (int j = 0; j < 4; ++j) gg[j] = ((const GAS f32x4*)g)[lane + 64 * j];
    for (int blk = F.vcu; blk < T / 64; blk += F.G) {
#pragma unroll 1
        for (int q0 = 0; q0 < 8; q0 += 4) {
        unsigned long long xw[4][4];
#pragma unroll
        for (int q = 0; q < 4; ++q) { const GAS unsigned long long* xr = (const GAS unsigned long long*)(X + (size_t)(blk * 64 + 8 * wave + q0 + q) * D) + lane;
#pragma unroll
            for (int j = 0; j < 4; ++j) xw[q][j] = xr[64 * j]; }
        int se0 = 0, se1 = 0; float sw0 = 0.f;
#pragma unroll
        for (int q = 0; q < 4; ++q) { const int t = blk * 64 + 8 * wave + q0 + q;
            f32x4 v[4];
#pragma unroll
            for (int j = 0; j < 4; ++j) { const unsigned lo = (unsigned)xw[q][j], hi = (unsigned)(xw[q][j] >> 32); v[j] = (f32x4){bflo(lo), bfhi(lo), bflo(hi), bfhi(hi)}; }
            f32x4 la = (f32x4){0.f, 0.f, 0.f, 0.f}, lb = la;
#pragma unroll
            for (int j = 0; j < 4; ++j) { v[j] = v[j] * gg[j];
                la += wa[4 * j] * v[j].x + wa[4 * j + 1] * v[j].y + wa[4 * j + 2] * v[j].z + wa[4 * j + 3] * v[j].w;
                lb += wb[4 * j] * v[j].x + wb[4 * j + 1] * v[j].y + wb[4 * j + 2] * v[j].z + wb[4 * j + 3] * v[j].w; }
            const float rstd = pg8::row_rstd(ssq4, t, 1.f / D, RMS_EPS);
            float r4[4], r2[2], r1;
            { const bool h = (lane & 32) != 0; const float l8[8] = {la.x, la.y, la.z, la.w, lb.x, lb.y, lb.z, lb.w};
#pragma unroll
              for (int i = 0; i < 4; ++i) { const float snd = h ? l8[i] : l8[i + 4], kp = h ? l8[i + 4] : l8[i]; r4[i] = kp + __shfl_xor(snd, 32); } }
            { const bool h = (lane & 16) != 0;
#pragma unroll
              for (int i = 0; i < 2; ++i) { const float snd = h ? r4[i] : r4[i + 2], kp = h ? r4[i + 2] : r4[i]; r2[i] = kp + __shfl_xor(snd, 16); } }
            { const bool h = (lane & 8) != 0; const float snd = h ? r2[0] : r2[1], kp = h ? r2[1] : r2[0]; r1 = kp + __shfl_xor(snd, 8); }
            r1 += __shfl_xor(r1, 4); r1 += __shfl_xor(r1, 2); r1 += __shfl_xor(r1, 1);
            float lg[8];
#pragma unroll
            for (int e = 0; e < 8; ++e) lg[e] = __int_as_float(__builtin_amdgcn_readlane(__float_as_int(r1), 8 * e)) * rstd;
            int e0 = 0; float b0 = lg[0];
#pragma unroll
            for (int e = 1; e < 8; ++e) if (lg[e] > b0) { b0 = lg[e]; e0 = e; }
            int e1 = -1; float b1 = -INFINITY;
#pragma unroll
            for (int e = 0; e < 8; ++e) if (e != e0 && lg[e] > b1) { b1 = lg[e]; e1 = e; }
            const float w0 = 1.0f / (1.0f + expf(b1 - b0));
            if (lane == q) { se0 = e0; se1 = e1; sw0 = w0; }
        }
        if (lane < 4) { const int tl = 8 * wave + q0 + lane, t = blk * 64 + tl; SELE[t] = make_int2(se0, se1); SELW[t] = make_float2(sw0, 1.0f - sw0); tok_e[tl] = se0 | (se1 << 8); } }
        __syncthreads();
        { const int ee = tok_e[lane]; const bool h0 = (ee & 255) == wave, h1 = (ee >> 8) == wave;
          const unsigned long long mm = __ballot(h0 || h1); const int before = __popcll(mm & ((1ull << lane) - 1ull));
          if (h0) loc[2 * lane] = before; if (h1) loc[2 * lane + 1] = before;
          if (lane == 0) CNTB[blk * 8 + wave] = __popcll(mm); }
        __syncthreads();
        if (tid < 64) SELL[blk * 64 + tid] = make_int2(loc[2 * tid], loc[2 * tid + 1]);
        __syncthreads();
    }
}
__device__ __forceinline__ void p13_route2(Frame& F, const bf16* X, bf16* XS, unsigned char* rt, const float* ssq4, const float* g) {
    const int lane = F.lane, wave = F.wave, tid = F.tid;
    f32x4 ga[2], gb[2];
    ga[0] = *(const GAS f32x4*)(g + 8 * lane); ga[1] = *(const GAS f32x4*)(g + 8 * lane + 4); gb[0] = *(const GAS f32x4*)(g + 512 + 8 * lane); gb[1] = *(const GAS f32x4*)(g + 512 + 8 * lane + 4);
    LAS int* tot = (LAS int*)F.lds; LAS int* bas = tot + 8; LAS int* pst = tot + 16;
    const int2* SELE = (const int2*)(rt + RT_SELE); const int2* SELL = (const int2*)(rt + RT_SELL); int2* TOKD = (int2*)(rt + RT_TOKD); const int* CNTB = (const int*)(rt + RT_CNTB);
    int* CHE = (int*)(rt + RT_CHE); int* NCH = (int*)(rt + RT_NCH);
    const int c0 = CNTB[(4 * lane + 0) * 8 + wave], c1 = CNTB[(4 * lane + 1) * 8 + wave], c2 = CNTB[(4 * lane + 2) * 8 + wave], c3 = CNTB[(4 * lane + 3) * 8 + wave];
    const int sl = c0 + c1 + c2 + c3; int inc = sl;
#pragma unroll
    for (int o = 1; o < 64; o <<= 1) { const int t = __shfl_up(inc, o); if (lane >= o) inc += t; }
    const int ex = inc - sl, total = __shfl(inc, 63);
    for (int blk = F.vcu; blk < T / 64; blk += F.G) {
        const int j = blk & 3; const int pj = ex + (j > 0 ? c0 : 0) + (j > 1 ? c1 : 0) + (j > 2 ? c2 : 0);
        const int mybase = __shfl(pj, blk >> 2);
        __syncthreads();
        if (lane == 0) { tot[wave] = total; bas[wave] = mybase; }
        __syncthreads();
        if (tid == 0) { int ps = 0;
            for (int e = 0; e < 8; ++e) { pst[e] = ps; const int nc = (tot[e] + 255) >> 8;
                if (blockIdx.x == 0 && blk == F.vcu) for (int c = 0; c < nc; ++c) CHE[(ps >> 8) + c] = e;
                ps += nc << 8; if (blockIdx.x == 0 && blk == F.vcu) ((int*)(rt + RT_CB))[e] = ps >> 8; }
            if (blockIdx.x == 0 && blk == F.vcu) NCH[0] = ps >> 8; }
        __syncthreads();
        for (int i0 = 0; i0 < 8; i0 += 4) {
            v4u ra[4], rb[4]; int d0[4], d1[4]; float rs[4];
#pragma unroll
            for (int q = 0; q < 4; ++q) { const int t = blk * 64 + 8 * wave + i0 + q; const int2 ee = SELE[t], ll = SELL[t];
                d0[q] = pst[ee.x] + bas[ee.x] + ll.x; d1[q] = pst[ee.y] + bas[ee.y] + ll.y;
                const GAS v4u* src = (const GAS v4u*)(X + (size_t)t * D); ra[q] = src[lane]; rb[q] = src[lane + 64]; rs[q] = pg8::row_rstd(ssq4, t, 1.f / D, RMS_EPS); }
#pragma unroll
            for (int q = 0; q < 4; ++q) { const int t = blk * 64 + 8 * wave + i0 + q;
                if (lane == 0) TOKD[t] = make_int2(d0[q], d1[q]);
                const f32x4 a0 = ga[0] * rs[q], a1 = ga[1] * rs[q], b0 = gb[0] * rs[q], b1 = gb[1] * rs[q];
                v2u fa, fb; fa.x = pk4f8(bflo(ra[q].x) * a0.x, bfhi(ra[q].x) * a0.y, bflo(ra[q].y) * a0.z, bfhi(ra[q].y) * a0.w); fa.y = pk4f8(bflo(ra[q].z) * a1.x, bfhi(ra[q].z) * a1.y, bflo(ra[q].w) * a1.z, bfhi(ra[q].w) * a1.w);
                fb.x = pk4f8(bflo(rb[q].x) * b0.x, bfhi(rb[q].x) * b0.y, bflo(rb[q].y) * b0.z, bfhi(rb[q].y) * b0.w); fb.y = pk4f8(bflo(rb[q].z) * b1.x, bfhi(rb[q].z) * b1.y, bflo(rb[q].w) * b1.z, bfhi(rb[q].w) * b1.w);
                GAS v2u* q0 = (GAS v2u*)((unsigned char*)XS + (size_t)d0[q] * D); GAS v2u* q1 = (GAS v2u*)((unsigned char*)XS + (size_t)d1[q] * D);
                q0[lane] = fa; q0[lane + 64] = fb; q1[lane] = fa; q1[lane + 64] = fb; } }
    }
}
__device__ __forceinline__ void p16_combine(Frame& F, bf16* X, const bf16* YS, const bf16* PART, const unsigned char* rt, const float* g, float* ssq4, float* out, bool last, bool poison, unsigned char* x8  ) {
    const int gw = F.vcu * NWAVES + F.wave, NGW = F.G * NWAVES, lane = F.lane;
    const int2* TOKD = (const int2*)(rt + RT_TOKD); const float2* SELW = (const float2*)(rt + RT_SELW);
    f32x4 gg[4];
#pragma unroll
    for (int j = 0; j < 4; ++j) gg[j] = ((const GAS f32x4*)g)[lane + 64 * j];
    for (int m0 = gw; m0 < T; m0 += 4 * NGW) {
        int2 dd[4]; float2 ww[4];
#pragma unroll
        for (int q = 0; q < 4; ++q) { const int m = m0 + q * NGW < T ? m0 + q * NGW : m0; dd[q] = TOKD[m]; ww[q] = SELW[m]; }
        f32x4 v[4][4]; unsigned long long xa[4][4], ya[4][4], yb[4][4];
#pragma unroll
        for (int q = 0; q < 4; ++q) { const int m = m0 + q * NGW < T ? m0 + q * NGW : m0;
            const int d0 = dd[q].x < NFC * 256 ? dd[q].x : 0, d1 = dd[q].y < NFC * 256 ? dd[q].y : 0;
            const GAS unsigned long long* xr = (const GAS unsigned long long*)(X + (size_t)m * D) + lane;
            const GAS unsigned long long* y0 = (const GAS unsigned long long*)(YS + (size_t)d0 * D) + lane; const GAS unsigned long long* y1 = (const GAS unsigned long long*)(YS + (size_t)d1 * D) + lane;
#pragma unroll
            for (int j = 0; j < 4; ++j) { xa[q][j] = xr[64 * j]; ya[q][j] = y0[64 * j]; yb[q][j] = y1[64 * j]; } }
#pragma unroll
        for (int q = 0; q < 4; ++q)
#pragma unroll
            for (int j = 0; j < 4; ++j) { const unsigned lo = (unsigned)xa[q][j], hi = (unsigned)(xa[q][j] >> 32); v[q][j] = (f32x4){bflo(lo), bfhi(lo), bflo(hi), bfhi(hi)}; }
#pragma unroll
        for (int q = 0; q < 4; ++q) { const int m = m0 + q * NGW;
#pragma unroll
            for (int e = 0; e < 2; ++e) { const int d = e ? dd[q].y : dd[q].x; const float w = e ? ww[q].y : ww[q].x;
                if (d < NFC * 256) {
#pragma unroll
                    for (int j = 0; j < 4; ++j) { const unsigned long long a = e ? yb[q][j] : ya[q][j]; const unsigned al = (unsigned)a, ah = (unsigned)(a >> 32);
                        v[q][j].x += w * bflo(al); v[q][j].y += w * bfhi(al); v[q][j].z += w * bflo(ah); v[q][j].w += w * bfhi(ah); } }
                else { f32x4 t[4];
#pragma unroll
                    for (int j = 0; j < 4; ++j) t[j] = (f32x4){0.f, 0.f, 0.f, 0.f};
                    for (int ks = 0; ks < TAIL_KS; ++ks) { const GAS unsigned long long* y = (const GAS unsigned long long*)(PART + ((size_t)ks * TAIL_ROWS + (d - NFC * 256)) * D) + lane;
#pragma unroll
                        for (int j = 0; j < 4; ++j) { const unsigned long long a = y[64 * j]; const unsigned al = (unsigned)a, ah = (unsigned)(a >> 32);
                            t[j].x += bflo(al); t[j].y += bfhi(al); t[j].z += bflo(ah); t[j].w += bfhi(ah); } }
#pragma unroll
                    for (int j = 0; j < 4; ++j) v[q][j] += t[j] * w; } }
            if (last) {
                float s = 0.f;
#pragma unroll
                for (int j = 0; j < 4; ++j) s += (v[q][j].x * v[q][j].x + v[q][j].y * v[q][j].y) + (v[q][j].z * v[q][j].z + v[q][j].w * v[q][j].w);
                const float rstd = 1.f / sqrtf(wave_sum(s) * (1.f / D) + RMS_EPS);
                if (m < T) { GAS f32x4* orow = (GAS f32x4*)(out + (size_t)m * D) + lane; const float qn = __builtin_nanf("");
#pragma unroll
                    for (int j = 0; j < 4; ++j) { f32x4 o = v[q][j] * rstd * gg[j]; if (poison) o = (f32x4){qn, qn, qn, qn}; __builtin_nontemporal_store(o, &orow[64 * j]); } } }
            else {
                float s = 0.f; unsigned long long w[4];
#pragma unroll
                for (int j = 0; j < 4; ++j) { const unsigned lo = pkbf(v[q][j].x, v[q][j].y), hi = pkbf(v[q][j].z, v[q][j].w); w[j] = (unsigned long long)lo | ((unsigned long long)hi << 32);
                    const float r0 = bflo(lo), r1 = bfhi(lo), r2 = bflo(hi), r3 = bfhi(hi); s += (r0 * r0 + r1 * r1) + (r2 * r2 + r3 * r3); }
                s = wave_sum(s);
                if (m < T) { GAS unsigned long long* o8 = (GAS unsigned long long*)(X + (size_t)m * D) + lane;
#pragma unroll
                    for (int j = 0; j < 4; ++j) o8[64 * j] = w[j];
                    if (x8) { GAS unsigned* q8 = (GAS unsigned*)(x8 + (size_t)m * D) + lane; const float xs = (float)(1 << pg8::F8_XSHIFT);
#pragma unroll
                        for (int j = 0; j < 4; ++j) { const unsigned lo = (unsigned)w[j], hi = (unsigned)(w[j] >> 32);
                            q8[64 * j] = pk4f8(__builtin_amdgcn_fmed3f(bflo(lo) * xs, -440.f, 440.f), __builtin_amdgcn_fmed3f(bfhi(lo) * xs, -440.f, 440.f), __builtin_amdgcn_fmed3f(bflo(hi) * xs, -440.f, 440.f), __builtin_amdgcn_fmed3f(bfhi(hi) * xs, -440.f, 440.f)); } }
                    if (lane < 4) ssq4[(size_t)m * 4 + lane] = lane == 0 ? s : 0.f; } }
        }
    }
}
#if defined(MK_STAT)
constexpr size_t WS_STAMP = WS_RT + 2 * MiB;
#define MK_STAMP_ARR(s_) do { if (threadIdx.x == 0) { ((unsigned long long*)(ws + WS_STAMP))[((size_t)blockIdx.x * 40 + (s_)) * 2] = __builtin_amdgcn_s_memrealtime(); if (blockIdx.x == 0) ((unsigned long long*)(ws + WS_STAMP))[(size_t)256 * 80 + (s_) * 2] = __builtin_amdgcn_s_memtime(); } } while (0)
#define MK_STAMP_GO(s_)  do { if (threadIdx.x == 0) { ((unsigned long long*)(ws + WS_STAMP))[((size_t)blockIdx.x * 40 + (s_)) * 2 + 1] = __builtin_amdgcn_s_memrealtime(); if (blockIdx.x == 0) ((unsigned long long*)(ws + WS_STAMP))[(size_t)256 * 80 + (s_) * 2 + 1] = __builtin_amdgcn_s_memtime(); } } while (0)
#else
#define MK_STAMP_ARR(s_) do {} while (0)
#define MK_STAMP_GO(s_) do {} while (0)
#endif
template <int pair> __device__ __forceinline__ void layer_pair(Frame& F) {
    const KAS char* const ka0 = (const KAS char*)__builtin_amdgcn_kernarg_segment_ptr();
    extern __shared__ __attribute__((aligned(16))) unsigned char lds[];
        const int pb = pair * NPH;
#define PLO() (*(const int KAS*)(ka0 + KA_LO))
#define PHI() (*(const int KAS*)(ka0 + KA_HI))
#if defined(MK_STAT)
#define IN(k) ((threadIdx.x == 0 ? (void)(((LAS unsigned*)(F.lds + 143360 + 1024))[8] = (unsigned)(pb + (k))) : (void)0), PLO() <= pb + (k) && pb + (k) < PHI())
#else
#define IN(k) (PLO() <= pb + (k) && pb + (k) < PHI())
#endif
#define SEAM(k) do { if (pb + (k) + 1 < PHI()) { XcdBarrier b_; b_.bar = (unsigned*)((gu32*)(ws + WS_CTL) + CW_BAR) + (size_t)(*(const int KAS*)(ka + KA_LI)) * XCD_BAR_WORDS; b_.x = xb_xcc_id(); b_.st = F.MISC + 8; MK_STAMP_ARR(pb + (k)); xcd_barrier(b_); MK_STAMP_GO(pb + (k)); } } while (0)
#define REFRESH() int l_ = (int)__builtin_amdgcn_mbcnt_hi(~0u, __builtin_amdgcn_mbcnt_lo(~0u, 0u)); asm volatile("" : "+v"(l_)); F.lane = l_; F.tid = F.wave * 64 + l_; \
        const KAS char* ka = (const KAS char*)__builtin_amdgcn_kernarg_segment_ptr(); asm volatile("" : "+s"(ka)); unsigned char* const ws = *(unsigned char* const KAS*)(ka + KA_WS); (void)ws
#define INP(i) (*(const float* const KAS*)(ka + 8 * (i)))
#define WSP(T_, off) ((T_*)(ws + (off)))
        const float lam_init = pair == 0 ? 0.2f : 0.47071302f;

        if (IN(0)) { REFRESH();
            if (pair == 0 || *(const int KAS*)(ka + KA_DBG) != 0) p0_convert(F, ka, pair, WSP(bf16, WS_WB));
            if (pair == 0 && *(const int KAS*)(ka + KA_DBG) == 0) prep_x(F, INP(0), WSP(bf16, WS_X), WSP(float, WS_RT + RT_SSQ));
            if (pair == 0 || *(const int KAS*)(ka + KA_DBG) != 0) SEAM(0);
        }
        if (IN(1)) { REFRESH();
            pg8::Gemm g{PROJ_F8(pair) ? WSP(bf16, WS_XB) : WSP(bf16, WS_X), WSP(bf16, WS_WB) + WB_IN, T, NPROJ, PROJ_F8(pair) ? D / 2 : D, PROJ_F8(pair) ? D / 2 : D, pg8::f8_scale(pg8::F8_WSHIFT), pg8::f8_scale(pg8::F8_XSHIFT)}; pg8::StaticOrder S; S.init(T, NPROJ, F.G, (int)blockIdx.x);
            pg8::EpiProj E{WSP(bf16, WS_R1 + R1_PROJ), NPROJ, 0xC3u, attn_body::C2, WSP(const float, WS_RT + RT_SSQ), 1.0f / D, RMS_EPS};
            pg8::gemm_phase<pg8::EpiProj, pg8::StaticOrder, true, true, PROJ_F8(pair) != 0>(F.lds, g, S, E, F.wave);
            SEAM(1);
        }
        if (IN(2)) { REFRESH();
            const attn_body::bf16* PJ = WSP(const attn_body::bf16, WS_R1 + R1_PROJ); attn_body::bf16* O16 = WSP(attn_body::bf16, WS_R1 + R1_O16); attn_body::bf16* MIX = WSP(attn_body::bf16, WS_R1 + R1_MIX); const float* sinks = INP(5) + pair * 8;
#if defined(PROBE_SKIP_DIFF)
            if (F.vcu < 256 && *(const int KAS*)(ka + KA_LI) == 0) { const int k = F.vcu;
#else
            if (F.vcu < 256) { const int k = F.vcu;
#endif
                const int bhc = k >> 4, s = k & 15, b = bhc >> 3, h = (bhc >> 1) & 3, c = bhc & 1;
                const attn_body::bf16* base = PJ + (size_t)b * SEQ * NPROJ;
                for (int i = 0; i < 2; ++i) { const int qb = (i == 0) ? s : 31 - s;
                    attn_body::attn_unit128<8>(qb, base + h * 128 + c * 64, base + 512 + h * 128 + c * 64, base + 1024 + h * 128,
                                               O16 + (size_t)b * SEQ * D + (h * 2 + c) * 128, (char*)lds, F.wave); }
            }
#if defined(PROBE_SKIP_SWA)
            if (F.vcu < 256 && *(const int KAS*)(ka + KA_LI) == 0)
#else
            if (F.vcu < 256)
#endif
                for (int i = 0; i < 2; ++i) { const int su = F.vcu * 2 + i, b = su >> 8, hq = (su >> 5) & 7, qb = su & 31, kvh = hq >> 2;
                    const attn_body::bf16* base = PJ + (size_t)b * SEQ * NPROJ;
                    const float sink2 = sinks[hq] * LOG2E;
                    attn_body::attn_unit<8, true>(qb, base + 1536 + hq * 64, base + 2048 + kvh * 64, base + 2176 + kvh * 64,
                                                  MIX + (size_t)b * SEQ * D + 512 + hq * 64, sink2, (char*)lds, F.wave); }
            SEAM(2);
        }
        if (IN(3)) { REFRESH(); p3_diffcombine(F, WSP(bf16, WS_R1 + R1_O16), WSP(bf16, WS_R1 + R1_MIX), INP(3) + pair * 256, INP(4) + pair * 128, lam_init, OUT_F8(pair) ? ws + WS_R1 + R1_MIX8 : nullptr); SEAM(3); }
        if (IN(4)) { REFRESH();
            pg8::Gemm g{OUT_F8(pair) ? WSP(bf16, WS_R1 + R1_MIX8) : WSP(bf16, WS_R1 + R1_MIX), WSP(bf16, WS_WB) + WB_OUT, T, D, OUT_F8(pair) ? D / 2 : D, OUT_F8(pair) ? D / 2 : D, pg8::f8_scale(pg8::F8_WSHIFT), pg8::f8_scale(pg8::F8_HSHIFT)}; pg8::StaticOrder S; S.init(T, D, F.G, (int)blockIdx.x);
            pg8::EpiResX E{WSP(const bf16, WS_X), nullptr, WSP(bf16, WS_X), D, nullptr, WSP(float, WS_RT + RT_SSQ), FFN_F8(pair) ? ws + WS_XB : nullptr, (float)(1 << pg8::F8_XSHIFT)};
            pg8::gemm_phase<pg8::EpiResX, pg8::StaticOrder, false, true, OUT_F8(pair) != 0>(F.lds, g, S, E, F.wave);
            SEAM(4);
        }
        if (IN(6)) { REFRESH();
            pg8::Gemm g{FFN_F8(pair) ? WSP(bf16, WS_XB) : WSP(bf16, WS_X), WSP(bf16, WS_WB) + WB_W13, T, 2 * DFF, FFN_F8(pair) ? D / 2 : D, FFN_F8(pair) ? D / 2 : D, pg8::f8_scale(pg8::F8_WSHIFT), pg8::f8_scale(pg8::F8_XSHIFT)}; pg8::StaticOrder S; S.init(T, 2 * DFF, F.G, (int)blockIdx.x);
            pg8::EpiSwiglu E{WSP(bf16, WS_R1 + R1_HB), DFF, WSP(const float, WS_RT + RT_SSQ), 1.0f / D, RMS_EPS, FFN_F8(pair) ? (float)(1 << pg8::F8_HSHIFT) : 0.f};
            pg8::gemm_phase<pg8::EpiSwiglu, pg8::StaticOrder, true, true, FFN_F8(pair) != 0>(F.lds, g, S, E, F.wave);
            SEAM(6);
        }
        if (IN(7)) { REFRESH();
            pg8::Gemm g{WSP(bf16, WS_R1 + R1_HB), WSP(bf16, WS_WB) + WB_W2, T, D, FFN_F8(pair) ? DFF / 2 : DFF, FFN_F8(pair) ? DFF / 2 : DFF, pg8::f8_scale(pg8::F8_FW2SHIFT), pg8::f8_scale(pg8::F8_HSHIFT)}; pg8::StaticOrder S; S.init(T, D, F.G, (int)blockIdx.x);
            pg8::EpiResX E{WSP(const bf16, WS_X), nullptr, WSP(bf16, WS_X), D, nullptr, WSP(float, WS_RT + RT_SSQ), CONV_F8(pair) ? ws + WS_XB : nullptr, (float)(1 << pg8::F8_XSHIFT)};
            pg8::gemm_phase<pg8::EpiResX, pg8::StaticOrder, false, true, FFN_F8(pair) != 0>(F.lds, g, S, E, F.wave);
            SEAM(7);
        }
        if (IN(9)) { REFRESH();
            pg8::Gemm g{CONV_F8(pair) ? WSP(bf16, WS_XB) : WSP(bf16, WS_X), WSP(bf16, WS_WB) + WB_PW1, T, 2 * D, CONV_F8(pair) ? D / 2 : D, CONV_F8(pair) ? D / 2 : D, pg8::f8_scale(pg8::F8_WSHIFT), pg8::f8_scale(pg8::F8_XSHIFT)}; pg8::StaticOrder S; S.init(T, 2 * D, F.G, (int)blockIdx.x);
            pg8::EpiGlu E{WSP(bf16, WS_R1 + R1_U), D, INP(13) + pair * 2 * D, D, WSP(const float, WS_RT + RT_SSQ), 1.0f / D, RMS_EPS};
            pg8::gemm_phase<pg8::EpiGlu, pg8::StaticOrder, true, true, CONV_F8(pair) != 0>(F.lds, g, S, E, F.wave);
            SEAM(9);
        }
        if (IN(10)) { REFRESH(); p10_conv(F, WSP(bf16, WS_R1 + R1_U), WSP(bf16, WS_R1 + R1_V), INP(14) + pair * 31 * D, INP(15) + pair * D, INP(16) + pair * D, INP(17) + pair * D, CONV_F8(pair) ? (float)(1 << pg8::F8_HSHIFT) : 0.f); SEAM(10); }
        if (IN(11)) { REFRESH();
            pg8::Gemm g{WSP(bf16, WS_R1 + R1_V), WSP(bf16, WS_WB) + WB_PW2, T, D, CONV_F8(pair) ? D / 2 : D, CONV_F8(pair) ? D / 2 : D, pg8::f8_scale(pg8::F8_WSHIFT), pg8::f8_scale(pg8::F8_HSHIFT)}; pg8::StaticOrder S; S.init(T, D, F.G, (int)blockIdx.x);
            pg8::EpiResX E{WSP(const bf16, WS_X), nullptr, WSP(bf16, WS_X), D, INP(19) + pair * D, WSP(float, WS_RT + RT_SSQ), nullptr, 0.f};
            pg8::gemm_phase<pg8::EpiResX, pg8::StaticOrder, false, true, CONV_F8(pair) != 0>(F.lds, g, S, E, F.wave);
            SEAM(11);
        }
        if (IN(12)) { REFRESH(); p12_route1(F, WSP(bf16, WS_X), INP(20) + pair * D, INP(21) + (size_t)pair * D * NE, WSP(const float, WS_RT + RT_SSQ), ws + WS_RT); SEAM(12); }
        if (IN(13)) { REFRESH(); p13_route2(F, WSP(bf16, WS_X), WSP(bf16, WS_R2), ws + WS_RT, WSP(const float, WS_RT + RT_SSQ), INP(20) + pair * D); SEAM(13); }
        if (IN(14)) { REFRESH();
            const unsigned char* rt = ws + WS_RT; const int nch = __builtin_amdgcn_readfirstlane(*(const int*)(rt + RT_NCH));
            pg8::Gemm g{WSP(bf16, WS_R2), WSP(bf16, WS_WB) + WB_E13, nch * 256, 2 * DFE, D / 2, D / 2, pg8::f8_scale(pg8::F8_WSHIFT), pg8::f8_scale(0)};     pg8::MoeOrder S; S.so.init(nch * 256, 2 * DFE, F.G, (int)blockIdx.x); S.load_cb((const int*)(rt + RT_CB)); S.estride = (size_t)2 * DFE * D;
            pg8::EpiSwiglu E{WSP(bf16, WS_R1 + R1_HMOE), DFE, nullptr, 0.f, 0.f, (float)(1 << pg8::F8_HSHIFT)};
            pg8::gemm_phase<pg8::EpiSwiglu, pg8::MoeOrder, true, true, true>(F.lds, g, S, E, F.wave);
            SEAM(14);
        }
        if (IN(15)) { REFRESH();
            const unsigned char* rt = ws + WS_RT; const int nch = __builtin_amdgcn_readfirstlane(*(const int*)(rt + RT_NCH)); const int nfc = nch < NFC ? nch : NFC;
            { pg8::Gemm g{WSP(bf16, WS_R1 + R1_HMOE), WSP(bf16, WS_WB) + WB_E2, nfc * 256, D, DFE / 2, DFE / 2, pg8::f8_scale(pg8::F8_W2SHIFT), pg8::f8_scale(pg8::F8_HSHIFT)};     pg8::MoeOrder S; S.so.init(nfc * 256, D, F.G, (int)blockIdx.x); S.load_cb((const int*)(rt + RT_CB)); S.estride = (size_t)D * DFE;
              pg8::EpiProj E{WSP(bf16, WS_R2), D, 0u, 1.f, nullptr, 0.f, 0.f};
              pg8::gemm_phase<pg8::EpiProj, pg8::MoeOrder, true, true, true>(F.lds, g, S, E, F.wave); }
            if (nch > NFC) {
              pg8::Gemm g{WSP(bf16, WS_R1 + R1_HMOE), WSP(bf16, WS_WB) + WB_E2, 0, D, TAIL_KSLICE / 2, DFE / 2, pg8::f8_scale(pg8::F8_W2SHIFT), pg8::f8_scale(pg8::F8_HSHIFT)}; pg8::TailOrder S; S.nsu = (nch - NFC) * 4 * TAIL_KS; S.G = F.G; S.c = (int)blockIdx.x; S.nfc = NFC; S.KS = TAIL_KS; S.kslice = TAIL_KSLICE / 2; { const int* CB = (const int*)(rt + RT_CB);
#pragma unroll
                for (int e = 0; e < 7; ++e) S.cb[e] = __builtin_amdgcn_readfirstlane(CB[e]); } S.estride = (size_t)D * DFE;
              pg8::EpiProj E{(bf16*)(*(unsigned char* const KAS*)(ka + KA_PART)), D, 0u, 1.f, nullptr, 0.f, 0.f};
              pg8::gemm_phase<pg8::EpiProj, pg8::TailOrder, true, true, true>(F.lds, g, S, E, F.wave); }
            SEAM(15);
        }
        if (IN(16)) { REFRESH();
            const bool last = (pair == 1);
            const bool poison = last && (__hip_atomic_load((gu32*)(ws + WS_CTL) + CW_BAR + (size_t)(*(const int KAS*)(ka + KA_LI)) * XCD_BAR_WORDS + XB_TMO, RLX_AGENT) != 0u);
            p16_combine(F, WSP(bf16, WS_X), WSP(bf16, WS_R2), (const bf16*)(*(unsigned char* const KAS*)(ka + KA_PART)), ws + WS_RT, INP(25), WSP(float, WS_RT + RT_SSQ), *(float* const KAS*)(ka + KA_OUT), last, poison, (pair == 0 && PROJ_F8(1)) ? ws + WS_XB : nullptr);
            if (pair == 0 && *(const int KAS*)(ka + KA_DBG) == 0 && pb + 17 < PHI()) p0_convert(F, ka, 1, WSP(bf16, WS_WB));
            SEAM(16);
        }
#undef IN
#undef PLO
#undef PHI
#undef SEAM
#undef REFRESH
#undef INP
#undef WSP
}
__global__ void __launch_bounds__(NWAVES * 64, 2) mk_fwd(Args args) {
    extern __shared__ __attribute__((aligned(16))) unsigned char lds[];
    Frame F;
    F.lds = (LAS unsigned char*)lds;
    F.MISC = (volatile LAS unsigned*)(F.lds + MISC_OFF);
    F.tid = threadIdx.x; F.lane = F.tid & 63; F.wave = __builtin_amdgcn_readfirstlane(F.tid >> 6);
    F.G = gridDim.x; { const int bx = blockIdx.x; F.vcu = (F.G % 8 == 0) ? (bx % 8) * (F.G / 8) + bx / 8 : bx; }
    for (int u = F.tid; u < (LDS_BYTES - LDSCTL_OFF) / 4; u += NWAVES * 64) ((LAS unsigned*)(F.lds + LDSCTL_OFF))[u] = 0u;
    __syncthreads();
    unsigned* barw = (unsigned*)((gu32*)(args.ws + WS_CTL) + CW_BAR) + (size_t)args.li * XCD_BAR_WORDS;
    (void)xcd_barrier_post(barw, F.MISC + 8);

    layer_pair<0>(F);
    layer_pair<1>(F);
#if defined(MK_STAT)
    {
        unsigned char* ws = args.ws; const int last = 2 * NPH - 1;
        if (threadIdx.x == 0) ((unsigned long long*)(ws + WS_STAMP))[((size_t)blockIdx.x * 40 + last) * 2] = __builtin_amdgcn_s_memrealtime();
        XcdBarrier b_; b_.bar = barw; b_.x = xb_xcc_id(); b_.st = F.MISC + 8; xcd_barrier(b_);
        if (blockIdx.x == 0 && threadIdx.x < 64) {
            const int lane = threadIdx.x; const unsigned long long* TS = (const unsigned long long*)(ws + WS_STAMP); const int G = gridDim.x;
            const unsigned long long t_begin = TS[1];
            float tot_idle = 0.f, tot_bar = 0.f, best_idle = -1.f; int best_s = 0; float ph_mean = 0.f, ph_max = 0.f, t_total = 0.f;
            unsigned long long first_arr0 = ~0ull;
            for (int s = 0; s < 2 * NPH; ++s) {
                if (s == 5 || s == 8 || s == 17 || s == 22 || s == 25) continue;
                unsigned long long amax = 0, amin = ~0ull, gmin = ~0ull; float asum = 0.f;
                for (int b = lane; b < G; b += 64) { const unsigned long long a = TS[((size_t)b * 40 + s) * 2], g = (s < last) ? TS[((size_t)b * 40 + s) * 2 + 1] : 0ull;
                    amax = a > amax ? a : amax; amin = a < amin ? a : amin; gmin = g < gmin ? g : gmin; }
#pragma unroll
                for (int o = 1; o < 64; o <<= 1) { const unsigned long long x = __shfl_xor(amax, o), y = __shfl_xor(amin, o), z = __shfl_xor(gmin, o); amax = x > amax ? x : amax; amin = y < amin ? y : amin; gmin = z < gmin ? z : gmin; }
                for (int b = lane; b < G; b += 64) asum += (float)(amax - TS[((size_t)b * 40 + s) * 2]);
#pragma unroll
                for (int o = 1; o < 64; o <<= 1) asum += __shfl_xor(asum, o);
                const float idle = asum / (float)G * 0.01f;
                const float bar = (s < last) ? (float)(gmin - amax) * 0.01f : 0.f;
                tot_idle += idle; tot_bar += bar; if (idle > best_idle) { best_idle = idle; best_s = s; }
                if (s == 0) first_arr0 = amin;
                if (s == MK_STAT_PARAM) { ph_max = idle;
                    int sp = s - 1; while (sp == 5 || sp == 8 || sp == 17 || sp == 22 || sp == 25) --sp;
                    if (sp >= 0) { unsigned long long g0 = ~0ull; for (int b = lane; b < G; b += 64) { const unsigned long long g = TS[((size_t)b * 40 + sp) * 2 + 1]; g0 = g < g0 ? g : g0; }
#pragma unroll
                        for (int o = 1; o < 64; o <<= 1) { const unsigned long long z = __shfl_xor(g0, o); g0 = z < g0 ? z : g0; }
                        ph_mean = (float)(amax - g0) * 0.01f; } }
            }
            (void)t_begin; (void)ph_mean; (void)t_total; (void)first_arr0;
            float stat = 0.f;
            if (MK_STAT == 1) stat = tot_idle; else if (MK_STAT == 2) stat = tot_bar; else if (MK_STAT == 3) stat = (float)best_s * 500.f + best_idle; else if (MK_STAT == 4) stat = ph_max; else if (MK_STAT == 5) stat = ph_mean * 0.25f;
            else if (MK_STAT == 17) { const LAS unsigned* sw = (const LAS unsigned*)(F.lds + 143360 + 1024); stat = (MK_STAT_PARAM == 0) ? (float)sw[3] * 0.01f * 0.25f : (MK_STAT_PARAM == 1) ? (float)sw[5] * 0.25f : (float)sw[4] * 0.25f; }
            else if (MK_STAT == 7 || MK_STAT == 8 || MK_STAT == 9) { const LAS unsigned* sw = (const LAS unsigned*)(F.lds + 143360 + 1024); stat = (MK_STAT == 9) ? (float)sw[2] : (float)sw[MK_STAT - 7] * 0.01f * 0.25f; }
            else if (MK_STAT == 31) { const LAS unsigned* sw = (const LAS unsigned*)(F.lds + 143360 + 1024); stat = (float)sw[1] * 0.01f * 5.f * 0.25f; }
            else if (MK_STAT >= 21 && MK_STAT <= 29) { const LAS unsigned* sw = (const LAS unsigned*)(F.lds + 143360 + 1024); stat = (float)sw[MK_STAT - 21 + 9] * 0.01f * 10.f * 0.25f; }
            else if (MK_STAT == 10) { unsigned long long a0 = ~0ull, a1 = 0ull;
                for (int b = lane; b < G; b += 64) { const unsigned long long g = TS[((size_t)b * 40 + 0) * 2 + 1], a = TS[((size_t)b * 40 + last) * 2]; a0 = g < a0 ? g : a0; a1 = a > a1 ? a : a1; }
#pragma unroll
                for (int o = 1; o < 64; o <<= 1) { const unsigned long long x = __shfl_xor(a0, o), y = __shfl_xor(a1, o); a0 = x < a0 ? x : a0; a1 = y > a1 ? y : a1; }
                stat = (float)(a1 - a0) * 0.01f * 0.25f; }
            else if ((MK_STAT >= 11 && MK_STAT <= 16) || (MK_STAT >= 18 && MK_STAT <= 20) || MK_STAT == 30) {
                float acc_wait = 0.f, acc_busy = 0.f, acc_grp = 0.f, r_mean = 0.f, r_max = 0.f, r_wait = 0.f;
                for (int s = 0; s < 2 * NPH; ++s) { if (s == 5 || s == 8 || s == 17 || s == 22 || s == 25) continue;
                    int sp = s - 1; while (sp == 5 || sp == 8 || sp == 17 || sp == 22 || sp == 25) --sp;
                    float bsum = 0.f, bmax = 0.f, wsum_ = 0.f;
                    for (int b = lane; b < G; b += 64) { const unsigned long long a = TS[((size_t)b * 40 + s) * 2];
                        if (sp >= 0) { const float d = (float)(a - TS[((size_t)b * 40 + sp) * 2 + 1]); bsum += d; bmax = d > bmax ? d : bmax; }
                        if (s < last) wsum_ += (float)(TS[((size_t)b * 40 + s) * 2 + 1] - a); }
#pragma unroll
                    for (int o = 1; o < 64; o <<= 1) { bsum += __shfl_xor(bsum, o); wsum_ += __shfl_xor(wsum_, o); const float z = __shfl_xor(bmax, o); bmax = z > bmax ? z : bmax; }
                    acc_wait += wsum_ / (float)G * 0.01f; acc_busy += (sp >= 0) ? bsum / (float)G * 0.01f : 0.f;
                    { const int kk = s % NPH; const int grp = (kk == 1 || kk == 4 || kk == 6 || kk == 7 || kk == 9 || kk == 11 || kk == 14 || kk == 15) ? 1 : (kk == 2) ? 2 : (kk == 3 || kk == 10 || kk == 12 || kk == 13) ? 3 : (kk == 16) ? 4 : 0; if (grp == MK_STAT_PARAM && sp >= 0) acc_grp += bsum / (float)G * 0.01f; }
                    if (s == MK_STAT_PARAM) { r_mean = bsum / (float)G * 0.01f; r_max = bmax * 0.01f; r_wait = wsum_ / (float)G * 0.01f; } }
                stat = (MK_STAT == 11 ? r_mean : MK_STAT == 12 ? r_max : MK_STAT == 13 ? r_wait : MK_STAT == 14 ? acc_wait : MK_STAT == 15 ? acc_busy : MK_STAT == 18 ? r_mean * 10.f : MK_STAT == 19 ? r_max * 10.f : MK_STAT == 20 ? r_wait * 10.f : MK_STAT == 30 ? r_mean * 40.f : acc_grp) * 0.25f; }
            else if (MK_STAT == 6) { int sp = MK_STAT_PARAM - 1; while (sp == 5 || sp == 8 || sp == 17 || sp == 22 || sp == 25) --sp;
                const unsigned long long* MT = TS + (size_t)256 * 80; const unsigned long long c0 = MT[sp * 2 + 1], c1 = MT[MK_STAT_PARAM * 2], r0 = TS[((size_t)0 * 40 + sp) * 2 + 1], r1 = TS[((size_t)0 * 40 + MK_STAT_PARAM) * 2];
                stat = (float)(c1 - c0) / (float)(r1 - r0) * 100.0f * 0.0625f; }
            if (lane == 0) { const unsigned long long t0 = __builtin_amdgcn_s_memrealtime(); const unsigned long long wait = (unsigned long long)(stat * 4.0f * 100.0f);
                while (__builtin_amdgcn_s_memrealtime() - t0 < wait) __builtin_amdgcn_s_sleep(8); }
        }
    }
#endif
}
#ifndef MK_DEBUG
#define MK_DEBUG 0
#endif
#ifndef MK_REPORT
#define MK_REPORT -1
#endif
static int mk_grid(size_t ws_need, size_t ws_size, int n_in) {
    static int grid = 0;
    if (grid == 0) {
        if (n_in != 26 || ws_size < ws_need) { fprintf(stderr, "kernel_launch: built for 26 inputs and >= %zu bytes of workspace; got n_in %d, ws %zu; nothing launched\n", ws_need, n_in, ws_size); grid = -1; return grid; }
        int dev = 0, cus = 0, per_cu = 0;
        if (hipGetDevice(&dev) != hipSuccess || hipDeviceGetAttribute(&cus, hipDeviceAttributeMultiprocessorCount, dev) != hipSuccess) { grid = -1; return grid; }
        if (hipFuncSetAttribute((const void*)mk_fwd, hipFuncAttributeMaxDynamicSharedMemorySize, LDS_BYTES) != hipSuccess) { fprintf(stderr, "kernel_launch: hipFuncSetAttribute failed\n"); grid = -1; return grid; }
        if (hipOccupancyMaxActiveBlocksPerMultiprocessor(&per_cu, (const void*)mk_fwd, NWAVES * 64, LDS_BYTES) != hipSuccess || per_cu < 1) { fprintf(stderr, "kernel_launch: occupancy query reports %d\n", per_cu); }
        (void)hipGetLastError();
        grid = cus;
    }
    return grid;
}
#if MK_DEBUG
namespace dbg {
__global__ void __launch_bounds__(256) k_cmp(const void* a, int a_bf16, int lda, float sa, const float* b, int ldb, int rows, int cols, float* acc) {
    const size_t n = (size_t)rows * cols; float d2 = 0.f, b2 = 0.f;
    for (size_t i = (size_t)blockIdx.x * 256 + threadIdx.x; i < n; i += (size_t)gridDim.x * 256) { const size_t r = i / cols, c = i % cols;
        const float av = (a_bf16 ? __uint_as_float((unsigned)((const unsigned short*)a)[r * lda + c] << 16) : ((const float*)a)[r * lda + c]) * sa; const float bv = b[r * ldb + c];
        const float d = av - bv; d2 += d * d; b2 += bv * bv; }
    d2 = orc::wsum(d2); b2 = orc::wsum(b2);
    if ((threadIdx.x & 63) == 0) { atomicAdd(acc, d2); atomicAdd(acc + 1, b2); }
}
__global__ void k_report(float* out, const float* acc, int n, float tol, int which) {
    if (threadIdx.x != 0 || blockIdx.x != 0) return;
    float pert = 0.f;
    if (which < 0) { for (int i = 0; i < n; ++i) { const float e = sqrtf(acc[2 * i] / acc[2 * i + 1]); if (!(e <= tol)) { pert = exp2f((float)(i + 1)); break; } } }
    else { const float e = sqrtf(acc[2 * which] / acc[2 * which + 1]); pert = (e == e) ? e * 1024.f : 3e4f; }
    out[0] += pert;
}
__global__ void __launch_bounds__(256) k_prep(const float* xo, unsigned short* X, float* ssq4) {
    const int row = blockIdx.x * 4 + (threadIdx.x >> 6), lane = threadIdx.x & 63; float s = 0.f;
    for (int j = 0; j < 16; ++j) { const int c = lane + 64 * j; const float v = xo[(size_t)row * 1024 + c]; unsigned u = __float_as_uint(v); u = (u + 0x7fffu + ((u >> 16) & 1u)) >> 16; X[(size_t)row * 1024 + c] = (unsigned short)u; const float r = __uint_as_float(u << 16); s += r * r; }
    s = orc::wsum(s); if (lane < 4) ssq4[(size_t)row * 4 + lane] = lane == 0 ? s : 0.f;
}
static void cmp(hipStream_t st, const void* a, int a_bf16, int lda, float sa, const float* b, int ldb, int rows, int cols, float* acc) {
    hipLaunchKernelGGL(k_cmp, dim3(2048), dim3(256), 0, st, a, a_bf16, lda, sa, b, ldb, rows, cols, acc);
}
}
#endif

extern "C" void kernel_launch(void* const* d_in, const int* in_sizes, int n_in, void* d_out, int out_size, void* d_ws, size_t ws_size, hipStream_t stream) {
#if !MK_DEBUG
    const int grid = mk_grid(WS_FAST_END + (size_t)TAIL_KS * TAIL_ROWS * D * 2, ws_size, n_in); if (grid < 0) return;
    (void)hipMemsetAsync((char*)d_ws + WS_CTL, 0, 65536, stream);
    Args a{};
    for (int i = 0; i < 26; ++i) a.in[i] = (const float*)d_in[i];
    a.out = (float*)d_out; a.ws = (unsigned char*)d_ws; a.part = (unsigned char*)d_ws + WS_FAST_END; a.ph_lo = 0; a.ph_hi = 2 * NPH; a.li = 0; a.dbg = 0;
    hipLaunchKernelGGL(mk_fwd, dim3(grid), dim3(NWAVES * 64), LDS_BYTES, stream, a);
#if defined(PROBE_LO)
    a.ph_lo = PROBE_LO; a.ph_hi = PROBE_HI; a.li = 1; a.out = (float*)((unsigned char*)d_ws + WS_R1);
    hipLaunchKernelGGL(mk_fwd, dim3(grid), dim3(NWAVES * 64), LDS_BYTES, stream, a);
#endif
#else
    const int grid = mk_grid(WS_FAST_END + orc::O_END, ws_size, n_in); if (grid < 0) return;
    (void)hipMemsetAsync((char*)d_ws + WS_CTL, 0, CTL_ZERO_BYTES, stream);
    unsigned char* ws = (unsigned char*)d_ws; unsigned char* ob = ws + WS_FAST_END;
    const orc::In I = orc::make_in(d_in);
    float* Xo = (float*)(ob + orc::O_X); float* Ho = (float*)(ob + orc::O_H); float* BIGo = (float*)(ob + orc::O_BIG);
    unsigned short* Xf = (unsigned short*)(ws + WS_X);
    float* acc = (float*)(ws + WS_CTL + 512 * 1024);
    float* fout = (float*)(ws + WS_R1);
    hipLaunchKernelGGL(orc::k_copy, dim3(T * D / 4 / 256), dim3(256), 0, stream, (const float4*)I.x, (float4*)Xo, (size_t)T * D / 4);
    Args a{};
    for (int i = 0; i < 26; ++i) a.in[i] = (const float*)d_in[i];
    a.out = fout; a.ws = ws; a.part = (unsigned char*)d_out; a.dbg = 1;
    const int plo[4] = {0, 5, 8, 12}, phi[4] = {5, 8, 12, 17};
    for (int sub = 0; sub < 8; ++sub) {
        const int pair = sub >> 2, s4 = sub & 3; float* ac = acc + 2 * 10 * pair;
        hipLaunchKernelGGL(dbg::k_prep, dim3(T / 4), dim3(256), 0, stream, (const float*)Xo, Xf, (float*)(ws + WS_RT + RT_SSQ));
        a.ph_lo = pair * NPH + plo[s4]; a.ph_hi = pair * NPH + phi[s4]; a.li = sub;
        hipLaunchKernelGGL(mk_fwd, dim3(grid), dim3(NWAVES * 64), LDS_BYTES, stream, a);
        orc::sublayer(stream, I, ob, sub);
        if (s4 == 0) {
            const unsigned short* PROJ = (const unsigned short*)(ws + WS_R1 + R1_PROJ); const unsigned short* MIX = (const unsigned short*)(ws + WS_R1 + R1_MIX);
            dbg::cmp(stream, PROJ + 512, 1, NPROJ, 1.f, BIGo + 512, NPROJ, T, 1024, ac + 0);
            dbg::cmp(stream, PROJ, 1, NPROJ, 1.f / attn_body::C2, BIGo, NPROJ, T, 512, ac + 2);
            dbg::cmp(stream, MIX + 512, 1, D, 1.f, Ho + 512, D, T, 512, ac + 4);
            dbg::cmp(stream, MIX, 1, D, 1.f, Ho, D, T, 512, ac + 6);
            dbg::cmp(stream, Xf, 1, D, 1.f, Xo, D, T, D, ac + 8);
        } else if (s4 == 1) {
            const unsigned short* HB = (const unsigned short*)(ws + WS_R1 + R1_HB);
            dbg::cmp(stream, HB + (size_t)8192 * DFF, 1, DFF, 1.f, BIGo, DFF, 8192, DFF, ac + 10);
            dbg::cmp(stream, Xf, 1, D, 1.f, Xo, D, T, D, ac + 12);
        } else if (s4 == 2) {
            const unsigned short* V = (const unsigned short*)(ws + WS_R1 + R1_V);
            dbg::cmp(stream, V, 1, D, 1.f, Ho, D, T, D, ac + 14);
            dbg::cmp(stream, Xf, 1, D, 1.f, Xo, D, T, D, ac + 16);
        } else if (pair == 0) {
            dbg::cmp(stream, Xf, 1, D, 1.f, Xo, D, T, D, ac + 18);
        }
    }
    hipLaunchKernelGGL(orc::k_rmsnorm, dim3(T / 4), dim3(256), 0, stream, (const float*)Xo, I.final_norm_g, (float*)d_out, T);
    dbg::cmp(stream, fout, 0, D, 1.f, (const float*)d_out, D, T, D, acc + 2 * 19);
    hipLaunchKernelGGL(dbg::k_report, dim3(1), dim3(64), 0, stream, (float*)d_out, (const float*)acc, 20, 0.03f, (int)MK_REPORT);
#endif
}
```
